# Optimizing an MI355X kernel written in HIP

```python
import jax, jax.numpy as jnp
from jax import lax
import numpy as np

D_MODEL = 1024
BATCH = 2
SEQ = 8192
DEPTH = 2

D_LRU = 1024
LRU_HEADS = 16
LRU_BW = D_LRU // LRU_HEADS
RG_C = 8.0
CONV_K = 4
D_SSD = 1024
SSD_HEAD_DIM = 64
SSD_HEADS = D_SSD // SSD_HEAD_DIM
SSD_GROUPS = 4
SSD_STATE = 128
SSD_CHUNK = 128
SSD_CONV_DIM = D_SSD + 2 * SSD_GROUPS * SSD_STATE
D_MIX = D_LRU + D_SSD
IN_COLS = 2 * D_LRU + D_SSD + SSD_CONV_DIM + SSD_HEADS
MOE_GROUPS = 4
EXPERTS_PER_GROUP = 8
N_EXPERTS = MOE_GROUPS * EXPERTS_PER_GROUP
TOP_K = 2
D_EXPERT = 512
MOE_BLOCK = 128
EPS = 1e-6

kernel_name = "hybrid_rglru_ssd_hmoe_trunk"


def rms_norm(x, w):
    xf = x.astype(jnp.float32)
    y = xf * lax.rsqrt(jnp.mean(xf * xf, axis=-1, keepdims=True) + EPS)
    return (y * w.astype(jnp.float32)).astype(x.dtype)


def causal_dwconv(x, w, b):
    c = x.shape[-1]
    y = lax.conv_general_dilated(
        x, w[:, None, :].astype(x.dtype), window_strides=(1,),
        padding=[(CONV_K - 1, 0)], dimension_numbers=('NWC', 'WIO', 'NWC'),
        feature_group_count=c)
    return y + b.astype(x.dtype)


def linear_recurrence(a, u):
    def combine(l, r):
        a1, b1 = l
        a2, b2 = r
        return a1 * a2, a2 * b1 + b2
    _, h = lax.associative_scan(combine, (a, u), axis=1)
    return h


def rg_lru(u, wa, ba, wx, bx, lam):
    bsz, s, _ = u.shape
    ub = u.reshape(bsz, s, LRU_HEADS, LRU_BW)
    r = jax.nn.sigmoid(jnp.einsum('bshi,hij->bshj', ub, wa.astype(jnp.float32)) + ba).reshape(bsz, s, D_LRU)
    i = jax.nn.sigmoid(jnp.einsum('bshi,hij->bshj', ub, wx.astype(jnp.float32)) + bx).reshape(bsz, s, D_LRU)
    log_a = RG_C * r * jax.nn.log_sigmoid(lam.astype(jnp.float32))
    a = jnp.exp(log_a)
    mult = jnp.sqrt(-jnp.expm1(2.0 * log_a))
    return linear_recurrence(a, mult * (i * u))


def ssd_chunked(x, dt, A, Bm, Cm):
    b, s, h, p = x.shape
    g, n = Bm.shape[2], Bm.shape[3]
    c, l = s // SSD_CHUNK, SSD_CHUNK
    Bh = jnp.repeat(Bm, h // g, axis=2).reshape(b, c, l, h, n)
    Ch = jnp.repeat(Cm, h // g, axis=2).reshape(b, c, l, h, n)
    xdt = (x * dt[..., None]).reshape(b, c, l, h, p)
    a_cs = jnp.cumsum((dt * A).reshape(b, c, l, h), axis=2)
    seg = a_cs[:, :, :, None, :] - a_cs[:, :, None, :, :]
    mask = jnp.tril(jnp.ones((l, l), dtype=bool))[None, None, :, :, None]
    Lmat = jnp.exp(jnp.where(mask, seg, -jnp.inf))
    scores = jnp.einsum('bclhn,bcshn->bclsh', Ch, Bh)
    y_diag = jnp.einsum('bclsh,bcshp->bclhp', scores * Lmat, xdt)
    decay_states = jnp.exp(a_cs[:, :, -1:, :] - a_cs)
    states = jnp.einsum('bclhn,bclh,bclhp->bchpn', Bh, decay_states, xdt)
    chunk_decay = jnp.exp(a_cs[:, :, -1, :])

    def step(prev, inp):
        st, dec = inp
        return prev * dec[:, :, None, None] + st, prev

    _, prev_states = lax.scan(step, jnp.zeros((b, h, p, n), jnp.float32),
                              (states.transpose(1, 0, 2, 3, 4), chunk_decay.transpose(1, 0, 2)))
    prev_states = prev_states.transpose(1, 0, 2, 3, 4)
    y_off = jnp.einsum('bclhn,bchpn,bclh->bclhp', Ch, prev_states, jnp.exp(a_cs))
    return (y_diag + y_off).reshape(b, s, h, p)


def hybrid_mixer(h, w_in, lru_conv_w, lru_conv_b, lru_wa, lru_ba, lru_wx, lru_bx, lru_lambda,
                 lru_norm, ssd_conv_w, ssd_conv_b, ssd_dt_bias, ssd_a_log, ssd_d, ssd_norm, w_out):
    bsz, s, _ = h.shape
    proj = h @ w_in
    o1 = D_LRU
    o2 = o1 + D_LRU
    o3 = o2 + D_SSD
    o4 = o3 + SSD_CONV_DIM
    lru_x, lru_gate, ssd_z, ssd_xbc, ssd_dt = (proj[..., :o1], proj[..., o1:o2], proj[..., o2:o3],
                                               proj[..., o3:o4], proj[..., o4:])
    u = causal_dwconv(lru_x, lru_conv_w, lru_conv_b).astype(jnp.float32)
    hr = rg_lru(u, lru_wa, lru_ba, lru_wx, lru_bx, lru_lambda)
    y_lru = rms_norm((jax.nn.gelu(lru_gate.astype(jnp.float32)) * hr).astype(h.dtype), lru_norm)
    xbc = jax.nn.silu(causal_dwconv(ssd_xbc, ssd_conv_w, ssd_conv_b).astype(jnp.float32))
    xs = xbc[..., :D_SSD].reshape(bsz, s, SSD_HEADS, SSD_HEAD_DIM)
    Bm = xbc[..., D_SSD:D_SSD + SSD_GROUPS * SSD_STATE].reshape(bsz, s, SSD_GROUPS, SSD_STATE)
    Cm = xbc[..., D_SSD + SSD_GROUPS * SSD_STATE:].reshape(bsz, s, SSD_GROUPS, SSD_STATE)
    dt = jax.nn.softplus(ssd_dt.astype(jnp.float32) + ssd_dt_bias.astype(jnp.float32))
    A = -jnp.exp(ssd_a_log.astype(jnp.float32))
    y = ssd_chunked(xs, dt, A, Bm, Cm) + xs * ssd_d.astype(jnp.float32)[:, None]
    y = y.reshape(bsz, s, D_SSD) * jax.nn.silu(ssd_z.astype(jnp.float32))
    y_ssd = rms_norm(y.astype(h.dtype), ssd_norm)
    return jnp.concatenate([y_lru, y_ssd], axis=-1) @ w_out


def hier_moe(h, w_coarse, b_coarse, w_fine, b_fine, w_gate, w_up, w_down):
    bsz, s, d = h.shape
    xt = h.reshape(-1, d)
    n = xt.shape[0]
    xf = xt.astype(jnp.float32)
    c_logits = xf @ w_coarse.astype(jnp.float32) + b_coarse.astype(jnp.float32)
    c_prob = jax.nn.softmax(c_logits, axis=-1)
    g_idx = jnp.argmax(c_logits, axis=-1)
    g_w = jnp.take_along_axis(c_prob, g_idx[:, None], axis=1)[:, 0]
    f_all = jnp.einsum('nd,gde->nge', xf, w_fine.astype(jnp.float32)) + b_fine.astype(jnp.float32)
    f_logits = jnp.take_along_axis(f_all, g_idx[:, None, None], axis=1)[:, 0]
    f_val, f_idx = lax.top_k(f_logits, TOP_K)
    f_w = jax.nn.softmax(f_val, axis=-1)
    expert = (g_idx[:, None] * EXPERTS_PER_GROUP + f_idx).reshape(-1).astype(jnp.int32)
    weight = (g_w[:, None] * f_w).reshape(-1)
    token = jnp.repeat(jnp.arange(n, dtype=jnp.int32), TOP_K)
    n_assign = n * TOP_K
    n_blocks = -(-(n_assign + N_EXPERTS * (MOE_BLOCK - 1)) // MOE_BLOCK)
    n_rows = n_blocks * MOE_BLOCK
    order = jnp.argsort(expert)
    e_sorted = expert[order]
    counts = jnp.bincount(expert, length=N_EXPERTS).astype(jnp.int32)
    padded = (counts + MOE_BLOCK - 1) // MOE_BLOCK * MOE_BLOCK
    pad_end = jnp.cumsum(padded)
    pad_start = pad_end - padded
    start = jnp.cumsum(counts) - counts
    dest = pad_start[e_sorted] + jnp.arange(n_assign, dtype=jnp.int32) - start[e_sorted]
    row_tok = jnp.zeros((n_rows,), jnp.int32).at[dest].set(token[order])
    row_w = jnp.zeros((n_rows,), jnp.float32).at[dest].set(weight[order])
    blk_expert = jnp.minimum(
        jnp.searchsorted(pad_end, jnp.arange(n_blocks, dtype=jnp.int32) * MOE_BLOCK, side='right'),
        N_EXPERTS - 1)
    xb = xt[row_tok].reshape(n_blocks, MOE_BLOCK, d)

    def expert_block(args):
        xi, e = args
        hid = jax.nn.silu(xi @ w_gate[e]) * (xi @ w_up[e])
        return hid @ w_down[e]

    yb = lax.map(expert_block, (xb, blk_expert)).reshape(n_rows, d)
    out = jnp.zeros_like(xt).at[row_tok].add(yb * row_w[:, None].astype(yb.dtype))
    return out.reshape(bsz, s, d)


def setup_inputs(seed: int = 0) -> dict:
    key = jax.random.key(seed)
    ks = jax.random.split(key, 32)
    f32 = jnp.float32
    nrm = lambda k, shape, scale: jax.random.normal(k, shape, f32) * scale
    gain = lambda k, shape: 1.0 + 0.01 * jax.random.normal(k, shape, f32)
    u = jax.random.uniform(ks[9], (DEPTH, D_LRU), f32, 0.9, 0.999)
    s_l = u ** (1.0 / RG_C)
    lam = jnp.log(s_l) - jnp.log1p(-s_l)
    dt0 = jnp.exp(jax.random.uniform(ks[13], (DEPTH, SSD_HEADS), f32) * (jnp.log(0.1) - jnp.log(0.001)) + jnp.log(0.001))
    dt_bias = dt0 + jnp.log(-jnp.expm1(-dt0))
    return {
        "x": jax.random.normal(ks[0], (BATCH, SEQ, D_MODEL), f32),
        "norm_mix": gain(ks[1], (DEPTH, D_MODEL)),
        "w_in": nrm(ks[2], (DEPTH, D_MODEL, IN_COLS), D_MODEL ** -0.5),
        "lru_conv_w": nrm(ks[3], (DEPTH, CONV_K, D_LRU), CONV_K ** -0.5),
        "lru_conv_b": nrm(ks[4], (DEPTH, D_LRU), 0.02),
        "lru_wa": nrm(ks[5], (DEPTH, LRU_HEADS, LRU_BW, LRU_BW), LRU_BW ** -0.5),
        "lru_ba": nrm(ks[6], (DEPTH, LRU_HEADS, LRU_BW), 0.02),
        "lru_wx": nrm(ks[7], (DEPTH, LRU_HEADS, LRU_BW, LRU_BW), LRU_BW ** -0.5),
        "lru_bx": nrm(ks[8], (DEPTH, LRU_HEADS, LRU_BW), 0.02),
        "lru_lambda": lam,
        "lru_norm": gain(ks[10], (DEPTH, D_LRU)),
        "ssd_conv_w": nrm(ks[11], (DEPTH, CONV_K, SSD_CONV_DIM), CONV_K ** -0.5),
        "ssd_conv_b": nrm(ks[12], (DEPTH, SSD_CONV_DIM), 0.02),
        "ssd_dt_bias": dt_bias,
        "ssd_a_log": jnp.log(jax.random.uniform(ks[14], (DEPTH, SSD_HEADS), f32, 1.0, 16.0)),
        "ssd_d": gain(ks[15], (DEPTH, SSD_HEADS)),
        "ssd_norm": gain(ks[16], (DEPTH, D_SSD)),
        "w_out": nrm(ks[17], (DEPTH, D_MIX, D_MODEL), D_MIX ** -0.5),
        "norm_ffn": gain(ks[18], (DEPTH, D_MODEL)),
        "w_coarse": nrm(ks[19], (DEPTH, D_MODEL, MOE_GROUPS), D_MODEL ** -0.5),
        "b_coarse": nrm(ks[20], (DEPTH, MOE_GROUPS), 0.01),
        "w_fine": nrm(ks[21], (DEPTH, MOE_GROUPS, D_MODEL, EXPERTS_PER_GROUP), D_MODEL ** -0.5),
        "b_fine": nrm(ks[22], (DEPTH, MOE_GROUPS, EXPERTS_PER_GROUP), 0.01),
        "w_gate": nrm(ks[23], (DEPTH, N_EXPERTS, D_MODEL, D_EXPERT), D_MODEL ** -0.5),
        "w_up": nrm(ks[24], (DEPTH, N_EXPERTS, D_MODEL, D_EXPERT), D_MODEL ** -0.5),
        "w_down": nrm(ks[25], (DEPTH, N_EXPERTS, D_EXPERT, D_MODEL), D_EXPERT ** -0.5),
        "final_norm": gain(ks[26], (D_MODEL,)),
    }


def reference(x, norm_mix, w_in, lru_conv_w, lru_conv_b, lru_wa, lru_ba, lru_wx, lru_bx, lru_lambda,
              lru_norm, ssd_conv_w, ssd_conv_b, ssd_dt_bias, ssd_a_log, ssd_d, ssd_norm, w_out,
              norm_ffn, w_coarse, b_coarse, w_fine, b_fine, w_gate, w_up, w_down, final_norm):
    for i in range(DEPTH):
        h = rms_norm(x, norm_mix[i])
        x = x + hybrid_mixer(h, w_in[i], lru_conv_w[i], lru_conv_b[i], lru_wa[i], lru_ba[i],
                             lru_wx[i], lru_bx[i], lru_lambda[i], lru_norm[i], ssd_conv_w[i],
                             ssd_conv_b[i], ssd_dt_bias[i], ssd_a_log[i], ssd_d[i], ssd_norm[i], w_out[i])
        h = rms_norm(x, norm_ffn[i])
        x = x + hier_moe(h, w_coarse[i], b_coarse[i], w_fine[i], b_fine[i], w_gate[i], w_up[i], w_down[i])
    return rms_norm(x, final_norm)
```

```cpp
#include <hip/hip_runtime.h>
#include <hip/hip_cooperative_groups.h>
#include <cstdint>
#include <cstdio>
namespace cg = cooperative_groups;

#ifndef ONE_LAUNCH
#define ONE_LAUNCH 0
#endif

#define LAS __attribute__((address_space(3)))
typedef unsigned short bf16_t;
typedef short bf16x8 __attribute__((ext_vector_type(8)));
typedef float f32x4 __attribute__((ext_vector_type(4)));
typedef unsigned u32x2 __attribute__((ext_vector_type(2)));
typedef unsigned u32x4 __attribute__((ext_vector_type(4)));

constexpr int NB = 2, SEQ = 8192, DM = 1024, NTOK = NB * SEQ, DEPTH = 2;
constexpr int INC = 5136, PROJW = 5120;
constexpr int SSD_CD = 2048;
constexpr int O_LX = 0, O_LG = 1024, O_Z = 2048, O_XS = 3072, O_B = 4096, O_C = 4608;
constexpr int NEXP = 32, DEXP = 512, NCH = 64, CH = 128;
constexpr int NTHR = 512;
constexpr int MAXTILES = 160;
constexpr int LISTCAP = NTOK;

constexpr size_t MiB = 1u << 20;
constexpr size_t WS_CTL = 0;
constexpr size_t WS_WIN = 1 * MiB;
constexpr size_t WS_WOUT = 11 * MiB;
constexpr size_t WS_WGU = 15 * MiB;
constexpr size_t WS_WD = 79 * MiB;
constexpr size_t WS_PROJ = 111 * MiB;
constexpr size_t WS_H = WS_PROJ;
constexpr size_t WS_HID = WS_PROJ + 32 * MiB;
constexpr size_t WS_YSLOT = WS_PROJ + 72 * MiB;
constexpr size_t WS_LTOK = WS_PROJ + 136 * MiB;
constexpr size_t WS_LW = WS_PROJ + 138 * MiB;
constexpr size_t WS_MIX = 271 * MiB;
constexpr size_t WS_XN = WS_MIX;
constexpr size_t WS_STATES = 335 * MiB;
constexpr size_t WS_DTRAW = 399 * MiB;
constexpr size_t WS_ROWSS = 400 * MiB;
constexpr size_t WS_LSUM = 401 * MiB;
constexpr size_t WS_LCARRY = 402 * MiB;
constexpr size_t WS_DECAY = 403 * MiB;
constexpr size_t WS_END = 404 * MiB;

constexpr int LDS_BYTES = 150 * 1024;

struct Params {
    const float *x, *norm_mix, *w_in, *lru_conv_w, *lru_conv_b, *lru_wa, *lru_ba, *lru_wx, *lru_bx, *lru_lambda, *lru_norm,
        *ssd_conv_w, *ssd_conv_b, *ssd_dt_bias, *ssd_a_log, *ssd_d, *ssd_norm, *w_out, *norm_ffn, *w_coarse, *b_coarse, *w_fine, *b_fine,
        *w_gate, *w_up, *w_down, *final_norm;
    float* X;
    unsigned char* ws;
};

__device__ __forceinline__ float bf2f(bf16_t v) { return __uint_as_float((unsigned)v << 16); }
__device__ __forceinline__ unsigned f2bf(float f) { unsigned u = __float_as_uint(f); return (u + 0x7fffu + ((u >> 16) & 1u)) >> 16; }
__device__ __forceinline__ unsigned pk2(float lo, float hi) { return f2bf(lo) | (f2bf(hi) << 16); }
__device__ __forceinline__ float wave_sum(float v) {
#pragma unroll
    for (int o = 1; o < 64; o <<= 1) v += __shfl_xor(v, o);
    return v;
}
__device__ __forceinline__ float sigmoid_f(float x) { return 1.f / (1.f + __expf(-x)); }
__device__ __forceinline__ float silu_f(float x) { return x * sigmoid_f(x); }
__device__ __forceinline__ float softplus_f(float x) { return x > 20.f ? x : log1pf(__expf(x)); }
__device__ __forceinline__ float gelu_tanh_f(float x) { const float u = 0.7978845608028654f * (x + 0.044715f * x * x * x); return 0.5f * x * (1.f + tanhf(u)); }

#define LDS_WAIT() asm volatile("s_waitcnt lgkmcnt(0)" ::: "memory")
#define VM_WAIT() asm volatile("s_waitcnt vmcnt(0)" ::: "memory")

__device__ __forceinline__ void tr_item(const float* src, int ld, int k0, int c0, bf16_t* dst, int ldd, int r0, const float* kscale, LAS float* scr, int lane) {
#pragma unroll 8
    for (int i = 0; i < 32; ++i) {
        const int kk = 2 * i + (lane >> 5), nn = lane & 31;
        float v = src[(size_t)(k0 + kk) * ld + c0 + nn];
        if (kscale) v *= kscale[k0 + kk];
        scr[kk * 33 + nn] = v;
    }
    LDS_WAIT();
    const int c = lane & 7;
#pragma unroll
    for (int j = 0; j < 4; ++j) {
        const int n = (lane >> 3) + 8 * j; const LAS float* s = scr + (8 * c) * 33 + n;
        u32x4 o; o.x = pk2(s[0 * 33], s[1 * 33]); o.y = pk2(s[2 * 33], s[3 * 33]); o.z = pk2(s[4 * 33], s[5 * 33]); o.w = pk2(s[6 * 33], s[7 * 33]);
        *(u32x4*)(dst + (size_t)(r0 + n) * ldd + k0 + 8 * c) = o;
    }
    LDS_WAIT();
}

__device__ __forceinline__ void ph_convert(const Params& p, int l, LAS unsigned char* lds) {
    const int tid = threadIdx.x, lane = tid & 63, wave = tid >> 6;
    LAS float* scr = (LAS float*)(lds + wave * 16384);
    const int gw = blockIdx.x * 8 + wave, NGW = gridDim.x * 8;
    bf16_t* WinT = (bf16_t*)(p.ws + WS_WIN); bf16_t* WoutT = (bf16_t*)(p.ws + WS_WOUT); bf16_t* WguT = (bf16_t*)(p.ws + WS_WGU); bf16_t* WdT = (bf16_t*)(p.ws + WS_WD);
    constexpr int I_IN = 16 * 160, I_OUT = 32 * 32, I_GU = 32 * 512, I_D = 32 * 256;
    for (int it = gw; it < I_IN + I_OUT + I_GU + I_D; it += NGW) {
        int r = it;
        if (r < I_IN) { const int kb = r / 160, nb = r % 160; tr_item(p.w_in + (size_t)l * DM * INC, INC, kb * 64, nb * 32, WinT, DM, nb * 32, nullptr, scr, lane); continue; }
        r -= I_IN;
        if (r < I_OUT) { const int kb = r / 32, nb = r % 32; const int k0 = kb * 64;
            const float* ks = (k0 < 1024) ? (p.lru_norm + l * 1024) : (p.ssd_norm + l * 1024 - 1024);
            tr_item(p.w_out + (size_t)l * 2048 * DM, DM, k0, nb * 32, WoutT, 2048, nb * 32, ks, scr, lane); continue; }
        r -= I_OUT;
        if (r < I_GU) { const int e = r / 512, q = r % 512, kb = q / 32, rb = q % 32, pn = rb >> 3, jb = rb & 7;
            const float* src = (jb < 4 ? p.w_gate : p.w_up) + ((size_t)l * NEXP + e) * DM * DEXP;
            const int c0 = 128 * pn + 32 * (jb & 3);
            tr_item(src, DEXP, kb * 64, c0, WguT + (size_t)e * 1024 * 1024, DM, rb * 32, nullptr, scr, lane); continue; }
        r -= I_GU;
        { const int e = r / 256, q = r % 256, kb = q / 32, nb = q % 32;
            tr_item(p.w_down + ((size_t)l * NEXP + e) * DEXP * DM, DM, kb * 64, nb * 32, WdT + (size_t)e * 1024 * 512, DEXP, nb * 32, nullptr, scr, lane); }
    }
}

__device__ __forceinline__ void ph_norm(const Params& p, int l) {
    const int tid = threadIdx.x, lane = tid & 63, wave = tid >> 6;
    const int gw = blockIdx.x * 8 + wave, NGW = gridDim.x * 8;
    bf16_t* xn = (bf16_t*)(p.ws + WS_XN); float* dtraw = (float*)(p.ws + WS_DTRAW);
    const bf16_t* ys = (const bf16_t*)(p.ws + WS_YSLOT);
    const float* nw = p.norm_mix + l * DM;
    const float* wdt = p.w_in + (size_t)l * DM * INC + PROJW;
    if (blockIdx.x == 0 && tid < 64) ((int*)(p.ws + WS_CTL))[tid] = 0;
    for (int row = gw; row < NTOK; row += NGW) {
        f32x4 v[4];
        const float* src = (l == 0 ? p.x : p.X) + (size_t)row * DM;
#pragma unroll
        for (int j = 0; j < 4; ++j) v[j] = *(const f32x4*)(src + j * 256 + lane * 4);
        if (l > 0) {
#pragma unroll
            for (int s = 0; s < 2; ++s)
#pragma unroll
                for (int j = 0; j < 4; ++j) { const u32x2 y = *(const u32x2*)(ys + ((size_t)s * NTOK + row) * DM + j * 256 + lane * 4);
                    v[j].x += __uint_as_float(y.x << 16); v[j].y += __uint_as_float(y.x & 0xffff0000u); v[j].z += __uint_as_float(y.y << 16); v[j].w += __uint_as_float(y.y & 0xffff0000u); }
#pragma unroll
            for (int j = 0; j < 4; ++j) *(f32x4*)(p.X + (size_t)row * DM + j * 256 + lane * 4) = v[j];
        }
        float ss = 0.f;
#pragma unroll
        for (int j = 0; j < 4; ++j) ss += (v[j].x * v[j].x + v[j].y * v[j].y) + (v[j].z * v[j].z + v[j].w * v[j].w);
        const float rstd = rsqrtf(wave_sum(ss) * (1.f / DM) + 1e-6f);
#pragma unroll
        for (int j = 0; j < 4; ++j) { const f32x4 w = *(const f32x4*)(nw + j * 256 + lane * 4); v[j] = v[j] * rstd * w;
            u32x2 o; o.x = pk2(v[j].x, v[j].y); o.y = pk2(v[j].z, v[j].w); *(u32x2*)(xn + (size_t)row * DM + j * 256 + lane * 4) = o; }
        float dacc[16];
#pragma unroll
        for (int h = 0; h < 16; ++h) dacc[h] = 0.f;
#pragma unroll
        for (int j = 0; j < 4; ++j)
#pragma unroll
            for (int e = 0; e < 4; ++e) { const int k = j * 256 + lane * 4 + e; const float xv = v[j][e];
#pragma unroll
                for (int q = 0; q < 4; ++q) { const f32x4 w = *(const f32x4*)(wdt + (size_t)k * INC + q * 4);
                    dacc[q * 4 + 0] += xv * w.x; dacc[q * 4 + 1] += xv * w.y; dacc[q * 4 + 2] += xv * w.z; dacc[q * 4 + 3] += xv * w.w; } }
        float mine = 0.f;
#pragma unroll
        for (int h = 0; h < 16; ++h) { const float s = wave_sum(dacc[h]); if (lane == h) mine = s; }
        if (lane < 16) dtraw[(size_t)row * 16 + lane] = mine;
    }
}

constexpr int SG_A = 0, SG_B = 16384;
template <class ARow, class Mid, class Epi>
__device__ __forceinline__ void sgemm_tile(LAS unsigned char* lds, const ARow& arow, const bf16_t* Bt, int K, const Mid& mid, const Epi& epi) {
    const int tid = threadIdx.x, wid = __builtin_amdgcn_readfirstlane(tid >> 6), lane = tid & 63, wr = wid >> 2, wc = wid & 3, fr = lane & 15, fq = lane >> 4;
    const bf16_t* ap[2]; const bf16_t* bp[2];
#pragma unroll
    for (int i = 0; i < 2; ++i) { const int pc = tid + i * 512, row = pc >> 2, ch = pc & 3; ap[i] = arow(row) + ch * 8; bp[i] = Bt + (size_t)row * K + ch * 8; }
    f32x4 acc[8][2][2];
#pragma unroll
    for (int m = 0; m < 8; ++m)
#pragma unroll
        for (int bj = 0; bj < 2; ++bj)
#pragma unroll
            for (int n = 0; n < 2; ++n) acc[m][bj][n] = (f32x4){0.f, 0.f, 0.f, 0.f};
    const int nkt = K / 32;
    for (int kt = 0; kt < nkt; ++kt) {
        mid(kt, acc, wr, fq);
#pragma unroll
        for (int i = 0; i < 2; ++i) {
            __builtin_amdgcn_global_load_lds((const unsigned*)(ap[i] + kt * 32), (LAS unsigned*)(lds + SG_A + wid * 1024 + i * 8192), 16, 0, 0);
            __builtin_amdgcn_global_load_lds((const unsigned*)(bp[i] + kt * 32), (LAS unsigned*)(lds + SG_B + wid * 1024 + i * 8192), 16, 0, 0);
        }
        VM_WAIT(); __syncthreads();
        bf16x8 af[8], bfr[2][2];
#pragma unroll
        for (int m = 0; m < 8; ++m) af[m] = *(const LAS bf16x8*)(lds + SG_A + (wr * 128 + m * 16 + fr) * 64 + fq * 16);
#pragma unroll
        for (int bj = 0; bj < 2; ++bj)
#pragma unroll
            for (int n = 0; n < 2; ++n) bfr[bj][n] = *(const LAS bf16x8*)(lds + SG_B + (bj * 128 + wc * 32 + n * 16 + fr) * 64 + fq * 16);
#pragma unroll
        for (int m = 0; m < 8; ++m)
#pragma unroll
            for (int bj = 0; bj < 2; ++bj)
#pragma unroll
                for (int n = 0; n < 2; ++n) acc[m][bj][n] = __builtin_amdgcn_mfma_f32_16x16x32_bf16(af[m], bfr[bj][n], acc[m][bj][n], 0, 0, 0);
        __syncthreads();
    }
#pragma unroll
    for (int m = 0; m < 8; ++m)
#pragma unroll
        for (int n = 0; n < 2; ++n)
#pragma unroll
            for (int j = 0; j < 4; ++j) epi(wr * 128 + m * 16 + fq * 4 + j, wc * 32 + n * 16 + fr, acc[m][0][n][j], acc[m][1][n][j]);
}
struct NoMid { __device__ __forceinline__ void operator()(int, f32x4 (&)[8][2][2], int, int) const {} };
struct ARowPlain { const bf16_t* base; int ld; __device__ __forceinline__ const bf16_t* operator()(int r) const { return base + (size_t)r * ld; } };

struct EpiProj { bf16_t* out; __device__ __forceinline__ void operator()(int r, int c, float v0, float v1) const { out[(size_t)r * PROJW + c] = (bf16_t)f2bf(v0); out[(size_t)r * PROJW + 128 + c] = (bf16_t)f2bf(v1); } };
__device__ __forceinline__ void ph_inproj(const Params& p, LAS unsigned char* lds) {
    const bf16_t* xn = (const bf16_t*)(p.ws + WS_XN); const bf16_t* WinT = (const bf16_t*)(p.ws + WS_WIN); bf16_t* proj = (bf16_t*)(p.ws + WS_PROJ);
    for (int u = blockIdx.x; u < 64 * 20; u += gridDim.x) { const int pm = u / 20, pn = u % 20;
        sgemm_tile(lds, ARowPlain{xn + (size_t)pm * 256 * DM, DM}, WinT + (size_t)pn * 256 * DM, DM, NoMid{}, EpiProj{proj + (size_t)pm * 256 * PROJW + pn * 256}); }
}

__device__ __forceinline__ void row_rstd(const float* rowss, int row, float& rl, float& rs) {
    const f32x4 a = *(const f32x4*)(rowss + (size_t)row * 8), b = *(const f32x4*)(rowss + (size_t)row * 8 + 4);
    rl = rsqrtf(((a.x + a.y) + (a.z + a.w)) * (1.f / 1024.f) + 1e-6f); rs = rsqrtf(((b.x + b.y) + (b.z + b.w)) * (1.f / 1024.f) + 1e-6f);
}
struct MidOut { const float* rowss; int row0;
    __device__ __forceinline__ void operator()(int kt, f32x4 (&acc)[8][2][2], int wr, int fq) const {
        if (kt != 32) return;
#pragma unroll
        for (int m = 0; m < 8; ++m)
#pragma unroll
            for (int j = 0; j < 4; ++j) { float rl, rs; row_rstd(rowss, row0 + wr * 128 + m * 16 + fq * 4 + j, rl, rs); const float f = rl / rs;
#pragma unroll
                for (int bj = 0; bj < 2; ++bj)
#pragma unroll
                    for (int n = 0; n < 2; ++n) acc[m][bj][n][j] *= f; }
    } };
struct EpiOut { const float* resid; float* out; const float* rowss; int row0;
    __device__ __forceinline__ void operator()(int r, int c, float v0, float v1) const { float rl, rs; row_rstd(rowss, row0 + r, rl, rs);
        out[(size_t)r * DM + c] = resid[(size_t)r * DM + c] + rs * v0; out[(size_t)r * DM + 128 + c] = resid[(size_t)r * DM + 128 + c] + rs * v1; } };
__device__ __forceinline__ void ph_outproj(const Params& p, int l, LAS unsigned char* lds) {
    const bf16_t* mix = (const bf16_t*)(p.ws + WS_MIX); const bf16_t* WoutT = (const bf16_t*)(p.ws + WS_WOUT); const float* rowss = (const float*)(p.ws + WS_ROWSS);
    const float* resid = (l == 0) ? p.x : p.X;
    for (int u = blockIdx.x; u < 64 * 4; u += gridDim.x) { const int pm = u / 4, pn = u % 4; const size_t o = (size_t)pm * 256 * DM + pn * 256;
        sgemm_tile(lds, ARowPlain{mix + (size_t)pm * 256 * 2048, 2048}, WoutT + (size_t)pn * 256 * 2048, 2048, MidOut{rowss, pm * 256}, EpiOut{resid + o, p.X + o, rowss, pm * 256}); }
}

__device__ __forceinline__ float conv4(const bf16_t* proj, int R0, int t0, int l, int col, const float* cw, int cwld, float cb) {
    float acc = cb;
#pragma unroll
    for (int k = 0; k < 4; ++k) { const int tt = t0 + l - 3 + k; if (tt >= 0) acc += cw[k * cwld] * bf2f(proj[(size_t)(R0 + l - 3 + k) * PROJW + col]); }
    return acc;
}

__device__ __forceinline__ void lru_head_av(const Params& p, int l_, const bf16_t* proj, int R0, int t0, int h, LAS float* ub, LAS float* was, LAS float* wxs, LAS float* av, LAS float* vv) {
    const int tid = threadIdx.x;
    const float* cw = p.lru_conv_w + (size_t)l_ * 4 * 1024; const float* cb = p.lru_conv_b + l_ * 1024;
    for (int i = tid; i < 64 * 64; i += NTHR) { was[i] = p.lru_wa[((size_t)l_ * 16 + h) * 4096 + i]; wxs[i] = p.lru_wx[((size_t)l_ * 16 + h) * 4096 + i]; }
    for (int i = tid; i < 128 * 64; i += NTHR) { const int l = i >> 6, j = i & 63, col = h * 64 + j; ub[i] = conv4(proj, R0, t0, l, O_LX + col, cw + col, 1024, cb[col]); }
    __syncthreads();
    { const int l = tid >> 2, jb = (tid & 3) * 16;
        float ra[16], ia[16];
#pragma unroll
        for (int q = 0; q < 16; ++q) { ra[q] = 0.f; ia[q] = 0.f; }
        for (int i = 0; i < 64; ++i) { const float uv = ub[l * 64 + i];
#pragma unroll
            for (int q = 0; q < 16; ++q) { ra[q] += uv * was[i * 64 + jb + q]; ia[q] += uv * wxs[i * 64 + jb + q]; } }
#pragma unroll
        for (int q = 0; q < 16; ++q) { const int j = jb + q, col = h * 64 + j;
            const float r = sigmoid_f(ra[q] + p.lru_ba[l_ * 1024 + col]), ig = sigmoid_f(ia[q] + p.lru_bx[l_ * 1024 + col]);
            const float lam = p.lru_lambda[l_ * 1024 + col];
            const float log_a = 8.f * r * (-softplus_f(-lam));
            const float a = __expf(log_a); const float mult = sqrtf(fmaxf(0.f, -expm1f(2.f * log_a)));
            av[l * 64 + j] = a; vv[l * 64 + j] = mult * (ig * ub[l * 64 + j]); }
    }
    __syncthreads();
}

__device__ __forceinline__ void ssd_dt(const Params& p, int l_, int R0, int g, LAS float* dtv, LAS float* acs) {
    const int tid = threadIdx.x; const float* dtraw = (const float*)(p.ws + WS_DTRAW);
    if (tid < 4) { const int h = 4 * g + tid; const float bias = p.ssd_dt_bias[l_ * 16 + h], A = -__expf(p.ssd_a_log[l_ * 16 + h]); float cum = 0.f;
        for (int l = 0; l < 128; ++l) { const float dt = softplus_f(dtraw[(size_t)(R0 + l) * 16 + h] + bias); cum += dt * A; dtv[tid * 128 + l] = dt; acs[tid * 128 + l] = cum; } }
}

__device__ __forceinline__ void ph_mixA(const Params& p, int l_, LAS unsigned char* lds) {
    const int tid = threadIdx.x;
    const bf16_t* proj = (const bf16_t*)(p.ws + WS_PROJ);
    float* states = (float*)(p.ws + WS_STATES); float* decay = (float*)(p.ws + WS_DECAY); float* lsum = (float*)(p.ws + WS_LSUM);
    LAS float* xh = (LAS float*)(lds);
    LAS float* Bc = (LAS float*)(lds + 32768);
    LAS float* dtv = (LAS float*)(lds + 98304);
    LAS float* acs = (LAS float*)(lds + 100352);
    LAS float* was = (LAS float*)(lds + 102400);
    LAS float* wxs = (LAS float*)(lds + 118784);
    const float* cw = p.ssd_conv_w + (size_t)l_ * 4 * SSD_CD; const float* cb = p.ssd_conv_b + l_ * SSD_CD;
    for (int u = blockIdx.x; u < NB * NCH * 4; u += gridDim.x) {
        const int g = u & 3, c = (u >> 2) & 63, b = u >> 8; const int t0 = c * CH, R0 = b * SEQ + t0;
        for (int i = tid; i < 128 * 128; i += NTHR) { const int l = i >> 7, n = i & 127, cc = 1024 + g * 128 + n;
            Bc[i] = silu_f(conv4(proj, R0, t0, l, O_XS + cc, cw + cc, SSD_CD, cb[cc])); }
        ssd_dt(p, l_, R0, g, dtv, acs);
        __syncthreads();
        for (int hh = 0; hh < 4; ++hh) { const int h = 4 * g + hh;
            const float alast = acs[hh * 128 + 127];
            for (int i = tid; i < 128 * 64; i += NTHR) { const int l = i >> 6, pp = i & 63, cc = h * 64 + pp;
                xh[i] = silu_f(conv4(proj, R0, t0, l, O_XS + cc, cw + cc, SSD_CD, cb[cc])) * dtv[hh * 128 + l] * __expf(alast - acs[hh * 128 + l]); }
            __syncthreads();
            { const int pp = tid >> 3, nb = (tid & 7) * 16; float a16[16];
#pragma unroll
                for (int q = 0; q < 16; ++q) a16[q] = 0.f;
                for (int l = 0; l < 128; ++l) { const float xv = xh[l * 64 + pp];
#pragma unroll
                    for (int q = 0; q < 16; ++q) a16[q] += xv * Bc[l * 128 + nb + q]; }
                float* st = states + ((size_t)((b * NCH + c) * 16 + h)) * 8192 + pp * 128 + nb;
#pragma unroll
                for (int q = 0; q < 16; q += 4) *(f32x4*)(st + q) = (f32x4){a16[q], a16[q + 1], a16[q + 2], a16[q + 3]};
                if (tid == 0) decay[(b * NCH + c) * 16 + h] = __expf(alast);
            }
            __syncthreads();
        }
        LAS float* av = Bc; LAS float* vv = Bc + 128 * 64;
        for (int hh = 0; hh < 4; ++hh) { const int h = 4 * g + hh;
            lru_head_av(p, l_, proj, R0, t0, h, xh, was, wxs, av, vv);
            if (tid < 64) { float P = 1.f, hc = 0.f;
                for (int l = 0; l < 128; ++l) { const float a = av[l * 64 + tid]; hc = a * hc + vv[l * 64 + tid]; P *= a; }
                float* o = lsum + ((size_t)(b * NCH + c) * 1024 + h * 64 + tid) * 2; o[0] = P; o[1] = hc; }
            __syncthreads();
        }
    }
}

__device__ __forceinline__ void ph_scan(const Params& p) {
    float* states = (float*)(p.ws + WS_STATES); const float* decay = (const float*)(p.ws + WS_DECAY);
    const float* lsum = (const float*)(p.ws + WS_LSUM); float* lcarry = (float*)(p.ws + WS_LCARRY);
    const int gt = blockIdx.x * NTHR + threadIdx.x, NGT = gridDim.x * NTHR;
    for (int e = gt; e < NB * 16 * 8192 / 4; e += NGT) {
        const int q = e & 2047, h = (e >> 11) & 15, b = e >> 15;
        f32x4 r = (f32x4){0.f, 0.f, 0.f, 0.f};
        for (int c = 0; c < NCH; ++c) { f32x4* sp = (f32x4*)(states + ((size_t)((b * NCH + c) * 16 + h)) * 8192) + q; const f32x4 t = *sp; *sp = r; r = r * decay[(b * NCH + c) * 16 + h] + t; }
    }
    for (int e = gt; e < NB * 1024; e += NGT) { const int ch = e & 1023, b = e >> 10; float r = 0.f;
        for (int c = 0; c < NCH; ++c) { const size_t i = (size_t)(b * NCH + c) * 1024 + ch; lcarry[i] = r; r = lsum[i * 2] * r + lsum[i * 2 + 1]; } }
}

__device__ __forceinline__ void ph_mixB(const Params& p, int l_, LAS unsigned char* lds) {
    const int tid = threadIdx.x;
    const bf16_t* proj = (const bf16_t*)(p.ws + WS_PROJ); bf16_t* mix = (bf16_t*)(p.ws + WS_MIX); float* rowss = (float*)(p.ws + WS_ROWSS);
    const float* states = (const float*)(p.ws + WS_STATES); const float* lcarry = (const float*)(p.ws + WS_LCARRY);
    LAS bf16_t* Bc = (LAS bf16_t*)(lds);
    LAS bf16_t* Cc = (LAS bf16_t*)(lds + 32768);
    LAS bf16_t* Sc = (LAS bf16_t*)(lds + 65536);
    LAS float* xh = (LAS float*)(lds + 98304);
    LAS bf16_t* pv = (LAS bf16_t*)(lds + 131072);
    LAS float* dtv = (LAS float*)(lds + 147456);
    LAS float* acs = (LAS float*)(lds + 149504);
    LAS float* was = (LAS float*)(lds); LAS float* wxs = (LAS float*)(lds + 16384); LAS float* av = (LAS float*)(lds + 32768); LAS float* vv = (LAS float*)(lds + 65536);
    const float* cw = p.ssd_conv_w + (size_t)l_ * 4 * SSD_CD; const float* cb = p.ssd_conv_b + l_ * SSD_CD;
    for (int u = blockIdx.x; u < NB * NCH * 4; u += gridDim.x) {
        const int g = u & 3, c = (u >> 2) & 63, b = u >> 8; const int t0 = c * CH, R0 = b * SEQ + t0;
        for (int i = tid; i < 128 * 128; i += NTHR) { const int l = i >> 7, n = i & 127, cb_ = 1024 + g * 128 + n, cc_ = 1536 + g * 128 + n;
            Bc[i] = (bf16_t)f2bf(silu_f(conv4(proj, R0, t0, l, O_XS + cb_, cw + cb_, SSD_CD, cb[cb_])));
            Cc[i] = (bf16_t)f2bf(silu_f(conv4(proj, R0, t0, l, O_XS + cc_, cw + cc_, SSD_CD, cb[cc_]))); }
        ssd_dt(p, l_, R0, g, dtv, acs);
        __syncthreads();
        { const int l = tid >> 2, sb = (tid & 3) * 32;
            for (int s = sb; s < sb + 32; ++s) { float d = 0.f;
                if (s <= l) { for (int n = 0; n < 128; ++n) d += bf2f(Cc[l * 128 + n]) * bf2f(Bc[s * 128 + n]); }
                Sc[l * 128 + s] = (bf16_t)f2bf(d); } }
        __syncthreads();
        float ssq = 0.f;
        for (int hh = 0; hh < 4; ++hh) { const int h = 4 * g + hh;
            for (int i = tid; i < 128 * 64; i += NTHR) { const int l = i >> 6, pp = i & 63, cc = h * 64 + pp; xh[i] = silu_f(conv4(proj, R0, t0, l, O_XS + cc, cw + cc, SSD_CD, cb[cc])); }
            { const float* st = states + ((size_t)((b * NCH + c) * 16 + h)) * 8192; for (int i = tid; i < 8192; i += NTHR) pv[i] = (bf16_t)f2bf(st[i]); }
            __syncthreads();
            { const int l = tid >> 2, pb = (tid & 3) * 16; float yd[16], yo[16];
#pragma unroll
                for (int q = 0; q < 16; ++q) { yd[q] = 0.f; yo[q] = 0.f; }
                const float al = acs[hh * 128 + l];
                for (int s = 0; s <= l; ++s) { const float w = bf2f(Sc[l * 128 + s]) * __expf(al - acs[hh * 128 + s]) * dtv[hh * 128 + s];
#pragma unroll
                    for (int q = 0; q < 16; ++q) yd[q] += w * xh[s * 64 + pb + q]; }
                for (int n = 0; n < 128; ++n) { const float cv = bf2f(Cc[l * 128 + n]);
#pragma unroll
                    for (int q = 0; q < 16; ++q) yo[q] += cv * bf2f(pv[(pb + q) * 128 + n]); }
                const float eal = __expf(al), Dh = p.ssd_d[l_ * 16 + h];
#pragma unroll
                for (int q = 0; q < 16; ++q) { const int pp = pb + q;
                    float y = yd[q] + eal * yo[q] + Dh * xh[l * 64 + pp];
                    const float z = bf2f(proj[(size_t)(R0 + l) * PROJW + O_Z + h * 64 + pp]);
                    y *= silu_f(z); ssq += y * y;
                    mix[(size_t)(R0 + l) * 2048 + 1024 + h * 64 + pp] = (bf16_t)f2bf(y); }
            }
            __syncthreads();
        }
        ssq += __shfl_xor(ssq, 1); ssq += __shfl_xor(ssq, 2);
        if ((tid & 3) == 0) rowss[(size_t)(R0 + (tid >> 2)) * 8 + 4 + g] = ssq;
        float lsq = 0.f;
        for (int hh = 0; hh < 4; ++hh) { const int h = 4 * g + hh;
            lru_head_av(p, l_, proj, R0, t0, h, xh, was, wxs, av, vv);
            if (tid < 64) { float hc = lcarry[(size_t)(b * NCH + c) * 1024 + h * 64 + tid];
                for (int l = 0; l < 128; ++l) { hc = av[l * 64 + tid] * hc + vv[l * 64 + tid]; vv[l * 64 + tid] = hc; } }
            __syncthreads();
            { const int l = tid >> 2, jb = (tid & 3) * 16;
#pragma unroll
                for (int q = 0; q < 16; ++q) { const int j = jb + q; const float gt = bf2f(proj[(size_t)(R0 + l) * PROJW + O_LG + h * 64 + j]);
                    const float y = gelu_tanh_f(gt) * vv[l * 64 + j]; lsq += y * y; mix[(size_t)(R0 + l) * 2048 + h * 64 + j] = (bf16_t)f2bf(y); } }
            __syncthreads();
        }
        lsq += __shfl_xor(lsq, 1); lsq += __shfl_xor(lsq, 2);
        if ((tid & 3) == 0) rowss[(size_t)(R0 + (tid >> 2)) * 8 + g] = lsq;
        __syncthreads();
    }
}

__device__ __forceinline__ void ph_router(const Params& p, int l) {
    const int tid = threadIdx.x, lane = tid & 63, wave = tid >> 6;
    const int gw = blockIdx.x * 8 + wave, NGW = gridDim.x * 8;
    bf16_t* hb = (bf16_t*)(p.ws + WS_H); int* cnt = (int*)(p.ws + WS_CTL); int* ltok = (int*)(p.ws + WS_LTOK); float* lw = (float*)(p.ws + WS_LW);
    const float* nw = p.norm_ffn + l * DM; const float* wc = p.w_coarse + (size_t)l * DM * 4; const float* wf = p.w_fine + (size_t)l * 4 * DM * 8;
    for (int row = gw; row < NTOK; row += NGW) {
        f32x4 v[4]; float ss = 0.f;
#pragma unroll
        for (int j = 0; j < 4; ++j) { v[j] = *(const f32x4*)(p.X + (size_t)row * DM + j * 256 + lane * 4); ss += (v[j].x * v[j].x + v[j].y * v[j].y) + (v[j].z * v[j].z + v[j].w * v[j].w); }
        const float rstd = rsqrtf(wave_sum(ss) * (1.f / DM) + 1e-6f);
        float cl[4] = {0.f, 0.f, 0.f, 0.f};
#pragma unroll
        for (int j = 0; j < 4; ++j) { const f32x4 w = *(const f32x4*)(nw + j * 256 + lane * 4); v[j] = v[j] * rstd * w;
            u32x2 o; o.x = pk2(v[j].x, v[j].y); o.y = pk2(v[j].z, v[j].w); *(u32x2*)(hb + (size_t)row * DM + j * 256 + lane * 4) = o;
#pragma unroll
            for (int e = 0; e < 4; ++e) { const f32x4 c4 = *(const f32x4*)(wc + (size_t)(j * 256 + lane * 4 + e) * 4); const float xv = v[j][e];
                cl[0] += xv * c4.x; cl[1] += xv * c4.y; cl[2] += xv * c4.z; cl[3] += xv * c4.w; } }
#pragma unroll
        for (int q = 0; q < 4; ++q) cl[q] = wave_sum(cl[q]) + p.b_coarse[l * 4 + q];
        int gi = 0; float cm = cl[0];
#pragma unroll
        for (int q = 1; q < 4; ++q) if (cl[q] > cm) { cm = cl[q]; gi = q; }
        float den = 0.f;
#pragma unroll
        for (int q = 0; q < 4; ++q) den += __expf(cl[q] - cm);
        const float gwt = 1.f / den;
        float fl[8];
#pragma unroll
        for (int q = 0; q < 8; ++q) fl[q] = 0.f;
        const float* wfg = wf + (size_t)gi * DM * 8;
#pragma unroll
        for (int j = 0; j < 4; ++j)
#pragma unroll
            for (int e = 0; e < 4; ++e) { const float* wp = wfg + (size_t)(j * 256 + lane * 4 + e) * 8; const f32x4 a = *(const f32x4*)wp, b2 = *(const f32x4*)(wp + 4); const float xv = v[j][e];
                fl[0] += xv * a.x; fl[1] += xv * a.y; fl[2] += xv * a.z; fl[3] += xv * a.w; fl[4] += xv * b2.x; fl[5] += xv * b2.y; fl[6] += xv * b2.z; fl[7] += xv * b2.w; }
#pragma unroll
        for (int q = 0; q < 8; ++q) fl[q] = wave_sum(fl[q]) + p.b_fine[(l * 4 + gi) * 8 + q];
        int i0 = 0; float v0 = fl[0];
#pragma unroll
        for (int q = 1; q < 8; ++q) if (fl[q] > v0) { v0 = fl[q]; i0 = q; }
        int i1 = -1; float v1 = -3.0e38f;
#pragma unroll
        for (int q = 0; q < 8; ++q) if (q != i0 && fl[q] > v1) { v1 = fl[q]; i1 = q; }
        const float e1 = __expf(v1 - v0), w0 = gwt / (1.f + e1), w1 = gwt * e1 / (1.f + e1);
        if (lane == 0) {
            const int ex0 = gi * 8 + i0, ex1 = gi * 8 + i1;
            const int p0 = atomicAdd(cnt + ex0, 1); ltok[(size_t)ex0 * LISTCAP + p0] = row * 2 + 0; lw[(size_t)ex0 * LISTCAP + p0] = w0;
            const int p1 = atomicAdd(cnt + ex1, 1); ltok[(size_t)ex1 * LISTCAP + p1] = row * 2 + 1; lw[(size_t)ex1 * LISTCAP + p1] = w1;
        }
    }
}

__device__ __forceinline__ int moe_tiles(const Params& p, LAS int* tb) {
    const int* cnt = (const int*)(p.ws + WS_CTL);
    __syncthreads();
    if (threadIdx.x == 0) { int s = 0; for (int e = 0; e < NEXP; ++e) { tb[e] = s; s += (cnt[e] + 255) >> 8; } tb[NEXP] = s; }
    __syncthreads();
    return tb[NEXP];
}
struct ARowGather { const bf16_t* h; const int* ltok; int pos0, n; __device__ __forceinline__ const bf16_t* operator()(int r) const { const int ps = pos0 + r; const int tok = (ps < n) ? (ltok[ps] >> 1) : 0; return h + (size_t)tok * DM; } };
struct EpiUp { bf16_t* hid; __device__ __forceinline__ void operator()(int r, int c, float v0, float v1) const { hid[(size_t)r * DEXP + c] = (bf16_t)f2bf(silu_f(v0) * v1); } };
__device__ __forceinline__ void ph_moe_up(const Params& p, LAS unsigned char* lds) {
    LAS int* tb = (LAS int*)(lds + 40960);
    const int nt = moe_tiles(p, tb);
    const int* cnt = (const int*)(p.ws + WS_CTL); const int* ltok = (const int*)(p.ws + WS_LTOK);
    const bf16_t* hb = (const bf16_t*)(p.ws + WS_H); const bf16_t* WguT = (const bf16_t*)(p.ws + WS_WGU); bf16_t* hid = (bf16_t*)(p.ws + WS_HID);
    for (int u = blockIdx.x; u < nt * 4; u += gridDim.x) { const int t = u >> 2, pn = u & 3; int e = 0; while (tb[e + 1] <= t) ++e;
        const int pos0 = (t - tb[e]) * 256;
        sgemm_tile(lds, ARowGather{hb, ltok + (size_t)e * LISTCAP, pos0, cnt[e]}, WguT + ((size_t)e * 1024 + pn * 256) * DM, DM, NoMid{}, EpiUp{hid + (size_t)t * 256 * DEXP + pn * 128}); }
}
struct EpiDown { bf16_t* ys; const int* ltok; const float* lw; int pos0, n, col0;
    __device__ __forceinline__ void operator()(int r, int c, float v0, float v1) const { const int ps = pos0 + r; if (ps < n) { const int tk = ltok[ps]; const float w = lw[ps];
        bf16_t* o = ys + ((size_t)(tk & 1) * NTOK + (tk >> 1)) * DM + col0; o[c] = (bf16_t)f2bf(w * v0); o[128 + c] = (bf16_t)f2bf(w * v1); } } };
__device__ __forceinline__ void ph_moe_down(const Params& p, LAS unsigned char* lds) {
    LAS int* tb = (LAS int*)(lds + 40960);
    const int nt = moe_tiles(p, tb);
    const int* cnt = (const int*)(p.ws + WS_CTL); const int* ltok = (const int*)(p.ws + WS_LTOK); const float* lw = (const float*)(p.ws + WS_LW);
    const bf16_t* hid = (const bf16_t*)(p.ws + WS_HID); const bf16_t* WdT = (const bf16_t*)(p.ws + WS_WD); bf16_t* ys = (bf16_t*)(p.ws + WS_YSLOT);
    for (int u = blockIdx.x; u < nt * 4; u += gridDim.x) { const int t = u >> 2, pn = u & 3; int e = 0; while (tb[e + 1] <= t) ++e;
        const int pos0 = (t - tb[e]) * 256;
        sgemm_tile(lds, ARowPlain{hid + (size_t)t * 256 * DEXP, DEXP}, WdT + ((size_t)e * 1024 + pn * 256) * DEXP, DEXP, NoMid{},
                   EpiDown{ys, ltok + (size_t)e * LISTCAP, lw + (size_t)e * LISTCAP, pos0, cnt[e], pn * 256}); }
}

__device__ __forceinline__ void ph_final(const Params& p) {
    const int tid = threadIdx.x, lane = tid & 63, wave = tid >> 6;
    const int gw = blockIdx.x * 8 + wave, NGW = gridDim.x * 8;
    const bf16_t* ys = (const bf16_t*)(p.ws + WS_YSLOT);
    for (int row = gw; row < NTOK; row += NGW) {
        f32x4 v[4];
#pragma unroll
        for (int j = 0; j < 4; ++j) v[j] = *(const f32x4*)(p.X + (size_t)row * DM + j * 256 + lane * 4);
#pragma unroll
        for (int s = 0; s < 2; ++s)
#pragma unroll
            for (int j = 0; j < 4; ++j) { const u32x2 y = *(const u32x2*)(ys + ((size_t)s * NTOK + row) * DM + j * 256 + lane * 4);
                v[j].x += __uint_as_float(y.x << 16); v[j].y += __uint_as_float(y.x & 0xffff0000u); v[j].z += __uint_as_float(y.y << 16); v[j].w += __uint_as_float(y.y & 0xffff0000u); }
        float ss = 0.f;
#pragma unroll
        for (int j = 0; j < 4; ++j) ss += (v[j].x * v[j].x + v[j].y * v[j].y) + (v[j].z * v[j].z + v[j].w * v[j].w);
        const float rstd = rsqrtf(wave_sum(ss) * (1.f / DM) + 1e-6f);
#pragma unroll
        for (int j = 0; j < 4; ++j) { const f32x4 w = *(const f32x4*)(p.final_norm + j * 256 + lane * 4); *(f32x4*)(p.X + (size_t)row * DM + j * 256 + lane * 4) = v[j] * rstd * w; }
    }
}


#ifndef DBG
#define DBG 0
#endif
#ifndef DBGA
#define DBGA 12
#define DBGB 12
#endif
#if DBG
constexpr size_t WS_MIX2 = 404 * MiB;
constexpr size_t WS_DBG = 470 * MiB;
__global__ void __launch_bounds__(64) dbg_lru_seq(Params p, int l_) {
    const int b = blockIdx.x >> 4, h = blockIdx.x & 15, j = threadIdx.x, col = h * 64 + j;
    const bf16_t* proj = (const bf16_t*)(p.ws + WS_PROJ); bf16_t* mix2 = (bf16_t*)(p.ws + WS_MIX2);
    __shared__ float us[64];
    const float* cw = p.lru_conv_w + (size_t)l_ * 4 * 1024 + col; const float cb = p.lru_conv_b[l_ * 1024 + col];
    const float* wa = p.lru_wa + ((size_t)l_ * 16 + h) * 4096; const float* wx = p.lru_wx + ((size_t)l_ * 16 + h) * 4096;
    const float ba = p.lru_ba[l_ * 1024 + col], bx = p.lru_bx[l_ * 1024 + col], lam = p.lru_lambda[l_ * 1024 + col];
    const float ls = -log1pf(expf(-lam));
    float hc = 0.f;
    for (int t = 0; t < SEQ; ++t) {
        float u = cb;
        for (int k = 0; k < 4; ++k) { const int tt = t - 3 + k; if (tt >= 0) u += cw[k * 1024] * bf2f(proj[(size_t)(b * SEQ + tt) * PROJW + O_LX + col]); }
        __syncthreads(); us[j] = u; __syncthreads();
        float ra = ba, ia = bx;
        for (int i = 0; i < 64; ++i) { ra += us[i] * wa[i * 64 + j]; ia += us[i] * wx[i * 64 + j]; }
        const float r = 1.f / (1.f + expf(-ra)), ig = 1.f / (1.f + expf(-ia));
        const float log_a = 8.f * r * ls, a = expf(log_a), mult = sqrtf(fmaxf(0.f, -expm1f(2.f * log_a)));
        hc = a * hc + mult * (ig * u);
        const float gt = bf2f(proj[(size_t)(b * SEQ + t) * PROJW + O_LG + col]);
        mix2[(size_t)(b * SEQ + t) * 2048 + col] = (bf16_t)f2bf(gelu_tanh_f(gt) * hc);
    }
}
__global__ void __launch_bounds__(512) dbg_ssd_seq(Params p, int l_) {
    const int b = blockIdx.x >> 4, h = blockIdx.x & 15, g = h >> 2, tid = threadIdx.x;
    const bf16_t* proj = (const bf16_t*)(p.ws + WS_PROJ); bf16_t* mix2 = (bf16_t*)(p.ws + WS_MIX2); const float* dtraw = (const float*)(p.ws + WS_DTRAW);
    __shared__ float xs[64], Bs[128], Cs[128];
    const float* cw = p.ssd_conv_w + (size_t)l_ * 4 * SSD_CD; const float* cb = p.ssd_conv_b + l_ * SSD_CD;
    const float bias = p.ssd_dt_bias[l_ * 16 + h], A = -expf(p.ssd_a_log[l_ * 16 + h]), Dh = p.ssd_d[l_ * 16 + h];
    const int pp = tid >> 3, nb = (tid & 7) * 16;
    float st[16];
    for (int q = 0; q < 16; ++q) st[q] = 0.f;
    for (int t = 0; t < SEQ; ++t) {
        __syncthreads();
        if (tid < 320) { int cc; if (tid < 64) cc = h * 64 + tid; else if (tid < 192) cc = 1024 + g * 128 + (tid - 64); else cc = 1536 + g * 128 + (tid - 192);
            float u = cb[cc];
            for (int k = 0; k < 4; ++k) { const int tt = t - 3 + k; if (tt >= 0) u += cw[k * SSD_CD + cc] * bf2f(proj[(size_t)(b * SEQ + tt) * PROJW + O_XS + cc]); }
            u = u / (1.f + expf(-u));
            if (tid < 64) xs[tid] = u; else if (tid < 192) Bs[tid - 64] = u; else Cs[tid - 192] = u; }
        __syncthreads();
        const float dtp = dtraw[(size_t)(b * SEQ + t) * 16 + h] + bias; const float dt = dtp > 20.f ? dtp : log1pf(expf(dtp));
        const float dec = expf(dt * A), xv = xs[pp] * dt;
        float y = 0.f;
        for (int q = 0; q < 16; ++q) { st[q] = dec * st[q] + xv * Bs[nb + q]; y += Cs[nb + q] * st[q]; }
        y += __shfl_xor(y, 1); y += __shfl_xor(y, 2); y += __shfl_xor(y, 4);
        if ((tid & 7) == 0) { y += Dh * xs[pp]; const float z = bf2f(proj[(size_t)(b * SEQ + t) * PROJW + O_Z + h * 64 + pp]); y *= z / (1.f + expf(-z));
            mix2[(size_t)(b * SEQ + t) * 2048 + 1024 + h * 64 + pp] = (bf16_t)f2bf(y); }
    }
}
__global__ void dbg_cmp_mix(Params p) {
    const bf16_t* a = (const bf16_t*)(p.ws + WS_MIX); const bf16_t* b2 = (const bf16_t*)(p.ws + WS_MIX2); float* acc = (float*)(p.ws + WS_DBG);
    float s[4] = {0.f, 0.f, 0.f, 0.f};
    for (size_t i = (size_t)blockIdx.x * blockDim.x + threadIdx.x; i < (size_t)NTOK * 2048; i += (size_t)gridDim.x * blockDim.x) {
        const int col = (int)(i & 2047); const float x = bf2f(a[i]), y = bf2f(b2[i]); const int o = col < 1024 ? 0 : 2; s[o] += (x - y) * (x - y); s[o + 1] += y * y; }
    for (int q = 0; q < 4; ++q) { const float v = wave_sum(s[q]); if ((threadIdx.x & 63) == 0) atomicAdd(acc + q, v); }
}

__global__ void dbg_chk_inproj(Params p, int l) {
    const int sidx = blockIdx.x * blockDim.x + threadIdx.x; float* acc = (float*)(p.ws + WS_DBG);
    const bf16_t* proj = (const bf16_t*)(p.ws + WS_PROJ); const float* dtraw = (const float*)(p.ws + WS_DTRAW);
    unsigned hsh = (unsigned)sidx * 2654435761u + 12345u; hsh ^= hsh >> 13; hsh *= 0x5bd1e995u; hsh ^= hsh >> 15;
    const int row = hsh % NTOK, col = (hsh >> 14) % INC;
    const float* xr = (l == 0 ? p.x : p.X) + (size_t)row * DM; float ss = 0.f;
    for (int k = 0; k < DM; ++k) ss += xr[k] * xr[k];
    const float rstd = 1.f / sqrtf(ss / DM + 1e-6f);
    float d = 0.f;
    for (int k = 0; k < DM; ++k) d += (xr[k] * rstd * p.norm_mix[l * DM + k]) * p.w_in[((size_t)l * DM + k) * INC + col];
    if (col < PROJW) { const float got = bf2f(proj[(size_t)row * PROJW + col]); atomicAdd(acc + 4, (got - d) * (got - d)); atomicAdd(acc + 5, d * d); }
    else { const float got = dtraw[(size_t)row * 16 + col - PROJW]; atomicAdd(acc + 6, (got - d) * (got - d)); atomicAdd(acc + 7, d * d); }
}
__global__ void dbg_chk_outproj(Params p, int l) {
    const int sidx = blockIdx.x * blockDim.x + threadIdx.x; float* acc = (float*)(p.ws + WS_DBG);
    const bf16_t* mix = (const bf16_t*)(p.ws + WS_MIX);
    unsigned hsh = (unsigned)sidx * 2654435761u + 777u; hsh ^= hsh >> 13; hsh *= 0x5bd1e995u; hsh ^= hsh >> 15;
    const int row = hsh % NTOK, col = (hsh >> 14) % DM;
    const bf16_t* mr = mix + (size_t)row * 2048; float s1 = 0.f, s2 = 0.f;
    for (int k = 0; k < 1024; ++k) { const float a = bf2f(mr[k]), b = bf2f(mr[1024 + k]); s1 += a * a; s2 += b * b; }
    const float r1 = 1.f / sqrtf(s1 / 1024.f + 1e-6f), r2 = 1.f / sqrtf(s2 / 1024.f + 1e-6f);
    float d = 0.f;
    for (int k = 0; k < 1024; ++k) { d += bf2f(mr[k]) * r1 * p.lru_norm[l * 1024 + k] * p.w_out[((size_t)l * 2048 + k) * DM + col]; d += bf2f(mr[1024 + k]) * r2 * p.ssd_norm[l * 1024 + k] * p.w_out[((size_t)l * 2048 + 1024 + k) * DM + col]; }
    const float* xb = (l == 0) ? p.x : (const float*)(p.ws + WS_MIX2); const float ref = d, got = p.X[(size_t)row * DM + col] - xb[(size_t)row * DM + col];
    atomicAdd(acc + 8, (got - ref) * (got - ref)); atomicAdd(acc + 9, ref * ref);
}

__global__ void __launch_bounds__(256) dbg_chk_moe(Params p, int l) {
    const int tid = threadIdx.x; float* acc = (float*)(p.ws + WS_DBG); const bf16_t* ys = (const bf16_t*)(p.ws + WS_YSLOT);
    unsigned hsh = (unsigned)blockIdx.x * 2654435761u + 4242u; hsh ^= hsh >> 13; hsh *= 0x5bd1e995u; hsh ^= hsh >> 15;
    const int row = hsh % NTOK;
    __shared__ float hs[1024], hid[512], red[256], outv[4]; __shared__ int ex[2]; __shared__ float ew[2];
    float ss = 0.f; for (int k = tid; k < DM; k += 256) { const float v = p.X[(size_t)row * DM + k]; ss += v * v; }
    red[tid] = ss; __syncthreads(); if (tid == 0) { float t = 0.f; for (int i = 0; i < 256; ++i) t += red[i]; red[0] = 1.f / sqrtf(t / DM + 1e-6f); } __syncthreads();
    const float rstd = red[0];
    for (int k = tid; k < DM; k += 256) hs[k] = p.X[(size_t)row * DM + k] * rstd * p.norm_ffn[l * DM + k];
    __syncthreads();
    if (tid == 0) { float cl[4]; for (int q = 0; q < 4; ++q) { float d = p.b_coarse[l * 4 + q]; for (int k = 0; k < DM; ++k) d += hs[k] * p.w_coarse[((size_t)l * DM + k) * 4 + q]; cl[q] = d; }
        int gi = 0; for (int q = 1; q < 4; ++q) if (cl[q] > cl[gi]) gi = q; float den = 0.f; for (int q = 0; q < 4; ++q) den += expf(cl[q] - cl[gi]);
        float fl[8]; for (int q = 0; q < 8; ++q) { float d = p.b_fine[(l * 4 + gi) * 8 + q]; for (int k = 0; k < DM; ++k) d += hs[k] * p.w_fine[(((size_t)l * 4 + gi) * DM + k) * 8 + q]; fl[q] = d; }
        int i0 = 0; for (int q = 1; q < 8; ++q) if (fl[q] > fl[i0]) i0 = q; int i1 = -1; for (int q = 0; q < 8; ++q) if (q != i0 && (i1 < 0 || fl[q] > fl[i1])) i1 = q;
        const float e1 = expf(fl[i1] - fl[i0]); ex[0] = gi * 8 + i0; ex[1] = gi * 8 + i1; ew[0] = (1.f / den) / (1.f + e1); ew[1] = (1.f / den) * e1 / (1.f + e1); }
    __syncthreads();
    if (tid < 4) outv[tid] = 0.f;
    for (int s2 = 0; s2 < 2; ++s2) { const int e = ex[s2]; const float* wg = p.w_gate + ((size_t)l * NEXP + e) * DM * DEXP; const float* wu = p.w_up + ((size_t)l * NEXP + e) * DM * DEXP; const float* wd = p.w_down + ((size_t)l * NEXP + e) * DEXP * DM;
        __syncthreads();
        for (int j = tid; j < DEXP; j += 256) { float g = 0.f, u = 0.f; for (int k = 0; k < DM; ++k) { g += hs[k] * wg[(size_t)k * DEXP + j]; u += hs[k] * wu[(size_t)k * DEXP + j]; } hid[j] = g / (1.f + expf(-g)) * u; }
        __syncthreads();
        if (tid < 4) { const int col = (hsh >> 16) % 256 + tid * 256; float d = 0.f; for (int j = 0; j < DEXP; ++j) d += hid[j] * wd[(size_t)j * DM + col]; outv[tid] += ew[s2] * d; } }
    __syncthreads();
    if (tid < 4) { const int col = (hsh >> 16) % 256 + tid * 256; const float got = bf2f(ys[(size_t)row * DM + col]) + bf2f(ys[((size_t)NTOK + row) * DM + col]); const float ref = outv[tid];
        atomicAdd(acc + 10, (got - ref) * (got - ref)); atomicAdd(acc + 11, ref * ref); }
}

__global__ void dbg_chk_final(Params p) {
    const int sidx = blockIdx.x * blockDim.x + threadIdx.x; float* acc = (float*)(p.ws + WS_DBG); const bf16_t* ys = (const bf16_t*)(p.ws + WS_YSLOT);
    unsigned hsh = (unsigned)sidx * 2654435761u + 99u; hsh ^= hsh >> 13; hsh *= 0x5bd1e995u; hsh ^= hsh >> 15;
    const int row = hsh % NTOK, col = (hsh >> 14) % DM; const float* xb = (const float*)(p.ws + WS_MIX2) + (size_t)row * DM;
    float ss = 0.f; for (int k = 0; k < DM; ++k) { const float v = xb[k] + bf2f(ys[(size_t)row * DM + k]) + bf2f(ys[((size_t)NTOK + row) * DM + k]); ss += v * v; }
    const float v = xb[col] + bf2f(ys[(size_t)row * DM + col]) + bf2f(ys[((size_t)NTOK + row) * DM + col]);
    const float ref = v / sqrtf(ss / DM + 1e-6f) * p.final_norm[col], got = p.X[(size_t)row * DM + col];
    atomicAdd(acc + 12, (got - ref) * (got - ref)); atomicAdd(acc + 13, ref * ref);
}
__global__ void dbg_zero(Params p) { float* acc = (float*)(p.ws + WS_DBG); if (threadIdx.x < 64) acc[threadIdx.x] = 0.f; }
__device__ __forceinline__ int dbg_digit(float num, float den) { const float d = sqrtf(num / fmaxf(den, 1e-30f)); if (!(d == d)) return 0; const float v = -2.f * log10f(fmaxf(d, 1e-10f)); return v < 0.f ? 0 : (v > 8.f ? 8 : (int)v); }
__global__ void dbg_report(Params p) {
    const float* acc = (const float*)(p.ws + WS_DBG);
    const size_t i = (size_t)blockIdx.x * blockDim.x + threadIdx.x;
    if (i < (size_t)NTOK * DM) p.X[i] = 0.f;
    if (i == 0) { const int a = dbg_digit(acc[DBGA], acc[DBGA + 1]), b = dbg_digit(acc[DBGB], acc[DBGB + 1]); p.X[0] = sqrtf((float)NTOK * DM * (9.f + 10.f * a + b)); }
}
#endif
enum { PH_CONVERT = 0, PH_NORM, PH_INPROJ, PH_MIXA, PH_SCAN, PH_MIXB, PH_OUTPROJ, PH_ROUTER, PH_MOEUP, PH_MOEDOWN, PH_FINAL };

template <int PH>
__device__ __forceinline__ void run_phase(const Params& p, int l, LAS unsigned char* lds) {
    if (PH == PH_CONVERT) ph_convert(p, l, lds);
    if (PH == PH_NORM) ph_norm(p, l);
    if (PH == PH_INPROJ) ph_inproj(p, lds);
    if (PH == PH_MIXA) ph_mixA(p, l, lds);
    if (PH == PH_SCAN) ph_scan(p);
    if (PH == PH_MIXB) ph_mixB(p, l, lds);
    if (PH == PH_OUTPROJ) ph_outproj(p, l, lds);
    if (PH == PH_ROUTER) ph_router(p, l);
    if (PH == PH_MOEUP) ph_moe_up(p, lds);
    if (PH == PH_MOEDOWN) ph_moe_down(p, lds);
    if (PH == PH_FINAL) ph_final(p);
}

template <int PH>
__global__ void __launch_bounds__(NTHR) k_phase(Params p, int l) {
    extern __shared__ __attribute__((aligned(16))) unsigned char lds_raw[];
    run_phase<PH>(p, l, (LAS unsigned char*)lds_raw);
}

#if ONE_LAUNCH
__global__ void __launch_bounds__(NTHR) k_mega(Params p) {
    extern __shared__ __attribute__((aligned(16))) unsigned char lds_raw[];
    LAS unsigned char* lds = (LAS unsigned char*)lds_raw;
    cg::grid_group grid = cg::this_grid();
    for (int l = 0; l < DEPTH; ++l) {
        ph_convert(p, l, lds); ph_norm(p, l); grid.sync();
        ph_inproj(p, lds); grid.sync();
        ph_mixA(p, l, lds); grid.sync();
        ph_scan(p); grid.sync();
        ph_mixB(p, l, lds); grid.sync();
        ph_outproj(p, l, lds); grid.sync();
        ph_router(p, l); grid.sync();
        ph_moe_up(p, lds); grid.sync();
        ph_moe_down(p, lds); grid.sync();
    }
    ph_final(p);
}
#endif

template <int PH> static void launch_phase(const Params& p, int l, int grid, hipStream_t stream) {
    static bool attr = false;
    if (!attr) { (void)hipFuncSetAttribute((const void*)k_phase<PH>, hipFuncAttributeMaxDynamicSharedMemorySize, LDS_BYTES); attr = true; }
    hipLaunchKernelGGL(k_phase<PH>, dim3(grid), dim3(NTHR), LDS_BYTES, stream, p, l);
}

extern "C" void kernel_launch(void* const* d_in, const int* in_sizes, int n_in, void* d_out, int out_size, void* d_ws, size_t ws_size, hipStream_t stream) {
    if (n_in != 27 || in_sizes[0] != NTOK * DM || out_size != NTOK * DM || ws_size < WS_END) {
        fprintf(stderr, "kernel_launch: unexpected shapes (n_in %d, in0 %d, out %d, ws %zu)\n", n_in, n_in > 0 ? in_sizes[0] : -1, out_size, ws_size); return; }
    Params p{};
    const float** f = (const float**)&p;
    for (int i = 0; i < 27; ++i) f[i] = (const float*)d_in[i];
    p.X = (float*)d_out; p.ws = (unsigned char*)d_ws;
#if DBG
    { const int G = 256;
      launch_phase<PH_CONVERT>(p, 0, G, stream); launch_phase<PH_NORM>(p, 0, G, stream); launch_phase<PH_INPROJ>(p, 0, G, stream);
      launch_phase<PH_MIXA>(p, 0, G, stream); launch_phase<PH_SCAN>(p, 0, G, stream); launch_phase<PH_MIXB>(p, 0, G, stream);
      launch_phase<PH_OUTPROJ>(p, 0, G, stream);
      launch_phase<PH_ROUTER>(p, 0, G, stream); launch_phase<PH_MOEUP>(p, 0, G, stream); launch_phase<PH_MOEDOWN>(p, 0, G, stream);
      launch_phase<PH_CONVERT>(p, 1, G, stream); launch_phase<PH_NORM>(p, 1, G, stream); launch_phase<PH_INPROJ>(p, 1, G, stream);
      launch_phase<PH_MIXA>(p, 1, G, stream); launch_phase<PH_SCAN>(p, 1, G, stream); launch_phase<PH_MIXB>(p, 1, G, stream);
      launch_phase<PH_OUTPROJ>(p, 1, G, stream);
      launch_phase<PH_ROUTER>(p, 1, G, stream); launch_phase<PH_MOEUP>(p, 1, G, stream); launch_phase<PH_MOEDOWN>(p, 1, G, stream);
      (void)hipMemcpyAsync(p.ws + WS_MIX2, p.X, (size_t)NTOK * DM * 4, hipMemcpyDeviceToDevice, stream);
      launch_phase<PH_FINAL>(p, 0, G, stream);
      hipLaunchKernelGGL(dbg_zero, dim3(1), dim3(64), 0, stream, p);
      hipLaunchKernelGGL(dbg_chk_final, dim3(64), dim3(64), 0, stream, p);
      hipLaunchKernelGGL(dbg_report, dim3(NTOK * DM / 256), dim3(256), 0, stream, p);
      return; }
#endif
#if ONE_LAUNCH
    static int grid = 0;
    if (!grid) { int dev = 0, cus = 0, per_cu = 0; (void)hipGetDevice(&dev); (void)hipDeviceGetAttribute(&cus, hipDeviceAttributeMultiprocessorCount, dev);
        (void)hipFuncSetAttribute((const void*)k_mega, hipFuncAttributeMaxDynamicSharedMemorySize, LDS_BYTES);
        (void)hipOccupancyMaxActiveBlocksPerMultiprocessor(&per_cu, (const void*)k_mega, NTHR, LDS_BYTES);
        if (per_cu < 1) { fprintf(stderr, "kernel_launch: occupancy query says %d blocks/CU\n", per_cu); per_cu = 1; }
        grid = cus * 1; }
    void* args[] = {&p};
    hipError_t e = hipLaunchCooperativeKernel((const void*)k_mega, dim3(grid), dim3(NTHR), args, LDS_BYTES, stream);
    if (e != hipSuccess) fprintf(stderr, "cooperative launch failed: %s (grid %d)\n", hipGetErrorString(e), grid);
#else
    const int G = 256;
    for (int l = 0; l < DEPTH; ++l) {
        launch_phase<PH_CONVERT>(p, l, G, stream);
        launch_phase<PH_NORM>(p, l, G, stream);
        launch_phase<PH_INPROJ>(p, l, G, stream);
        launch_phase<PH_MIXA>(p, l, G, stream);
        launch_phase<PH_SCAN>(p, l, G, stream);
        launch_phase<PH_MIXB>(p, l, G, stream);
        launch_phase<PH_OUTPROJ>(p, l, G, stream);
        launch_phase<PH_ROUTER>(p, l, G, stream);
        launch_phase<PH_MOEUP>(p, l, G, stream);
        launch_phase<PH_MOEDOWN>(p, l, G, stream);
    }
    launch_phase<PH_FINAL>(p, 0, G, stream);
#endif
}
```

```cpp
#include <hip/hip_runtime.h>
#include <hip/hip_cooperative_groups.h>
#include <cstdint>
#include <cstdio>
namespace cg = cooperative_groups;

#ifndef ONE_LAUNCH
#define ONE_LAUNCH 1
#endif

#define LAS __attribute__((address_space(3)))
typedef unsigned short bf16_t;
typedef short bf16x8 __attribute__((ext_vector_type(8)));
typedef float f32x4 __attribute__((ext_vector_type(4)));
typedef unsigned u32x2 __attribute__((ext_vector_type(2)));
typedef unsigned u32x4 __attribute__((ext_vector_type(4)));

constexpr int NB = 2, SEQ = 8192, DM = 1024, NTOK = NB * SEQ, DEPTH = 2;
constexpr int INC = 5136, PROJW = 5120;
constexpr int SSD_CD = 2048;
constexpr int O_LX = 0, O_LG = 1024, O_Z = 2048, O_XS = 3072, O_B = 4096, O_C = 4608;
constexpr int NEXP = 32, DEXP = 512, NCH = 64, CH = 128;
constexpr int NTHR = 512;
constexpr int MAXTILES = 160;
constexpr int LISTCAP = NTOK;

constexpr size_t MiB = 1u << 20;
constexpr size_t WS_CTL = 0;
constexpr size_t WS_WIN = 1 * MiB;
constexpr size_t WS_WOUT = 11 * MiB;
constexpr size_t WS_WGU = 15 * MiB;
constexpr size_t WS_WD = 79 * MiB;
constexpr size_t WS_PROJ = 111 * MiB;
constexpr size_t WS_H = WS_PROJ;
constexpr size_t WS_HID = WS_PROJ + 32 * MiB;
constexpr size_t WS_YSLOT = WS_PROJ + 72 * MiB;
constexpr size_t WS_LTOK = WS_PROJ + 136 * MiB;
constexpr size_t WS_LW = WS_PROJ + 138 * MiB;
constexpr size_t WS_MIX = 271 * MiB;
constexpr size_t WS_XN = WS_MIX;
constexpr size_t WS_STATES = 335 * MiB;
constexpr size_t WS_DTRAW = 399 * MiB;
constexpr size_t WS_ROWSS = 400 * MiB;
constexpr size_t WS_LSUM = 401 * MiB;
constexpr size_t WS_LCARRY = 402 * MiB;
constexpr size_t WS_DECAY = 403 * MiB;
constexpr size_t WS_END = 404 * MiB;

constexpr int LDS_BYTES = 150 * 1024;

struct Params {
    const float *x, *norm_mix, *w_in, *lru_conv_w, *lru_conv_b, *lru_wa, *lru_ba, *lru_wx, *lru_bx, *lru_lambda, *lru_norm,
        *ssd_conv_w, *ssd_conv_b, *ssd_dt_bias, *ssd_a_log, *ssd_d, *ssd_norm, *w_out, *norm_ffn, *w_coarse, *b_coarse, *w_fine, *b_fine,
        *w_gate, *w_up, *w_down, *final_norm;
    float* X;
    unsigned char* ws;
};

__device__ __forceinline__ float bf2f(bf16_t v) { return __uint_as_float((unsigned)v << 16); }
__device__ __forceinline__ unsigned f2bf(float f) { unsigned u = __float_as_uint(f); return (u + 0x7fffu + ((u >> 16) & 1u)) >> 16; }
__device__ __forceinline__ unsigned pk2(float lo, float hi) { return f2bf(lo) | (f2bf(hi) << 16); }
__device__ __forceinline__ float wave_sum(float v) {
#pragma unroll
    for (int o = 1; o < 64; o <<= 1) v += __shfl_xor(v, o);
    return v;
}
__device__ __forceinline__ float sigmoid_f(float x) { return 1.f / (1.f + __expf(-x)); }
__device__ __forceinline__ float silu_f(float x) { return x * sigmoid_f(x); }
__device__ __forceinline__ float softplus_f(float x) { return x > 20.f ? x : log1pf(__expf(x)); }
__device__ __forceinline__ float gelu_tanh_f(float x) { const float u = 0.7978845608028654f * (x + 0.044715f * x * x * x); return 0.5f * x * (1.f + tanhf(u)); }

__device__ __forceinline__ int opaque_tid() { int t = threadIdx.x; asm volatile("" : "+v"(t)); return t; }
#define LDS_WAIT() asm volatile("s_waitcnt lgkmcnt(0)" ::: "memory")
#define VM_WAIT() asm volatile("s_waitcnt vmcnt(0)" ::: "memory")

__device__ __forceinline__ void tr_item(const float* src, int ld, int k0, int c0, bf16_t* dst, int ldd, int r0, const float* kscale, LAS float* scr, int lane) {
#pragma unroll 8
    for (int i = 0; i < 32; ++i) {
        const int kk = 2 * i + (lane >> 5), nn = lane & 31;
        float v = src[(size_t)(k0 + kk) * ld + c0 + nn];
        if (kscale) v *= kscale[k0 + kk];
        scr[kk * 33 + nn] = v;
    }
    LDS_WAIT();
    const int c = lane & 7;
#pragma unroll
    for (int j = 0; j < 4; ++j) {
        const int n = (lane >> 3) + 8 * j; const LAS float* s = scr + (8 * c) * 33 + n;
        u32x4 o; o.x = pk2(s[0 * 33], s[1 * 33]); o.y = pk2(s[2 * 33], s[3 * 33]); o.z = pk2(s[4 * 33], s[5 * 33]); o.w = pk2(s[6 * 33], s[7 * 33]);
        *(u32x4*)(dst + (size_t)(r0 + n) * ldd + k0 + 8 * c) = o;
    }
    LDS_WAIT();
}

__device__ __forceinline__ void ph_convert(const Params& p, int l, LAS unsigned char* lds) {
    const int tid = opaque_tid(), lane = tid & 63, wave = tid >> 6;
    LAS float* scr = (LAS float*)(lds + wave * 16384);
    const int gw = blockIdx.x * 8 + wave, NGW = gridDim.x * 8;
    bf16_t* WinT = (bf16_t*)(p.ws + WS_WIN); bf16_t* WoutT = (bf16_t*)(p.ws + WS_WOUT); bf16_t* WguT = (bf16_t*)(p.ws + WS_WGU); bf16_t* WdT = (bf16_t*)(p.ws + WS_WD);
    constexpr int I_IN = 16 * 160, I_OUT = 32 * 32, I_GU = 32 * 512, I_D = 32 * 256;
    for (int it = gw; it < I_IN + I_OUT + I_GU + I_D; it += NGW) {
        int r = it;
        if (r < I_IN) { const int kb = r / 160, nb = r % 160; tr_item(p.w_in + (size_t)l * DM * INC, INC, kb * 64, nb * 32, WinT, DM, nb * 32, nullptr, scr, lane); continue; }
        r -= I_IN;
        if (r < I_OUT) { const int kb = r / 32, nb = r % 32; const int k0 = kb * 64;
            const float* ks = (k0 < 1024) ? (p.lru_norm + l * 1024) : (p.ssd_norm + l * 1024 - 1024);
            tr_item(p.w_out + (size_t)l * 2048 * DM, DM, k0, nb * 32, WoutT, 2048, nb * 32, ks, scr, lane); continue; }
        r -= I_OUT;
        if (r < I_GU) { const int e = r / 512, q = r % 512, kb = q / 32, rb = q % 32, pn = rb >> 3, jb = rb & 7;
            const float* src = (jb < 4 ? p.w_gate : p.w_up) + ((size_t)l * NEXP + e) * DM * DEXP;
            const int c0 = 128 * pn + 32 * (jb & 3);
            tr_item(src, DEXP, kb * 64, c0, WguT + (size_t)e * 1024 * 1024, DM, rb * 32, nullptr, scr, lane); continue; }
        r -= I_GU;
        { const int e = r / 256, q = r % 256, kb = q / 32, nb = q % 32;
            tr_item(p.w_down + ((size_t)l * NEXP + e) * DEXP * DM, DM, kb * 64, nb * 32, WdT + (size_t)e * 1024 * 512, DEXP, nb * 32, nullptr, scr, lane); }
    }
}

__device__ __forceinline__ void ph_norm(const Params& p, int l) {
    const int tid = opaque_tid(), lane = tid & 63, wave = tid >> 6;
    const int gw = blockIdx.x * 8 + wave, NGW = gridDim.x * 8;
    bf16_t* xn = (bf16_t*)(p.ws + WS_XN); float* dtraw = (float*)(p.ws + WS_DTRAW);
    const bf16_t* ys = (const bf16_t*)(p.ws + WS_YSLOT);
    const float* nw = p.norm_mix + l * DM;
    const float* wdt = p.w_in + (size_t)l * DM * INC + PROJW;
    if (blockIdx.x == 0 && tid < 64) ((int*)(p.ws + WS_CTL))[tid] = 0;
    for (int row = gw; row < NTOK; row += NGW) {
        f32x4 v[4];
        const float* src = (l == 0 ? p.x : p.X) + (size_t)row * DM;
#pragma unroll
        for (int j = 0; j < 4; ++j) v[j] = *(const f32x4*)(src + j * 256 + lane * 4);
        if (l > 0) {
#pragma unroll
            for (int s = 0; s < 2; ++s)
#pragma unroll
                for (int j = 0; j < 4; ++j) { const u32x2 y = *(const u32x2*)(ys + ((size_t)s * NTOK + row) * DM + j * 256 + lane * 4);
                    v[j].x += __uint_as_float(y.x << 16); v[j].y += __uint_as_float(y.x & 0xffff0000u); v[j].z += __uint_as_float(y.y << 16); v[j].w += __uint_as_float(y.y & 0xffff0000u); }
#pragma unroll
            for (int j = 0; j < 4; ++j) *(f32x4*)(p.X + (size_t)row * DM + j * 256 + lane * 4) = v[j];
        }
        float ss = 0.f;
#pragma unroll
        for (int j = 0; j < 4; ++j) ss += (v[j].x * v[j].x + v[j].y * v[j].y) + (v[j].z * v[j].z + v[j].w * v[j].w);
        const float rstd = rsqrtf(wave_sum(ss) * (1.f / DM) + 1e-6f);
#pragma unroll
        for (int j = 0; j < 4; ++j) { const f32x4 w = *(const f32x4*)(nw + j * 256 + lane * 4); v[j] = v[j] * rstd * w;
            u32x2 o; o.x = pk2(v[j].x, v[j].y); o.y = pk2(v[j].z, v[j].w); *(u32x2*)(xn + (size_t)row * DM + j * 256 + lane * 4) = o; }
        float dacc[16];
#pragma unroll
        for (int h = 0; h < 16; ++h) dacc[h] = 0.f;
#pragma unroll
        for (int j = 0; j < 4; ++j)
#pragma unroll
            for (int e = 0; e < 4; ++e) { const int k = j * 256 + lane * 4 + e; const float xv = v[j][e];
#pragma unroll
                for (int q = 0; q < 4; ++q) { const f32x4 w = *(const f32x4*)(wdt + (size_t)k * INC + q * 4);
                    dacc[q * 4 + 0] += xv * w.x; dacc[q * 4 + 1] += xv * w.y; dacc[q * 4 + 2] += xv * w.z; dacc[q * 4 + 3] += xv * w.w; } }
        float mine = 0.f;
#pragma unroll
        for (int h = 0; h < 16; ++h) { const float s = wave_sum(dacc[h]); if (lane == h) mine = s; }
        if (lane < 16) dtraw[(size_t)row * 16 + lane] = mine;
    }
}

constexpr int SG_A = 0, SG_B = 16384;
template <class ARow, class Epi>
__device__ __forceinline__ void sgemm_tile(LAS unsigned char* lds, const ARow& arow, const bf16_t* Bt, int ldb, int K, const Epi& epi) {
    const int tid = opaque_tid(), wid = __builtin_amdgcn_readfirstlane(tid >> 6), lane = tid & 63, wr = wid >> 2, wc = wid & 3, fr = lane & 15, fq = lane >> 4;
    const bf16_t* ap[2]; const bf16_t* bp[2];
#pragma unroll
    for (int i = 0; i < 2; ++i) { const int pc = tid + i * 512, row = pc >> 2, ch = pc & 3; ap[i] = arow(row) + ch * 8; bp[i] = Bt + (size_t)row * ldb + ch * 8; }
    f32x4 acc[8][2][2];
#pragma unroll
    for (int m = 0; m < 8; ++m)
#pragma unroll
        for (int bj = 0; bj < 2; ++bj)
#pragma unroll
            for (int n = 0; n < 2; ++n) acc[m][bj][n] = (f32x4){0.f, 0.f, 0.f, 0.f};
    const int nkt = K / 32;
    for (int kt = 0; kt < nkt; ++kt) {
#pragma unroll
        for (int i = 0; i < 2; ++i) {
            __builtin_amdgcn_global_load_lds((const unsigned*)(ap[i] + kt * 32), (LAS unsigned*)(lds + SG_A + wid * 1024 + i * 8192), 16, 0, 0);
            __builtin_amdgcn_global_load_lds((const unsigned*)(bp[i] + kt * 32), (LAS unsigned*)(lds + SG_B + wid * 1024 + i * 8192), 16, 0, 0);
        }
        VM_WAIT(); __syncthreads();
        bf16x8 af[8], bfr[2][2];
#pragma unroll
        for (int m = 0; m < 8; ++m) af[m] = *(const LAS bf16x8*)(lds + SG_A + (wr * 128 + m * 16 + fr) * 64 + fq * 16);
#pragma unroll
        for (int bj = 0; bj < 2; ++bj)
#pragma unroll
            for (int n = 0; n < 2; ++n) bfr[bj][n] = *(const LAS bf16x8*)(lds + SG_B + (bj * 128 + wc * 32 + n * 16 + fr) * 64 + fq * 16);
#pragma unroll
        for (int m = 0; m < 8; ++m)
#pragma unroll
            for (int bj = 0; bj < 2; ++bj)
#pragma unroll
                for (int n = 0; n < 2; ++n) acc[m][bj][n] = __builtin_amdgcn_mfma_f32_16x16x32_bf16(af[m], bfr[bj][n], acc[m][bj][n], 0, 0, 0);
        __syncthreads();
    }
#pragma unroll
    for (int m = 0; m < 8; ++m)
#pragma unroll
        for (int n = 0; n < 2; ++n)
#pragma unroll
            for (int j = 0; j < 4; ++j) epi(wr * 128 + m * 16 + fq * 4 + j, wc * 32 + n * 16 + fr, acc[m][0][n][j], acc[m][1][n][j]);
}
struct ARowPlain { const bf16_t* base; int ld; __device__ __forceinline__ const bf16_t* operator()(int r) const { return base + (size_t)r * ld; } };

struct EpiProj { bf16_t* out; __device__ __forceinline__ void operator()(int r, int c, float v0, float v1) const { out[(size_t)r * PROJW + c] = (bf16_t)f2bf(v0); out[(size_t)r * PROJW + 128 + c] = (bf16_t)f2bf(v1); } };
__device__ __forceinline__ void ph_inproj(const Params& p, LAS unsigned char* lds) {
    const bf16_t* xn = (const bf16_t*)(p.ws + WS_XN); const bf16_t* WinT = (const bf16_t*)(p.ws + WS_WIN); bf16_t* proj = (bf16_t*)(p.ws + WS_PROJ);
    for (int u = blockIdx.x; u < 64 * 20; u += gridDim.x) { const int pm = u / 20, pn = u % 20;
        sgemm_tile(lds, ARowPlain{xn + (size_t)pm * 256 * DM, DM}, WinT + (size_t)pn * 256 * DM, DM, DM, EpiProj{proj + (size_t)pm * 256 * PROJW + pn * 256}); }
}

__device__ __forceinline__ void row_rstd(const float* rowss, int row, float& rl, float& rs) {
    const f32x4 a = *(const f32x4*)(rowss + (size_t)row * 8), b = *(const f32x4*)(rowss + (size_t)row * 8 + 4);
    rl = rsqrtf(((a.x + a.y) + (a.z + a.w)) * (1.f / 1024.f) + 1e-6f); rs = rsqrtf(((b.x + b.y) + (b.z + b.w)) * (1.f / 1024.f) + 1e-6f);
}
struct EpiOut { const float* resid; float* out; const float* rowss; int row0; int half;
    __device__ __forceinline__ void operator()(int r, int c, float v0, float v1) const { float rl, rs; row_rstd(rowss, row0 + r, rl, rs); const float sc = half ? rs : rl;
        out[(size_t)r * DM + c] = resid[(size_t)r * DM + c] + sc * v0; out[(size_t)r * DM + 128 + c] = resid[(size_t)r * DM + 128 + c] + sc * v1; } };
__device__ __forceinline__ void ph_outproj(const Params& p, int l, LAS unsigned char* lds) {
    const bf16_t* mix = (const bf16_t*)(p.ws + WS_MIX); const bf16_t* WoutT = (const bf16_t*)(p.ws + WS_WOUT); const float* rowss = (const float*)(p.ws + WS_ROWSS);
    const float* resid = (l == 0) ? p.x : p.X;
    for (int u = blockIdx.x; u < 64 * 4; u += gridDim.x) { const int pm = u / 4, pn = u % 4; const size_t o = (size_t)pm * 256 * DM + pn * 256;
        sgemm_tile(lds, ARowPlain{mix + (size_t)pm * 256 * 2048, 2048}, WoutT + (size_t)pn * 256 * 2048, 2048, 1024, EpiOut{resid + o, p.X + o, rowss, pm * 256, 0});
        sgemm_tile(lds, ARowPlain{mix + (size_t)pm * 256 * 2048 + 1024, 2048}, WoutT + (size_t)pn * 256 * 2048 + 1024, 2048, 1024, EpiOut{p.X + o, p.X + o, rowss, pm * 256, 1}); }
}

__device__ __forceinline__ float conv4(const bf16_t* proj, int R0, int t0, int l, int col, const float* cw, int cwld, float cb) {
    float acc = cb;
#pragma unroll
    for (int k = 0; k < 4; ++k) { const int tt = t0 + l - 3 + k; if (tt >= 0) acc += cw[k * cwld] * bf2f(proj[(size_t)(R0 + l - 3 + k) * PROJW + col]); }
    return acc;
}

__device__ __forceinline__ void lru_head_av(const Params& p, int l_, const bf16_t* proj, int R0, int t0, int h, LAS float* ub, LAS float* was, LAS float* wxs, LAS float* av, LAS float* vv) {
    const int tid = opaque_tid();
    const float* cw = p.lru_conv_w + (size_t)l_ * 4 * 1024; const float* cb = p.lru_conv_b + l_ * 1024;
    for (int i = tid; i < 64 * 64; i += NTHR) { was[i] = p.lru_wa[((size_t)l_ * 16 + h) * 4096 + i]; wxs[i] = p.lru_wx[((size_t)l_ * 16 + h) * 4096 + i]; }
    for (int i = tid; i < 128 * 64; i += NTHR) { const int l = i >> 6, j = i & 63, col = h * 64 + j; ub[i] = conv4(proj, R0, t0, l, O_LX + col, cw + col, 1024, cb[col]); }
    __syncthreads();
    { const int l = tid >> 2, jb = (tid & 3) * 16;
        float ra[16], ia[16];
#pragma unroll
        for (int q = 0; q < 16; ++q) { ra[q] = 0.f; ia[q] = 0.f; }
        for (int i = 0; i < 64; ++i) { const float uv = ub[l * 64 + i];
#pragma unroll
            for (int q = 0; q < 16; ++q) { ra[q] += uv * was[i * 64 + jb + q]; ia[q] += uv * wxs[i * 64 + jb + q]; } }
#pragma unroll
        for (int q = 0; q < 16; ++q) { const int j = jb + q, col = h * 64 + j;
            const float r = sigmoid_f(ra[q] + p.lru_ba[l_ * 1024 + col]), ig = sigmoid_f(ia[q] + p.lru_bx[l_ * 1024 + col]);
            const float lam = p.lru_lambda[l_ * 1024 + col];
            const float log_a = 8.f * r * (-softplus_f(-lam));
            const float a = __expf(log_a); const float mult = sqrtf(fmaxf(0.f, -expm1f(2.f * log_a)));
            av[l * 64 + j] = a; vv[l * 64 + j] = mult * (ig * ub[l * 64 + j]); }
    }
    __syncthreads();
}

__device__ __forceinline__ void ssd_dt(const Params& p, int l_, int R0, int g, LAS float* dtv, LAS float* acs) {
    const int tid = opaque_tid(); const float* dtraw = (const float*)(p.ws + WS_DTRAW);
    if (tid < 4) { const int h = 4 * g + tid; const float bias = p.ssd_dt_bias[l_ * 16 + h], A = -__expf(p.ssd_a_log[l_ * 16 + h]); float cum = 0.f;
        for (int l = 0; l < 128; ++l) { const float dt = softplus_f(dtraw[(size_t)(R0 + l) * 16 + h] + bias); cum += dt * A; dtv[tid * 128 + l] = dt; acs[tid * 128 + l] = cum; } }
}

__device__ __forceinline__ void ph_mixA(const Params& p, int l_, LAS unsigned char* lds) {
    const int tid = opaque_tid();
    const bf16_t* proj = (const bf16_t*)(p.ws + WS_PROJ);
    float* states = (float*)(p.ws + WS_STATES); float* decay = (float*)(p.ws + WS_DECAY); float* lsum = (float*)(p.ws + WS_LSUM);
    LAS float* xh = (LAS float*)(lds);
    LAS float* Bc = (LAS float*)(lds + 32768);
    LAS float* dtv = (LAS float*)(lds + 98304);
    LAS float* acs = (LAS float*)(lds + 100352);
    LAS float* was = (LAS float*)(lds + 102400);
    LAS float* wxs = (LAS float*)(lds + 118784);
    const float* cw = p.ssd_conv_w + (size_t)l_ * 4 * SSD_CD; const float* cb = p.ssd_conv_b + l_ * SSD_CD;
    for (int u = blockIdx.x; u < NB * NCH * 4; u += gridDim.x) {
        const int g = u & 3, c = (u >> 2) & 63, b = u >> 8; const int t0 = c * CH, R0 = b * SEQ + t0;
        for (int i = tid; i < 128 * 128; i += NTHR) { const int l = i >> 7, n = i & 127, cc = 1024 + g * 128 + n;
            Bc[i] = silu_f(conv4(proj, R0, t0, l, O_XS + cc, cw + cc, SSD_CD, cb[cc])); }
        ssd_dt(p, l_, R0, g, dtv, acs);
        __syncthreads();
        for (int hh = 0; hh < 4; ++hh) { const int h = 4 * g + hh;
            const float alast = acs[hh * 128 + 127];
            for (int i = tid; i < 128 * 64; i += NTHR) { const int l = i >> 6, pp = i & 63, cc = h * 64 + pp;
                xh[i] = silu_f(conv4(proj, R0, t0, l, O_XS + cc, cw + cc, SSD_CD, cb[cc])) * dtv[hh * 128 + l] * __expf(alast - acs[hh * 128 + l]); }
            __syncthreads();
            { const int pp = tid >> 3, nb = (tid & 7) * 16; float a16[16];
#pragma unroll
                for (int q = 0; q < 16; ++q) a16[q] = 0.f;
                for (int l = 0; l < 128; ++l) { const float xv = xh[l * 64 + pp];
#pragma unroll
                    for (int q = 0; q < 16; ++q) a16[q] += xv * Bc[l * 128 + nb + q]; }
                float* st = states + ((size_t)((b * NCH + c) * 16 + h)) * 8192 + pp * 128 + nb;
#pragma unroll
                for (int q = 0; q < 16; q += 4) *(f32x4*)(st + q) = (f32x4){a16[q], a16[q + 1], a16[q + 2], a16[q + 3]};
                if (tid == 0) decay[(b * NCH + c) * 16 + h] = __expf(alast);
            }
            __syncthreads();
        }
        LAS float* av = Bc; LAS float* vv = Bc + 128 * 64;
        for (int hh = 0; hh < 4; ++hh) { const int h = 4 * g + hh;
            lru_head_av(p, l_, proj, R0, t0, h, xh, was, wxs, av, vv);
            if (tid < 64) { float P = 1.f, hc = 0.f;
                for (int l = 0; l < 128; ++l) { const float a = av[l * 64 + tid]; hc = a * hc + vv[l * 64 + tid]; P *= a; }
                float* o = lsum + ((size_t)(b * NCH + c) * 1024 + h * 64 + tid) * 2; o[0] = P; o[1] = hc; }
            __syncthreads();
        }
    }
}

__device__ __forceinline__ void ph_scan(const Params& p) {
    float* states = (float*)(p.ws + WS_STATES); const float* decay = (const float*)(p.ws + WS_DECAY);
    const float* lsum = (const float*)(p.ws + WS_LSUM); float* lcarry = (float*)(p.ws + WS_LCARRY);
    const int gt = blockIdx.x * NTHR + opaque_tid(), NGT = gridDim.x * NTHR;
    for (int e = gt; e < NB * 16 * 8192 / 4; e += NGT) {
        const int q = e & 2047, h = (e >> 11) & 15, b = e >> 15;
        f32x4 r = (f32x4){0.f, 0.f, 0.f, 0.f};
        for (int c = 0; c < NCH; ++c) { f32x4* sp = (f32x4*)(states + ((size_t)((b * NCH + c) * 16 + h)) * 8192) + q; const f32x4 t = *sp; *sp = r; r = r * decay[(b * NCH + c) * 16 + h] + t; }
    }
    for (int e = gt; e < NB * 1024; e += NGT) { const int ch = e & 1023, b = e >> 10; float r = 0.f;
        for (int c = 0; c < NCH; ++c) { const size_t i = (size_t)(b * NCH + c) * 1024 + ch; lcarry[i] = r; r = lsum[i * 2] * r + lsum[i * 2 + 1]; } }
}

__device__ __forceinline__ void ph_mixB(const Params& p, int l_, LAS unsigned char* lds) {
    const int tid = opaque_tid();
    const bf16_t* proj = (const bf16_t*)(p.ws + WS_PROJ); bf16_t* mix = (bf16_t*)(p.ws + WS_MIX); float* rowss = (float*)(p.ws + WS_ROWSS);
    const float* states = (const float*)(p.ws + WS_STATES); const float* lcarry = (const float*)(p.ws + WS_LCARRY);
    LAS bf16_t* Bc = (LAS bf16_t*)(lds);
    LAS bf16_t* Cc = (LAS bf16_t*)(lds + 32768);
    LAS bf16_t* Sc = (LAS bf16_t*)(lds + 65536);
    LAS float* xh = (LAS float*)(lds + 98304);
    LAS bf16_t* pv = (LAS bf16_t*)(lds + 131072);
    LAS float* dtv = (LAS float*)(lds + 147456);
    LAS float* acs = (LAS float*)(lds + 149504);
    LAS float* was = (LAS float*)(lds); LAS float* wxs = (LAS float*)(lds + 16384); LAS float* av = (LAS float*)(lds + 32768); LAS float* vv = (LAS float*)(lds + 65536);
    const float* cw = p.ssd_conv_w + (size_t)l_ * 4 * SSD_CD; const float* cb = p.ssd_conv_b + l_ * SSD_CD;
    for (int u = blockIdx.x; u < NB * NCH * 4; u += gridDim.x) {
        const int g = u & 3, c = (u >> 2) & 63, b = u >> 8; const int t0 = c * CH, R0 = b * SEQ + t0;
        for (int i = tid; i < 128 * 128; i += NTHR) { const int l = i >> 7, n = i & 127, cb_ = 1024 + g * 128 + n, cc_ = 1536 + g * 128 + n;
            Bc[i] = (bf16_t)f2bf(silu_f(conv4(proj, R0, t0, l, O_XS + cb_, cw + cb_, SSD_CD, cb[cb_])));
            Cc[i] = (bf16_t)f2bf(silu_f(conv4(proj, R0, t0, l, O_XS + cc_, cw + cc_, SSD_CD, cb[cc_]))); }
        ssd_dt(p, l_, R0, g, dtv, acs);
        __syncthreads();
        { const int l = tid >> 2, sb = (tid & 3) * 32;
            for (int s = sb; s < sb + 32; ++s) { float d = 0.f;
                if (s <= l) { for (int n = 0; n < 128; ++n) d += bf2f(Cc[l * 128 + n]) * bf2f(Bc[s * 128 + n]); }
                Sc[l * 128 + s] = (bf16_t)f2bf(d); } }
        __syncthreads();
        float ssq = 0.f;
        for (int hh = 0; hh < 4; ++hh) { const int h = 4 * g + hh;
            for (int i = tid; i < 128 * 64; i += NTHR) { const int l = i >> 6, pp = i & 63, cc = h * 64 + pp; xh[i] = silu_f(conv4(proj, R0, t0, l, O_XS + cc, cw + cc, SSD_CD, cb[cc])); }
            { const float* st = states + ((size_t)((b * NCH + c) * 16 + h)) * 8192; for (int i = tid; i < 8192; i += NTHR) pv[i] = (bf16_t)f2bf(st[i]); }
            __syncthreads();
            { const int l = tid >> 2, pb = (tid & 3) * 16; float yd[16], yo[16];
#pragma unroll
                for (int q = 0; q < 16; ++q) { yd[q] = 0.f; yo[q] = 0.f; }
                const float al = acs[hh * 128 + l];
                for (int s = 0; s <= l; ++s) { const float w = bf2f(Sc[l * 128 + s]) * __expf(al - acs[hh * 128 + s]) * dtv[hh * 128 + s];
#pragma unroll
                    for (int q = 0; q < 16; ++q) yd[q] += w * xh[s * 64 + pb + q]; }
                for (int n = 0; n < 128; ++n) { const float cv = bf2f(Cc[l * 128 + n]);
#pragma unroll
                    for (int q = 0; q < 16; ++q) yo[q] += cv * bf2f(pv[(pb + q) * 128 + n]); }
                const float eal = __expf(al), Dh = p.ssd_d[l_ * 16 + h];
#pragma unroll
                for (int q = 0; q < 16; ++q) { const int pp = pb + q;
                    float y = yd[q] + eal * yo[q] + Dh * xh[l * 64 + pp];
                    const float z = bf2f(proj[(size_t)(R0 + l) * PROJW + O_Z + h * 64 + pp]);
                    y *= silu_f(z); ssq += y * y;
                    mix[(size_t)(R0 + l) * 2048 + 1024 + h * 64 + pp] = (bf16_t)f2bf(y); }
            }
            __syncthreads();
        }
        ssq += __shfl_xor(ssq, 1); ssq += __shfl_xor(ssq, 2);
        if ((tid & 3) == 0) rowss[(size_t)(R0 + (tid >> 2)) * 8 + 4 + g] = ssq;
        float lsq = 0.f;
        for (int hh = 0; hh < 4; ++hh) { const int h = 4 * g + hh;
            lru_head_av(p, l_, proj, R0, t0, h, xh, was, wxs, av, vv);
            if (tid < 64) { float hc = lcarry[(size_t)(b * NCH + c) * 1024 + h * 64 + tid];
                for (int l = 0; l < 128; ++l) { hc = av[l * 64 + tid] * hc + vv[l * 64 + tid]; vv[l * 64 + tid] = hc; } }
            __syncthreads();
            { const int l = tid >> 2, jb = (tid & 3) * 16;
#pragma unroll
                for (int q = 0; q < 16; ++q) { const int j = jb + q; const float gt = bf2f(proj[(size_t)(R0 + l) * PROJW + O_LG + h * 64 + j]);
                    const float y = gelu_tanh_f(gt) * vv[l * 64 + j]; lsq += y * y; mix[(size_t)(R0 + l) * 2048 + h * 64 + j] = (bf16_t)f2bf(y); } }
            __syncthreads();
        }
        lsq += __shfl_xor(lsq, 1); lsq += __shfl_xor(lsq, 2);
        if ((tid & 3) == 0) rowss[(size_t)(R0 + (tid >> 2)) * 8 + g] = lsq;
        __syncthreads();
    }
}

__device__ __forceinline__ void ph_router(const Params& p, int l) {
    const int tid = opaque_tid(), lane = tid & 63, wave = tid >> 6;
    const int gw = blockIdx.x * 8 + wave, NGW = gridDim.x * 8;
    bf16_t* hb = (bf16_t*)(p.ws + WS_H); int* cnt = (int*)(p.ws + WS_CTL); int* ltok = (int*)(p.ws + WS_LTOK); float* lw = (float*)(p.ws + WS_LW);
    const float* nw = p.norm_ffn + l * DM; const float* wc = p.w_coarse + (size_t)l * DM * 4; const float* wf = p.w_fine + (size_t)l * 4 * DM * 8;
    for (int row = gw; row < NTOK; row += NGW) {
        f32x4 v[4]; float ss = 0.f;
#pragma unroll
        for (int j = 0; j < 4; ++j) { v[j] = *(const f32x4*)(p.X + (size_t)row * DM + j * 256 + lane * 4); ss += (v[j].x * v[j].x + v[j].y * v[j].y) + (v[j].z * v[j].z + v[j].w * v[j].w); }
        const float rstd = rsqrtf(wave_sum(ss) * (1.f / DM) + 1e-6f);
        float cl[4] = {0.f, 0.f, 0.f, 0.f};
#pragma unroll
        for (int j = 0; j < 4; ++j) { const f32x4 w = *(const f32x4*)(nw + j * 256 + lane * 4); v[j] = v[j] * rstd * w;
            u32x2 o; o.x = pk2(v[j].x, v[j].y); o.y = pk2(v[j].z, v[j].w); *(u32x2*)(hb + (size_t)row * DM + j * 256 + lane * 4) = o;
#pragma unroll
            for (int e = 0; e < 4; ++e) { const f32x4 c4 = *(const f32x4*)(wc + (size_t)(j * 256 + lane * 4 + e) * 4); const float xv = v[j][e];
                cl[0] += xv * c4.x; cl[1] += xv * c4.y; cl[2] += xv * c4.z; cl[3] += xv * c4.w; } }
#pragma unroll
        for (int q = 0; q < 4; ++q) cl[q] = wave_sum(cl[q]) + p.b_coarse[l * 4 + q];
        int gi = 0; float cm = cl[0];
#pragma unroll
        for (int q = 1; q < 4; ++q) if (cl[q] > cm) { cm = cl[q]; gi = q; }
        float den = 0.f;
#pragma unroll
        for (int q = 0; q < 4; ++q) den += __expf(cl[q] - cm);
        const float gwt = 1.f / den;
        float fl[8];
#pragma unroll
        for (int q = 0; q < 8; ++q) fl[q] = 0.f;
        const float* wfg = wf + (size_t)gi * DM * 8;
#pragma unroll
        for (int j = 0; j < 4; ++j)
#pragma unroll
            for (int e = 0; e < 4; ++e) { const float* wp = wfg + (size_t)(j * 256 + lane * 4 + e) * 8; const f32x4 a = *(const f32x4*)wp, b2 = *(const f32x4*)(wp + 4); const float xv = v[j][e];
                fl[0] += xv * a.x; fl[1] += xv * a.y; fl[2] += xv * a.z; fl[3] += xv * a.w; fl[4] += xv * b2.x; fl[5] += xv * b2.y; fl[6] += xv * b2.z; fl[7] += xv * b2.w; }
#pragma unroll
        for (int q = 0; q < 8; ++q) fl[q] = wave_sum(fl[q]) + p.b_fine[(l * 4 + gi) * 8 + q];
        int i0 = 0; float v0 = fl[0];
#pragma unroll
        for (int q = 1; q < 8; ++q) if (fl[q] > v0) { v0 = fl[q]; i0 = q; }
        int i1 = -1; float v1 = -3.0e38f;
#pragma unroll
        for (int q = 0; q < 8; ++q) if (q != i0 && fl[q] > v1) { v1 = fl[q]; i1 = q; }
        const float e1 = __expf(v1 - v0), w0 = gwt / (1.f + e1), w1 = gwt * e1 / (1.f + e1);
        if (lane == 0) {
            const int ex0 = gi * 8 + i0, ex1 = gi * 8 + i1;
            const int p0 = atomicAdd(cnt + ex0, 1); ltok[(size_t)ex0 * LISTCAP + p0] = row * 2 + 0; lw[(size_t)ex0 * LISTCAP + p0] = w0;
            const int p1 = atomicAdd(cnt + ex1, 1); ltok[(size_t)ex1 * LISTCAP + p1] = row * 2 + 1; lw[(size_t)ex1 * LISTCAP + p1] = w1;
        }
    }
}

__device__ __forceinline__ int moe_tiles(const Params& p, LAS int* tb) {
    const int* cnt = (const int*)(p.ws + WS_CTL);
    __syncthreads();
    if (opaque_tid() == 0) { int s = 0; for (int e = 0; e < NEXP; ++e) { tb[e] = s; s += (cnt[e] + 255) >> 8; } tb[NEXP] = s; }
    __syncthreads();
    return tb[NEXP];
}
struct ARowGather { const bf16_t* h; const int* ltok; int pos0, n; __device__ __forceinline__ const bf16_t* operator()(int r) const { const int ps = pos0 + r; const int tok = (ps < n) ? (ltok[ps] >> 1) : 0; return h + (size_t)tok * DM; } };
struct EpiUp { bf16_t* hid; __device__ __forceinline__ void operator()(int r, int c, float v0, float v1) const { hid[(size_t)r * DEXP + c] = (bf16_t)f2bf(silu_f(v0) * v1); } };
__device__ __forceinline__ void ph_moe_up(const Params& p, LAS unsigned char* lds) {
    LAS int* tb = (LAS int*)(lds + 40960);
    const int nt = moe_tiles(p, tb);
    const int* cnt = (const int*)(p.ws + WS_CTL); const int* ltok = (const int*)(p.ws + WS_LTOK);
    const bf16_t* hb = (const bf16_t*)(p.ws + WS_H); const bf16_t* WguT = (const bf16_t*)(p.ws + WS_WGU); bf16_t* hid = (bf16_t*)(p.ws + WS_HID);
    for (int u = blockIdx.x; u < nt * 4; u += gridDim.x) { const int t = u >> 2, pn = u & 3; int e = 0; while (tb[e + 1] <= t) ++e;
        const int pos0 = (t - tb[e]) * 256;
        sgemm_tile(lds, ARowGather{hb, ltok + (size_t)e * LISTCAP, pos0, cnt[e]}, WguT + ((size_t)e * 1024 + pn * 256) * DM, DM, DM, EpiUp{hid + (size_t)t * 256 * DEXP + pn * 128}); }
}
struct EpiDown { bf16_t* ys; const int* ltok; const float* lw; int pos0, n, col0;
    __device__ __forceinline__ void operator()(int r, int c, float v0, float v1) const { const int ps = pos0 + r; if (ps < n) { const int tk = ltok[ps]; const float w = lw[ps];
        bf16_t* o = ys + ((size_t)(tk & 1) * NTOK + (tk >> 1)) * DM + col0; o[c] = (bf16_t)f2bf(w * v0); o[128 + c] = (bf16_t)f2bf(w * v1); } } };
__device__ __forceinline__ void ph_moe_down(const Params& p, LAS unsigned char* lds) {
    LAS int* tb = (LAS int*)(lds + 40960);
    const int nt = moe_tiles(p, tb);
    const int* cnt = (const int*)(p.ws + WS_CTL); const int* ltok = (const int*)(p.ws + WS_LTOK); const float* lw = (const float*)(p.ws + WS_LW);
    const bf16_t* hid = (const bf16_t*)(p.ws + WS_HID); const bf16_t* WdT = (const bf16_t*)(p.ws + WS_WD); bf16_t* ys = (bf16_t*)(p.ws + WS_YSLOT);
    for (int u = blockIdx.x; u < nt * 4; u += gridDim.x) { const int t = u >> 2, pn = u & 3; int e = 0; while (tb[e + 1] <= t) ++e;
        const int pos0 = (t - tb[e]) * 256;
        sgemm_tile(lds, ARowPlain{hid + (size_t)t * 256 * DEXP, DEXP}, WdT + ((size_t)e * 1024 + pn * 256) * DEXP, DEXP, DEXP,
                   EpiDown{ys, ltok + (size_t)e * LISTCAP, lw + (size_t)e * LISTCAP, pos0, cnt[e], pn * 256}); }
}

__device__ __forceinline__ void ph_final(const Params& p) {
    const int tid = opaque_tid(), lane = tid & 63, wave = tid >> 6;
    const int gw = blockIdx.x * 8 + wave, NGW = gridDim.x * 8;
    const bf16_t* ys = (const bf16_t*)(p.ws + WS_YSLOT);
    for (int row = gw; row < NTOK; row += NGW) {
        f32x4 v[4];
#pragma unroll
        for (int j = 0; j < 4; ++j) v[j] = *(const f32x4*)(p.X + (size_t)row * DM + j * 256 + lane * 4);
#pragma unroll
        for (int s = 0; s < 2; ++s)
#pragma unroll
            for (int j = 0; j < 4; ++j) { const u32x2 y = *(const u32x2*)(ys + ((size_t)s * NTOK + row) * DM + j * 256 + lane * 4);
                v[j].x += __uint_as_float(y.x << 16); v[j].y += __uint_as_float(y.x & 0xffff0000u); v[j].z += __uint_as_float(y.y << 16); v[j].w += __uint_as_float(y.y & 0xffff0000u); }
        float ss = 0.f;
#pragma unroll
        for (int j = 0; j < 4; ++j) ss += (v[j].x * v[j].x + v[j].y * v[j].y) + (v[j].z * v[j].z + v[j].w * v[j].w);
        const float rstd = rsqrtf(wave_sum(ss) * (1.f / DM) + 1e-6f);
#pragma unroll
        for (int j = 0; j < 4; ++j) { const f32x4 w = *(const f32x4*)(p.final_norm + j * 256 + lane * 4); *(f32x4*)(p.X + (size_t)row * DM + j * 256 + lane * 4) = v[j] * rstd * w; }
    }
}


#ifndef DBG
#define DBG 0
#endif
#ifndef DBGA
#define DBGA 12
#define DBGB 12
#endif
#if DBG
constexpr size_t WS_MIX2 = 404 * MiB;
constexpr size_t WS_DBG = 470 * MiB;
__global__ void __launch_bounds__(64) dbg_lru_seq(Params p, int l_) {
    const int b = blockIdx.x >> 4, h = blockIdx.x & 15, j = threadIdx.x, col = h * 64 + j;
    const bf16_t* proj = (const bf16_t*)(p.ws + WS_PROJ); bf16_t* mix2 = (bf16_t*)(p.ws + WS_MIX2);
    __shared__ float us[64];
    const float* cw = p.lru_conv_w + (size_t)l_ * 4 * 1024 + col; const float cb = p.lru_conv_b[l_ * 1024 + col];
    const float* wa = p.lru_wa + ((size_t)l_ * 16 + h) * 4096; const float* wx = p.lru_wx + ((size_t)l_ * 16 + h) * 4096;
    const float ba = p.lru_ba[l_ * 1024 + col], bx = p.lru_bx[l_ * 1024 + col], lam = p.lru_lambda[l_ * 1024 + col];
    const float ls = -log1pf(expf(-lam));
    float hc = 0.f;
    for (int t = 0; t < SEQ; ++t) {
        float u = cb;
        for (int k = 0; k < 4; ++k) { const int tt = t - 3 + k; if (tt >= 0) u += cw[k * 1024] * bf2f(proj[(size_t)(b * SEQ + tt) * PROJW + O_LX + col]); }
        __syncthreads(); us[j] = u; __syncthreads();
        float ra = ba, ia = bx;
        for (int i = 0; i < 64; ++i) { ra += us[i] * wa[i * 64 + j]; ia += us[i] * wx[i * 64 + j]; }
        const float r = 1.f / (1.f + expf(-ra)), ig = 1.f / (1.f + expf(-ia));
        const float log_a = 8.f * r * ls, a = expf(log_a), mult = sqrtf(fmaxf(0.f, -expm1f(2.f * log_a)));
        hc = a * hc + mult * (ig * u);
        const float gt = bf2f(proj[(size_t)(b * SEQ + t) * PROJW + O_LG + col]);
        mix2[(size_t)(b * SEQ + t) * 2048 + col] = (bf16_t)f2bf(gelu_tanh_f(gt) * hc);
    }
}
__global__ void __launch_bounds__(512) dbg_ssd_seq(Params p, int l_) {
    const int b = blockIdx.x >> 4, h = blockIdx.x & 15, g = h >> 2, tid = threadIdx.x;
    const bf16_t* proj = (const bf16_t*)(p.ws + WS_PROJ); bf16_t* mix2 = (bf16_t*)(p.ws + WS_MIX2); const float* dtraw = (const float*)(p.ws + WS_DTRAW);
    __shared__ float xs[64], Bs[128], Cs[128];
    const float* cw = p.ssd_conv_w + (size_t)l_ * 4 * SSD_CD; const float* cb = p.ssd_conv_b + l_ * SSD_CD;
    const float bias = p.ssd_dt_bias[l_ * 16 + h], A = -expf(p.ssd_a_log[l_ * 16 + h]), Dh = p.ssd_d[l_ * 16 + h];
    const int pp = tid >> 3, nb = (tid & 7) * 16;
    float st[16];
    for (int q = 0; q < 16; ++q) st[q] = 0.f;
    for (int t = 0; t < SEQ; ++t) {
        __syncthreads();
        if (tid < 320) { int cc; if (tid < 64) cc = h * 64 + tid; else if (tid < 192) cc = 1024 + g * 128 + (tid - 64); else cc = 1536 + g * 128 + (tid - 192);
            float u = cb[cc];
            for (int k = 0; k < 4; ++k) { const int tt = t - 3 + k; if (tt >= 0) u += cw[k * SSD_CD + cc] * bf2f(proj[(size_t)(b * SEQ + tt) * PROJW + O_XS + cc]); }
            u = u / (1.f + expf(-u));
            if (tid < 64) xs[tid] = u; else if (tid < 192) Bs[tid - 64] = u; else Cs[tid - 192] = u; }
        __syncthreads();
        const float dtp = dtraw[(size_t)(b * SEQ + t) * 16 + h] + bias; const float dt = dtp > 20.f ? dtp : log1pf(expf(dtp));
        const float dec = expf(dt * A), xv = xs[pp] * dt;
        float y = 0.f;
        for (int q = 0; q < 16; ++q) { st[q] = dec * st[q] + xv * Bs[nb + q]; y += Cs[nb + q] * st[q]; }
        y += __shfl_xor(y, 1); y += __shfl_xor(y, 2); y += __shfl_xor(y, 4);
        if ((tid & 7) == 0) { y += Dh * xs[pp]; const float z = bf2f(proj[(size_t)(b * SEQ + t) * PROJW + O_Z + h * 64 + pp]); y *= z / (1.f + expf(-z));
            mix2[(size_t)(b * SEQ + t) * 2048 + 1024 + h * 64 + pp] = (bf16_t)f2bf(y); }
    }
}
__global__ void dbg_cmp_mix(Params p) {
    const bf16_t* a = (const bf16_t*)(p.ws + WS_MIX); const bf16_t* b2 = (const bf16_t*)(p.ws + WS_MIX2); float* acc = (float*)(p.ws + WS_DBG);
    float s[4] = {0.f, 0.f, 0.f, 0.f};
    for (size_t i = (size_t)blockIdx.x * blockDim.x + threadIdx.x; i < (size_t)NTOK * 2048; i += (size_t)gridDim.x * blockDim.x) {
        const int col = (int)(i & 2047); const float x = bf2f(a[i]), y = bf2f(b2[i]); const int o = col < 1024 ? 0 : 2; s[o] += (x - y) * (x - y); s[o + 1] += y * y; }
    for (int q = 0; q < 4; ++q) { const float v = wave_sum(s[q]); if ((threadIdx.x & 63) == 0) atomicAdd(acc + q, v); }
}

__global__ void dbg_chk_inproj(Params p, int l) {
    const int sidx = blockIdx.x * blockDim.x + threadIdx.x; float* acc = (float*)(p.ws + WS_DBG);
    const bf16_t* proj = (const bf16_t*)(p.ws + WS_PROJ); const float* dtraw = (const float*)(p.ws + WS_DTRAW);
    unsigned hsh = (unsigned)sidx * 2654435761u + 12345u; hsh ^= hsh >> 13; hsh *= 0x5bd1e995u; hsh ^= hsh >> 15;
    const int row = hsh % NTOK, col = (hsh >> 14) % INC;
    const float* xr = (l == 0 ? p.x : p.X) + (size_t)row * DM; float ss = 0.f;
    for (int k = 0; k < DM; ++k) ss += xr[k] * xr[k];
    const float rstd = 1.f / sqrtf(ss / DM + 1e-6f);
    float d = 0.f;
    for (int k = 0; k < DM; ++k) d += (xr[k] * rstd * p.norm_mix[l * DM + k]) * p.w_in[((size_t)l * DM + k) * INC + col];
    if (col < PROJW) { const float got = bf2f(proj[(size_t)row * PROJW + col]); atomicAdd(acc + 4, (got - d) * (got - d)); atomicAdd(acc + 5, d * d); }
    else { const float got = dtraw[(size_t)row * 16 + col - PROJW]; atomicAdd(acc + 6, (got - d) * (got - d)); atomicAdd(acc + 7, d * d); }
}
__global__ void dbg_chk_outproj(Params p, int l) {
    const int sidx = blockIdx.x * blockDim.x + threadIdx.x; float* acc = (float*)(p.ws + WS_DBG);
    const bf16_t* mix = (const bf16_t*)(p.ws + WS_MIX);
    unsigned hsh = (unsigned)sidx * 2654435761u + 777u; hsh ^= hsh >> 13; hsh *= 0x5bd1e995u; hsh ^= hsh >> 15;
    const int row = hsh % NTOK, col = (hsh >> 14) % DM;
    const bf16_t* mr = mix + (size_t)row * 2048; float s1 = 0.f, s2 = 0.f;
    for (int k = 0; k < 1024; ++k) { const float a = bf2f(mr[k]), b = bf2f(mr[1024 + k]); s1 += a * a; s2 += b * b; }
    const float r1 = 1.f / sqrtf(s1 / 1024.f + 1e-6f), r2 = 1.f / sqrtf(s2 / 1024.f + 1e-6f);
    float d = 0.f;
    for (int k = 0; k < 1024; ++k) { d += bf2f(mr[k]) * r1 * p.lru_norm[l * 1024 + k] * p.w_out[((size_t)l * 2048 + k) * DM + col]; d += bf2f(mr[1024 + k]) * r2 * p.ssd_norm[l * 1024 + k] * p.w_out[((size_t)l * 2048 + 1024 + k) * DM + col]; }
    const float* xb = (l == 0) ? p.x : (const float*)(p.ws + WS_MIX2); const float ref = d, got = p.X[(size_t)row * DM + col] - xb[(size_t)row * DM + col];
    atomicAdd(acc + 8, (got - ref) * (got - ref)); atomicAdd(acc + 9, ref * ref);
}

__global__ void __launch_bounds__(256) dbg_chk_moe(Params p, int l) {
    const int tid = threadIdx.x; float* acc = (float*)(p.ws + WS_DBG); const bf16_t* ys = (const bf16_t*)(p.ws + WS_YSLOT);
    unsigned hsh = (unsigned)blockIdx.x * 2654435761u + 4242u; hsh ^= hsh >> 13; hsh *= 0x5bd1e995u; hsh ^= hsh >> 15;
    const int row = hsh % NTOK;
    __shared__ float hs[1024], hid[512], red[256], outv[4]; __shared__ int ex[2]; __shared__ float ew[2];
    float ss = 0.f; for (int k = tid; k < DM; k += 256) { const float v = p.X[(size_t)row * DM + k]; ss += v * v; }
    red[tid] = ss; __syncthreads(); if (tid == 0) { float t = 0.f; for (int i = 0; i < 256; ++i) t += red[i]; red[0] = 1.f / sqrtf(t / DM + 1e-6f); } __syncthreads();
    const float rstd = red[0];
    for (int k = tid; k < DM; k += 256) hs[k] = p.X[(size_t)row * DM + k] * rstd * p.norm_ffn[l * DM + k];
    __syncthreads();
    if (tid == 0) { float cl[4]; for (int q = 0; q < 4; ++q) { float d = p.b_coarse[l * 4 + q]; for (int k = 0; k < DM; ++k) d += hs[k] * p.w_coarse[((size_t)l * DM + k) * 4 + q]; cl[q] = d; }
        int gi = 0; for (int q = 1; q < 4; ++q) if (cl[q] > cl[gi]) gi = q; float den = 0.f; for (int q = 0; q < 4; ++q) den += expf(cl[q] - cl[gi]);
        float fl[8]; for (int q = 0; q < 8; ++q) { float d = p.b_fine[(l * 4 + gi) * 8 + q]; for (int k = 0; k < DM; ++k) d += hs[k] * p.w_fine[(((size_t)l * 4 + gi) * DM + k) * 8 + q]; fl[q] = d; }
        int i0 = 0; for (int q = 1; q < 8; ++q) if (fl[q] > fl[i0]) i0 = q; int i1 = -1; for (int q = 0; q < 8; ++q) if (q != i0 && (i1 < 0 || fl[q] > fl[i1])) i1 = q;
        const float e1 = expf(fl[i1] - fl[i0]); ex[0] = gi * 8 + i0; ex[1] = gi * 8 + i1; ew[0] = (1.f / den) / (1.f + e1); ew[1] = (1.f / den) * e1 / (1.f + e1); }
    __syncthreads();
    if (tid < 4) outv[tid] = 0.f;
    for (int s2 = 0; s2 < 2; ++s2) { const int e = ex[s2]; const float* wg = p.w_gate + ((size_t)l * NEXP + e) * DM * DEXP; const float* wu = p.w_up + ((size_t)l * NEXP + e) * DM * DEXP; const float* wd = p.w_down + ((size_t)l * NEXP + e) * DEXP * DM;
        __syncthreads();
        for (int j = tid; j < DEXP; j += 256) { float g = 0.f, u = 0.f; for (int k = 0; k < DM; ++k) { g += hs[k] * wg[(size_t)k * DEXP + j]; u += hs[k] * wu[(size_t)k * DEXP + j]; } hid[j] = g / (1.f + expf(-g)) * u; }
        __syncthreads();
        if (tid < 4) { const int col = (hsh >> 16) % 256 + tid * 256; float d = 0.f; for (int j = 0; j < DEXP; ++j) d += hid[j] * wd[(size_t)j * DM + col]; outv[tid] += ew[s2] * d; } }
    __syncthreads();
    if (tid < 4) { const int col = (hsh >> 16) % 256 + tid * 256; const float got = bf2f(ys[(size_t)row * DM + col]) + bf2f(ys[((size_t)NTOK + row) * DM + col]); const float ref = outv[tid];
        atomicAdd(acc + 10, (got - ref) * (got - ref)); atomicAdd(acc + 11, ref * ref); }
}

__global__ void dbg_chk_final(Params p) {
    const int sidx = blockIdx.x * blockDim.x + threadIdx.x; float* acc = (float*)(p.ws + WS_DBG); const bf16_t* ys = (const bf16_t*)(p.ws + WS_YSLOT);
    unsigned hsh = (unsigned)sidx * 2654435761u + 99u; hsh ^= hsh >> 13; hsh *= 0x5bd1e995u; hsh ^= hsh >> 15;
    const int row = hsh % NTOK, col = (hsh >> 14) % DM; const float* xb = (const float*)(p.ws + WS_MIX2) + (size_t)row * DM;
    float ss = 0.f; for (int k = 0; k < DM; ++k) { const float v = xb[k] + bf2f(ys[(size_t)row * DM + k]) + bf2f(ys[((size_t)NTOK + row) * DM + k]); ss += v * v; }
    const float v = xb[col] + bf2f(ys[(size_t)row * DM + col]) + bf2f(ys[((size_t)NTOK + row) * DM + col]);
    const float ref = v / sqrtf(ss / DM + 1e-6f) * p.final_norm[col], got = p.X[(size_t)row * DM + col];
    atomicAdd(acc + 12, (got - ref) * (got - ref)); atomicAdd(acc + 13, ref * ref);
}
__global__ void dbg_zero(Params p) { float* acc = (float*)(p.ws + WS_DBG); if (threadIdx.x < 64) acc[threadIdx.x] = 0.f; }
__device__ __forceinline__ int dbg_digit(float num, float den) { const float d = sqrtf(num / fmaxf(den, 1e-30f)); if (!(d == d)) return 0; const float v = -2.f * log10f(fmaxf(d, 1e-10f)); return v < 0.f ? 0 : (v > 8.f ? 8 : (int)v); }
__global__ void dbg_report(Params p) {
    const float* acc = (const float*)(p.ws + WS_DBG);
    const size_t i = (size_t)blockIdx.x * blockDim.x + threadIdx.x;
    if (i < (size_t)NTOK * DM) p.X[i] = 0.f;
    if (i == 0) { const int a = dbg_digit(acc[DBGA], acc[DBGA + 1]), b = dbg_digit(acc[DBGB], acc[DBGB + 1]); p.X[0] = sqrtf((float)NTOK * DM * (9.f + 10.f * a + b)); }
}
#endif
enum { PH_CONVERT = 0, PH_NORM, PH_INPROJ, PH_MIXA, PH_SCAN, PH_MIXB, PH_OUTPROJ, PH_ROUTER, PH_MOEUP, PH_MOEDOWN, PH_FINAL };

template <int PH>
__device__ __forceinline__ void run_phase(const Params& p, int l, LAS unsigned char* lds) {
    if (PH == PH_CONVERT) ph_convert(p, l, lds);
    if (PH == PH_NORM) ph_norm(p, l);
    if (PH == PH_INPROJ) ph_inproj(p, lds);
    if (PH == PH_MIXA) ph_mixA(p, l, lds);
    if (PH == PH_SCAN) ph_scan(p);
    if (PH == PH_MIXB) ph_mixB(p, l, lds);
    if (PH == PH_OUTPROJ) ph_outproj(p, l, lds);
    if (PH == PH_ROUTER) ph_router(p, l);
    if (PH == PH_MOEUP) ph_moe_up(p, lds);
    if (PH == PH_MOEDOWN) ph_moe_down(p, lds);
    if (PH == PH_FINAL) ph_final(p);
}

template <int PH>
__global__ void __launch_bounds__(NTHR) k_phase(Params p, int l) {
    extern __shared__ __attribute__((aligned(16))) unsigned char lds_raw[];
    run_phase<PH>(p, l, (LAS unsigned char*)lds_raw);
}

#if ONE_LAUNCH
__global__ void __launch_bounds__(NTHR) k_mega(Params p) {
    extern __shared__ __attribute__((aligned(16))) unsigned char lds_raw[];
    LAS unsigned char* lds = (LAS unsigned char*)lds_raw;
    cg::grid_group grid = cg::this_grid();
#pragma unroll 1
    for (int l = 0; l < DEPTH; ++l) {
        ph_convert(p, l, lds); ph_norm(p, l); grid.sync();
        ph_inproj(p, lds); grid.sync();
        ph_mixA(p, l, lds); grid.sync();
        ph_scan(p); grid.sync();
        ph_mixB(p, l, lds); grid.sync();
        ph_outproj(p, l, lds); grid.sync();
        ph_router(p, l); grid.sync();
        ph_moe_up(p, lds); grid.sync();
        ph_moe_down(p, lds); grid.sync();
    }
    ph_final(p);
}
#endif

template <int PH> static void launch_phase(const Params& p, int l, int grid, hipStream_t stream) {
    static bool attr = false;
    if (!attr) { (void)hipFuncSetAttribute((const void*)k_phase<PH>, hipFuncAttributeMaxDynamicSharedMemorySize, LDS_BYTES); attr = true; }
    hipLaunchKernelGGL(k_phase<PH>, dim3(grid), dim3(NTHR), LDS_BYTES, stream, p, l);
}

extern "C" void kernel_launch(void* const* d_in, const int* in_sizes, int n_in, void* d_out, int out_size, void* d_ws, size_t ws_size, hipStream_t stream) {
    if (n_in != 27 || in_sizes[0] != NTOK * DM || out_size != NTOK * DM || ws_size < WS_END) {
        fprintf(stderr, "kernel_launch: unexpected shapes (n_in %d, in0 %d, out %d, ws %zu)\n", n_in, n_in > 0 ? in_sizes[0] : -1, out_size, ws_size); return; }
    Params p{};
    const float** f = (const float**)&p;
    for (int i = 0; i < 27; ++i) f[i] = (const float*)d_in[i];
    p.X = (float*)d_out; p.ws = (unsigned char*)d_ws;
#if DBG
    { const int G = 256;
      launch_phase<PH_CONVERT>(p, 0, G, stream); launch_phase<PH_NORM>(p, 0, G, stream); launch_phase<PH_INPROJ>(p, 0, G, stream);
      launch_phase<PH_MIXA>(p, 0, G, stream); launch_phase<PH_SCAN>(p, 0, G, stream); launch_phase<PH_MIXB>(p, 0, G, stream);
      launch_phase<PH_OUTPROJ>(p, 0, G, stream);
      launch_phase<PH_ROUTER>(p, 0, G, stream); launch_phase<PH_MOEUP>(p, 0, G, stream); launch_phase<PH_MOEDOWN>(p, 0, G, stream);
      launch_phase<PH_CONVERT>(p, 1, G, stream); launch_phase<PH_NORM>(p, 1, G, stream); launch_phase<PH_INPROJ>(p, 1, G, stream);
      launch_phase<PH_MIXA>(p, 1, G, stream); launch_phase<PH_SCAN>(p, 1, G, stream); launch_phase<PH_MIXB>(p, 1, G, stream);
      launch_phase<PH_OUTPROJ>(p, 1, G, stream);
      launch_phase<PH_ROUTER>(p, 1, G, stream); launch_phase<PH_MOEUP>(p, 1, G, stream); launch_phase<PH_MOEDOWN>(p, 1, G, stream);
      (void)hipMemcpyAsync(p.ws + WS_MIX2, p.X, (size_t)NTOK * DM * 4, hipMemcpyDeviceToDevice, stream);
      launch_phase<PH_FINAL>(p, 0, G, stream);
      hipLaunchKernelGGL(dbg_zero, dim3(1), dim3(64), 0, stream, p);
      hipLaunchKernelGGL(dbg_chk_final, dim3(64), dim3(64), 0, stream, p);
      hipLaunchKernelGGL(dbg_report, dim3(NTOK * DM / 256), dim3(256), 0, stream, p);
      return; }
#endif
#if ONE_LAUNCH
    static int grid = 0;
    if (!grid) { int dev = 0, cus = 0, per_cu = 0; (void)hipGetDevice(&dev); (void)hipDeviceGetAttribute(&cus, hipDeviceAttributeMultiprocessorCount, dev);
        (void)hipFuncSetAttribute((const void*)k_mega, hipFuncAttributeMaxDynamicSharedMemorySize, LDS_BYTES);
        (void)hipOccupancyMaxActiveBlocksPerMultiprocessor(&per_cu, (const void*)k_mega, NTHR, LDS_BYTES);
        if (per_cu < 1) { fprintf(stderr, "kernel_launch: occupancy query says %d blocks/CU\n", per_cu); per_cu = 1; }
        grid = cus * 1; }
    void* args[] = {&p};
    hipError_t e = hipLaunchCooperativeKernel((const void*)k_mega, dim3(grid), dim3(NTHR), args, LDS_BYTES, stream);
    if (e != hipSuccess) fprintf(stderr, "cooperative launch failed: %s (grid %d)\n", hipGetErrorString(e), grid);
#else
    const int G = 256;
    for (int l = 0; l < DEPTH; ++l) {
        launch_phase<PH_CONVERT>(p, l, G, stream);
        launch_phase<PH_NORM>(p, l, G, stream);
        launch_phase<PH_INPROJ>(p, l, G, stream);
        launch_phase<PH_MIXA>(p, l, G, stream);
        launch_phase<PH_SCAN>(p, l, G, stream);
        launch_phase<PH_MIXB>(p, l, G, stream);
        launch_phase<PH_OUTPROJ>(p, l, G, stream);
        launch_phase<PH_ROUTER>(p, l, G, stream);
        launch_phase<PH_MOEUP>(p, l, G, stream);
        launch_phase<PH_MOEDOWN>(p, l, G, stream);
    }
    launch_phase<PH_FINAL>(p, 0, G, stream);
#endif
}
```

```cpp
#include <hip/hip_runtime.h>
#include <hip/hip_cooperative_groups.h>
#include <cstdint>
#include <cstdio>
namespace cg = cooperative_groups;

#ifndef ONE_LAUNCH
#define ONE_LAUNCH 1
#endif

#define LAS __attribute__((address_space(3)))
typedef unsigned short bf16_t;
typedef short bf16x8 __attribute__((ext_vector_type(8)));
typedef float f32x4 __attribute__((ext_vector_type(4)));
typedef unsigned u32x2 __attribute__((ext_vector_type(2)));
typedef unsigned u32x4 __attribute__((ext_vector_type(4)));

constexpr int NB = 2, SEQ = 8192, DM = 1024, NTOK = NB * SEQ, DEPTH = 2;
constexpr int INC = 5136, PROJW = 5120;
constexpr int SSD_CD = 2048;
constexpr int O_LX = 0, O_LG = 1024, O_Z = 2048, O_XS = 3072, O_B = 4096, O_C = 4608;
constexpr int NEXP = 32, DEXP = 512, NCH = 64, CH = 128;
constexpr int NTHR = 512;
constexpr int MAXTILES = 160;
constexpr int LISTCAP = NTOK;

constexpr size_t MiB = 1u << 20;
constexpr size_t WS_CTL = 0;
constexpr size_t WS_WIN = 1 * MiB;
constexpr size_t WS_WOUT = 11 * MiB;
constexpr size_t WS_WGU = 15 * MiB;
constexpr size_t WS_WD = 79 * MiB;
constexpr size_t WS_PROJ = 111 * MiB;
constexpr size_t WS_H = WS_PROJ;
constexpr size_t WS_HID = WS_PROJ + 32 * MiB;
constexpr size_t WS_YSLOT = WS_PROJ + 72 * MiB;
constexpr size_t WS_LTOK = WS_PROJ + 136 * MiB;
constexpr size_t WS_LW = WS_PROJ + 138 * MiB;
constexpr size_t WS_MIX = 271 * MiB;
constexpr size_t WS_XN = WS_MIX;
constexpr size_t WS_STATES = 335 * MiB;
constexpr size_t WS_DTRAW = 399 * MiB;
constexpr size_t WS_ROWSS = 400 * MiB;
constexpr size_t WS_LSUM = 401 * MiB;
constexpr size_t WS_LCARRY = 402 * MiB;
constexpr size_t WS_DECAY = 403 * MiB;
constexpr size_t WS_END = 404 * MiB;

constexpr int LDS_BYTES = 152 * 1024;
constexpr int LDS_TB = 151552 + 256;
constexpr int LDS_MISC = 151552;

struct Params {
    const float *x, *norm_mix, *w_in, *lru_conv_w, *lru_conv_b, *lru_wa, *lru_ba, *lru_wx, *lru_bx, *lru_lambda, *lru_norm,
        *ssd_conv_w, *ssd_conv_b, *ssd_dt_bias, *ssd_a_log, *ssd_d, *ssd_norm, *w_out, *norm_ffn, *w_coarse, *b_coarse, *w_fine, *b_fine,
        *w_gate, *w_up, *w_down, *final_norm;
    float* X;
    unsigned char* ws;
};

__device__ __forceinline__ float bf2f(bf16_t v) { return __uint_as_float((unsigned)v << 16); }
__device__ __forceinline__ unsigned f2bf(float f) { unsigned u = __float_as_uint(f); return (u + 0x7fffu + ((u >> 16) & 1u)) >> 16; }
__device__ __forceinline__ unsigned pk2(float lo, float hi) { return f2bf(lo) | (f2bf(hi) << 16); }
#define SWZ_XOR(v, m) __builtin_bit_cast(float, __builtin_amdgcn_ds_swizzle(__builtin_bit_cast(int, (v)), ((m) << 10) | 0x1f))
__device__ __forceinline__ float wave_sum(float v) {
    v += SWZ_XOR(v, 1); v += SWZ_XOR(v, 2); v += SWZ_XOR(v, 4); v += SWZ_XOR(v, 8); v += SWZ_XOR(v, 16);
    return __builtin_bit_cast(float, __builtin_amdgcn_readlane(__builtin_bit_cast(int, v), 0)) + __builtin_bit_cast(float, __builtin_amdgcn_readlane(__builtin_bit_cast(int, v), 32));
}
__device__ __forceinline__ float sigmoid_f(float x) { return 1.f / (1.f + __expf(-x)); }
__device__ __forceinline__ float silu_f(float x) { return x * sigmoid_f(x); }
__device__ __forceinline__ float softplus_f(float x) { return x > 20.f ? x : log1pf(__expf(x)); }
__device__ __forceinline__ float gelu_tanh_f(float x) { const float u = 0.7978845608028654f * (x + 0.044715f * x * x * x); return 0.5f * x * (1.f + tanhf(u)); }

__device__ __forceinline__ int opaque_tid() { int t = threadIdx.x; asm volatile("" : "+v"(t)); return t; }
#define LDS_WAIT() asm volatile("s_waitcnt lgkmcnt(0)" ::: "memory")
#define VM_WAIT() asm volatile("s_waitcnt vmcnt(0)" ::: "memory")

__device__ __forceinline__ void tr_item(const float* src, int ld, int k0, int c0, bf16_t* dst, int ldd, int r0, const float* kscale, LAS float* scr, int lane) {
#pragma unroll 8
    for (int i = 0; i < 32; ++i) {
        const int kk = 2 * i + (lane >> 5), nn = lane & 31;
        float v = src[(size_t)(k0 + kk) * ld + c0 + nn];
        if (kscale) v *= kscale[k0 + kk];
        scr[kk * 33 + nn] = v;
    }
    LDS_WAIT();
    const int c = lane & 7;
#pragma unroll
    for (int j = 0; j < 4; ++j) {
        const int n = (lane >> 3) + 8 * j; const LAS float* s = scr + (8 * c) * 33 + n;
        u32x4 o; o.x = pk2(s[0 * 33], s[1 * 33]); o.y = pk2(s[2 * 33], s[3 * 33]); o.z = pk2(s[4 * 33], s[5 * 33]); o.w = pk2(s[6 * 33], s[7 * 33]);
        *(u32x4*)(dst + (size_t)(r0 + n) * ldd + k0 + 8 * c) = o;
    }
    LDS_WAIT();
}

__device__ __forceinline__ void ph_convert(const Params& p, int l, LAS unsigned char* lds) {
    const int tid = opaque_tid(), lane = tid & 63, wave = tid >> 6;
    LAS float* scr = (LAS float*)(lds + wave * 16384);
    const int gw = blockIdx.x * 8 + wave, NGW = gridDim.x * 8;
    bf16_t* WinT = (bf16_t*)(p.ws + WS_WIN); bf16_t* WoutT = (bf16_t*)(p.ws + WS_WOUT); bf16_t* WguT = (bf16_t*)(p.ws + WS_WGU); bf16_t* WdT = (bf16_t*)(p.ws + WS_WD);
    constexpr int I_IN = 16 * 160, I_OUT = 32 * 32, I_GU = 32 * 512, I_D = 32 * 256;
    for (int it = gw; it < I_IN + I_OUT + I_GU + I_D; it += NGW) {
        int r = it;
        if (r < I_IN) { const int kb = r / 160, nb = r % 160; tr_item(p.w_in + (size_t)l * DM * INC, INC, kb * 64, nb * 32, WinT, DM, nb * 32, nullptr, scr, lane); continue; }
        r -= I_IN;
        if (r < I_OUT) { const int kb = r / 32, nb = r % 32; const int k0 = kb * 64;
            const float* ks = (k0 < 1024) ? (p.lru_norm + l * 1024) : (p.ssd_norm + l * 1024 - 1024);
            tr_item(p.w_out + (size_t)l * 2048 * DM, DM, k0, nb * 32, WoutT, 2048, nb * 32, ks, scr, lane); continue; }
        r -= I_OUT;
        if (r < I_GU) { const int e = r / 512, q = r % 512, kb = q / 32, rb = q % 32, pn = rb >> 3, jb = rb & 7;
            const float* src = (jb < 4 ? p.w_gate : p.w_up) + ((size_t)l * NEXP + e) * DM * DEXP;
            const int c0 = 128 * pn + 32 * (jb & 3);
            tr_item(src, DEXP, kb * 64, c0, WguT + (size_t)e * 1024 * 1024, DM, rb * 32, nullptr, scr, lane); continue; }
        r -= I_GU;
        { const int e = r / 256, q = r % 256, kb = q / 32, nb = q % 32;
            tr_item(p.w_down + ((size_t)l * NEXP + e) * DEXP * DM, DM, kb * 64, nb * 32, WdT + (size_t)e * 1024 * 512, DEXP, nb * 32, nullptr, scr, lane); }
    }
}

__device__ __forceinline__ void ph_norm(const Params& p, int l) {
    const int tid = opaque_tid(), lane = tid & 63, wave = tid >> 6;
    const int gw = blockIdx.x * 8 + wave, NGW = gridDim.x * 8;
    bf16_t* xn = (bf16_t*)(p.ws + WS_XN); float* dtraw = (float*)(p.ws + WS_DTRAW);
    const bf16_t* ys = (const bf16_t*)(p.ws + WS_YSLOT);
    const float* nw = p.norm_mix + l * DM;
    const float* wdt = p.w_in + (size_t)l * DM * INC + PROJW;
    if (blockIdx.x == 0 && tid < 64) ((int*)(p.ws + WS_CTL))[tid] = 0;
    for (int row = gw; row < NTOK; row += NGW) {
        f32x4 v[4];
        const float* src = (l == 0 ? p.x : p.X) + (size_t)row * DM;
#pragma unroll
        for (int j = 0; j < 4; ++j) v[j] = *(const f32x4*)(src + j * 256 + lane * 4);
        if (l > 0) {
#pragma unroll
            for (int s = 0; s < 2; ++s)
#pragma unroll
                for (int j = 0; j < 4; ++j) { const u32x2 y = *(const u32x2*)(ys + ((size_t)s * NTOK + row) * DM + j * 256 + lane * 4);
                    v[j].x += __uint_as_float(y.x << 16); v[j].y += __uint_as_float(y.x & 0xffff0000u); v[j].z += __uint_as_float(y.y << 16); v[j].w += __uint_as_float(y.y & 0xffff0000u); }
#pragma unroll
            for (int j = 0; j < 4; ++j) *(f32x4*)(p.X + (size_t)row * DM + j * 256 + lane * 4) = v[j];
        }
        float ss = 0.f;
#pragma unroll
        for (int j = 0; j < 4; ++j) ss += (v[j].x * v[j].x + v[j].y * v[j].y) + (v[j].z * v[j].z + v[j].w * v[j].w);
        const float rstd = rsqrtf(wave_sum(ss) * (1.f / DM) + 1e-6f);
#pragma unroll
        for (int j = 0; j < 4; ++j) { const f32x4 w = *(const f32x4*)(nw + j * 256 + lane * 4); v[j] = v[j] * rstd * w;
            u32x2 o; o.x = pk2(v[j].x, v[j].y); o.y = pk2(v[j].z, v[j].w); *(u32x2*)(xn + (size_t)row * DM + j * 256 + lane * 4) = o; }
        float dacc[16];
#pragma unroll
        for (int h = 0; h < 16; ++h) dacc[h] = 0.f;
#pragma unroll
        for (int j = 0; j < 4; ++j)
#pragma unroll
            for (int e = 0; e < 4; ++e) { const int k = j * 256 + lane * 4 + e; const float xv = v[j][e];
#pragma unroll
                for (int q = 0; q < 4; ++q) { const f32x4 w = *(const f32x4*)(wdt + (size_t)k * INC + q * 4);
                    dacc[q * 4 + 0] += xv * w.x; dacc[q * 4 + 1] += xv * w.y; dacc[q * 4 + 2] += xv * w.z; dacc[q * 4 + 3] += xv * w.w; } }
        float mine = 0.f;
#pragma unroll
        for (int h = 0; h < 16; ++h) { const float s = wave_sum(dacc[h]); if (lane == h) mine = s; }
        if (lane < 16) dtraw[(size_t)row * 16 + lane] = mine;
    }
}

namespace pg8 {
constexpr int BM = 256, BK = 64, HALF = 128, HTB = HALF * BK * 2, STAGE_BYTES = 8 * HTB, NXCD = 8, WGM = 8;
__host__ __device__ __forceinline__ int lds_byte(int r, int c) { const int st = (r >> 4) * 2 + (c >> 5), rr = r & 15, cc = c & 31, ob = rr * 64 + cc * 2; return st * 1024 + (ob ^ (((ob >> 9) & 1) << 5)); }
__host__ __device__ __forceinline__ void stage_rc(int b, int& R, int& C) { const int st = b / 1024, sb = b % 1024, swz = sb ^ (((sb >> 9) & 1) << 5); R = (st >> 1) * 16 + swz / 64; C = (st & 1) * 32 + (swz % 64) / 2; }
__host__ __device__ __forceinline__ int perm32(int rho) { const int n = rho >> 4, i = rho & 15; return 8 * (i >> 2) + 4 * n + (i & 3); }
struct Unit { int pm, pn; const bf16_t* a; const bf16_t* b; const int* rows; int nrows; };
__device__ __forceinline__ unsigned cvt_pk_bf16(float lo, float hi) { unsigned r; asm volatile("v_cvt_pk_bf16_f32 %0, %1, %2" : "=v"(r) : "v"(lo), "v"(hi)); return r; }

struct GridOrder {
    int nM, nN, nwg, G, c;
    __device__ void init(int nM_, int nN_, int G_, int c_) { nM = nM_; nN = nN_; nwg = nM * nN; G = G_; c = c_; }
    __device__ bool tile(int i, int& pm, int& pn) const {
        const long L = (long)i * G + c; if (L >= nwg) return false;
        int wgid = (int)L; { const int q = nwg / NXCD, r = nwg % NXCD, xcd = wgid % NXCD, off = wgid / NXCD; wgid = (xcd < r ? xcd * (q + 1) : r * (q + 1) + (xcd - r) * q) + off; }
        const int nig = WGM * nN, gid = wgid / nig, fm = gid * WGM, gsz = (nM - fm) < WGM ? (nM - fm) : WGM;
        pm = fm + ((wgid % nig) % gsz); pn = (wgid % nig) / gsz; return true;
    }
};

template <class Epi, class Sched, bool GATHER>
__device__ __forceinline__ void gemm_phase(LAS unsigned char* lds, const int K, const int lda, const int ldb, const Sched& S, const Epi& E) {
    const int tid = opaque_tid(), wid = __builtin_amdgcn_readfirstlane(tid >> 6), lane = tid & 63, wr = wid >> 2, wc = wid & 3, fr = lane & 15, fq = lane >> 4;
    const int nt = K / BK;
    unsigned voffA[2], voffB[2];
#pragma unroll
    for (int i = 0; i < 2; ++i) { int R, C; stage_rc(tid * 16 + i * 8192, R, C); const int Rb = Epi::PERM ? ((R & ~31) + perm32(R & 31)) : R;
        voffA[i] = (unsigned)(R * lda + C) * 2u; voffB[i] = (unsigned)(Rb * ldb + C) * 2u; }
    const size_t hstepA = (size_t)HALF * lda * 2, hstepB = (size_t)HALF * ldb * 2;
    const size_t kstep = (size_t)(BK * 2);
    const unsigned ldsw = (unsigned)wid * 1024u;
    const int aoff = lds_byte(wr * 64 + fr, fq * 8), boff = lds_byte(wc * 32 + fr, fq * 8);
#define PG8_SA(b, h) (((b) * 2 + (h)) * HTB)
#define PG8_SB(b, h) ((4 + (b) * 2 + (h)) * HTB)
#define PG8_GLDS(bufoff, gp, i_) __builtin_amdgcn_global_load_lds((const unsigned*)(gp), (LAS unsigned*)(lds + (bufoff) + ldsw + (i_) * 8192), 16, 0, 0)
#define PG8_STAGE_B(bufoff, gbase, h) do { PG8_GLDS(bufoff, (const char*)(gbase) + (h) * hstepB + voffB[0], 0); PG8_GLDS(bufoff, (const char*)(gbase) + (h) * hstepB + voffB[1], 1); } while (0)
#define PG8_STAGE_A(bufoff, gbase, h, nx) do { if (GATHER) { PG8_GLDS(bufoff, (const char*)(gbase) + ((nx) ? nvo[h][0] : vo[h][0]), 0); PG8_GLDS(bufoff, (const char*)(gbase) + ((nx) ? nvo[h][1] : vo[h][1]), 1); } \
        else { PG8_GLDS(bufoff, (const char*)(gbase) + (h) * hstepA + voffA[0], 0); PG8_GLDS(bufoff, (const char*)(gbase) + (h) * hstepA + voffA[1], 1); } } while (0)
#define PG8_LDA(dst, b, h) do { _Pragma("unroll") for (int m = 0; m < 4; ++m) _Pragma("unroll") for (int k = 0; k < 2; ++k) dst[m][k] = *(const LAS bf16x8*)(lds + PG8_SA(b, h) + aoff + m * 2048 + k * 1024); } while (0)
#define PG8_LDB(dst, b, h) do { _Pragma("unroll") for (int n = 0; n < 2; ++n) _Pragma("unroll") for (int k = 0; k < 2; ++k) dst[n][k] = *(const LAS bf16x8*)(lds + PG8_SB(b, h) + boff + n * 2048 + k * 1024); } while (0)
#define PG8_MMA(ai, bj, At, Bt) do { __builtin_amdgcn_s_setprio(1); _Pragma("unroll") for (int m = 0; m < 4; ++m) _Pragma("unroll") for (int n = 0; n < 2; ++n) _Pragma("unroll") for (int k = 0; k < 2; ++k) \
        acc[ai][bj][m][n] = __builtin_amdgcn_mfma_f32_16x16x32_bf16(Bt[n][k], At[m][k], acc[ai][bj][m][n], 0, 0, 0); __builtin_amdgcn_s_setprio(0); } while (0)
#define PG8_WAIT_V(n) asm volatile("s_waitcnt vmcnt(" #n ")" ::: "memory")
#define PG8_WAIT_L(n) asm volatile("s_waitcnt lgkmcnt(" #n ")" ::: "memory")
#define PG8_BAR __builtin_amdgcn_s_barrier()
#define PG8_SCHED __builtin_amdgcn_sched_barrier(0)
#define PG8_GVO(dst, u) do { if (GATHER) { _Pragma("unroll") for (int h = 0; h < 2; ++h) _Pragma("unroll") for (int i = 0; i < 2; ++i) { int R, C; stage_rc(tid * 16 + i * 8192, R, C); \
        const int rr = h * HALF + R; const int tok = (rr < (u).nrows) ? ((u).rows[rr] >> 1) : 0; dst[h][i] = (unsigned)(tok * lda + C) * 2u; } } } while (0)
    Unit cur, nxt; int ui = 0;
    if (!S.next(0, cur)) return;
    f32x4 acc[2][2][4][2];
#pragma unroll
    for (int a = 0; a < 2; ++a)
#pragma unroll
        for (int b = 0; b < 2; ++b)
#pragma unroll
            for (int m = 0; m < 4; ++m)
#pragma unroll
                for (int n = 0; n < 2; ++n) acc[a][b][m][n] = (f32x4){0.f, 0.f, 0.f, 0.f};
    bf16x8 At[4][2], B0[2][2], B1[2][2];
    unsigned vo[2][2] = {{0u, 0u}, {0u, 0u}}, nvo[2][2] = {{0u, 0u}, {0u, 0u}};
    PG8_GVO(vo, cur);
    if (GATHER) {
#pragma unroll
        for (int h = 0; h < 2; ++h) { nvo[h][0] = vo[h][0]; nvo[h][1] = vo[h][1]; } }
    const char* cA = (const char*)cur.a; const char* cB = (const char*)cur.b;
    PG8_STAGE_B(PG8_SB(0, 0), cB, 0); PG8_STAGE_B(PG8_SB(0, 1), cB, 1); PG8_STAGE_A(PG8_SA(0, 0), cA, 0, false); PG8_STAGE_A(PG8_SA(0, 1), cA, 1, false);
    if (wr == 1) PG8_BAR;
    PG8_WAIT_V(2); PG8_BAR;
    PG8_STAGE_B(PG8_SB(1, 0), cB + kstep, 0); PG8_STAGE_A(PG8_SA(1, 0), cA + kstep, 0, false); PG8_STAGE_B(PG8_SB(1, 1), cB + kstep, 1);
    PG8_WAIT_V(6); PG8_BAR;
    for (;;) {
        const bool has_next = S.next(ui + 1, nxt);
        const char* nA = has_next ? (const char*)nxt.a : cA; const char* nB = has_next ? (const char*)nxt.b : cB;
        if (GATHER && has_next) PG8_GVO(nvo, nxt);
        for (int t = 0; t < nt; t += 2) {
            const bool last = (t == nt - 2);
            const char* a1 = cA + (size_t)(t + 1) * kstep;
            const char* a2 = last ? nA : cA + (size_t)(t + 2) * kstep; const char* b2 = last ? nB : cB + (size_t)(t + 2) * kstep;
            const char* a3 = a2 + kstep; const char* b3 = b2 + kstep;
            const bool nx = GATHER && last;
            PG8_LDB(B0, 0, 0); PG8_LDB(B1, 0, 1); PG8_SCHED; PG8_LDA(At, 0, 0); PG8_STAGE_A(PG8_SA(1, 1), a1, 1, false);
            PG8_WAIT_V(8); PG8_WAIT_L(0); PG8_BAR; PG8_MMA(0, 0, At, B0); PG8_MMA(0, 1, At, B1); PG8_BAR; PG8_SCHED;
            PG8_LDA(At, 0, 1); PG8_STAGE_B(PG8_SB(0, 0), b2, 0); PG8_STAGE_B(PG8_SB(0, 1), b2, 1); PG8_STAGE_A(PG8_SA(0, 0), a2, 0, nx);
            PG8_WAIT_V(8); PG8_WAIT_L(0); PG8_BAR; PG8_MMA(1, 0, At, B0); PG8_MMA(1, 1, At, B1); PG8_BAR; PG8_SCHED;
            PG8_LDB(B0, 1, 0); PG8_LDB(B1, 1, 1); PG8_SCHED; PG8_LDA(At, 1, 0); PG8_STAGE_A(PG8_SA(0, 1), a2, 1, nx);
            PG8_WAIT_V(8); PG8_WAIT_L(0); PG8_BAR; PG8_MMA(0, 0, At, B0); PG8_MMA(0, 1, At, B1); PG8_BAR; PG8_SCHED;
            PG8_LDA(At, 1, 1); PG8_STAGE_B(PG8_SB(1, 0), b3, 0); PG8_STAGE_B(PG8_SB(1, 1), b3, 1); PG8_STAGE_A(PG8_SA(1, 0), a3, 0, nx);
            PG8_WAIT_V(8); PG8_WAIT_L(0); PG8_BAR; PG8_MMA(1, 0, At, B0); PG8_MMA(1, 1, At, B1); PG8_BAR; PG8_SCHED;
        }
        if (wr == 0) PG8_BAR;
        E(acc, cur, wr, wc, fr, fq);
        if (!has_next) break;
#pragma unroll
        for (int a = 0; a < 2; ++a)
#pragma unroll
            for (int b = 0; b < 2; ++b)
#pragma unroll
                for (int m = 0; m < 4; ++m)
#pragma unroll
                    for (int n = 0; n < 2; ++n) acc[a][b][m][n] = (f32x4){0.f, 0.f, 0.f, 0.f};
        cur = nxt; cA = nA; cB = nB; ++ui;
        if (GATHER) {
#pragma unroll
            for (int h = 0; h < 2; ++h) { vo[h][0] = nvo[h][0]; vo[h][1] = nvo[h][1]; } }
        if (wr == 1) PG8_BAR;
    }
    PG8_WAIT_V(0);
    PG8_BAR;
#undef PG8_SA
#undef PG8_SB
#undef PG8_GLDS
#undef PG8_STAGE_A
#undef PG8_STAGE_B
#undef PG8_LDA
#undef PG8_LDB
#undef PG8_MMA
#undef PG8_WAIT_V
#undef PG8_WAIT_L
#undef PG8_BAR
#undef PG8_SCHED
#undef PG8_GVO
}
}

struct SchedIn { pg8::GridOrder o; const bf16_t* A; const bf16_t* B;
    __device__ __forceinline__ bool next(int i, pg8::Unit& u) const { int pm, pn; if (!o.tile(i, pm, pn)) return false; u.pm = pm; u.pn = pn; u.a = A + (size_t)pm * 256 * DM; u.b = B + (size_t)pn * 256 * DM; u.rows = nullptr; u.nrows = 0; return true; } };
struct EpiProj { static constexpr bool PERM = true; bf16_t* O;
    __device__ __forceinline__ void operator()(const f32x4 (&acc)[2][2][4][2], const pg8::Unit& u, int wr, int wc, int fr, int fq) const {
        const int row0 = u.pm * 256 + wr * 64 + fr, col0 = u.pn * 256 + wc * 32 + 8 * fq;
#pragma unroll
        for (int ai = 0; ai < 2; ++ai)
#pragma unroll
            for (int m = 0; m < 4; ++m) { bf16_t* rowp = O + (size_t)(row0 + ai * 128 + m * 16) * PROJW + col0;
#pragma unroll
                for (int bj = 0; bj < 2; ++bj) { const f32x4 v0 = acc[ai][bj][m][0], v1 = acc[ai][bj][m][1]; u32x4 w;
                    w.x = pg8::cvt_pk_bf16(v0[0], v0[1]); w.y = pg8::cvt_pk_bf16(v0[2], v0[3]); w.z = pg8::cvt_pk_bf16(v1[0], v1[1]); w.w = pg8::cvt_pk_bf16(v1[2], v1[3]);
                    *(u32x4*)(rowp + bj * 128) = w; } }
    } };
__device__ __forceinline__ void ph_inproj(const Params& p, LAS unsigned char* lds) {
    SchedIn S; S.o.init(64, 20, gridDim.x, blockIdx.x); S.A = (const bf16_t*)(p.ws + WS_XN); S.B = (const bf16_t*)(p.ws + WS_WIN);
    pg8::gemm_phase<EpiProj, SchedIn, false>(lds, DM, DM, DM, S, EpiProj{(bf16_t*)(p.ws + WS_PROJ)});
}

__device__ __forceinline__ void row_rstd(const float* rowss, int row, float& rl, float& rs) {
    const f32x4 a = *(const f32x4*)(rowss + (size_t)row * 8), b = *(const f32x4*)(rowss + (size_t)row * 8 + 4);
    rl = rsqrtf(((a.x + a.y) + (a.z + a.w)) * (1.f / 1024.f) + 1e-6f); rs = rsqrtf(((b.x + b.y) + (b.z + b.w)) * (1.f / 1024.f) + 1e-6f);
}
struct SchedOut { pg8::GridOrder o; const bf16_t* A; const bf16_t* B;
    __device__ __forceinline__ bool next(int i, pg8::Unit& u) const { int pm, pn; if (!o.tile(i, pm, pn)) return false; u.pm = pm; u.pn = pn; u.a = A + (size_t)pm * 256 * 2048; u.b = B + (size_t)pn * 256 * 2048; u.rows = nullptr; u.nrows = 0; return true; } };
struct EpiOut { static constexpr bool PERM = false; const float* resid; float* out; const float* rowss; int half;
    __device__ __forceinline__ void operator()(const f32x4 (&acc)[2][2][4][2], const pg8::Unit& u, int wr, int wc, int fr, int fq) const {
        const int row0 = u.pm * 256 + wr * 64 + fr, col0 = u.pn * 256 + wc * 32 + 4 * fq;
#pragma unroll
        for (int ai = 0; ai < 2; ++ai)
#pragma unroll
            for (int m = 0; m < 4; ++m) { const int row = row0 + ai * 128 + m * 16; float rl, rs; row_rstd(rowss, row, rl, rs); const float sc = half ? rs : rl; const size_t off = (size_t)row * DM + col0;
#pragma unroll
                for (int bj = 0; bj < 2; ++bj)
#pragma unroll
                    for (int n = 0; n < 2; ++n) { const f32x4 bs = *(const f32x4*)(resid + off + bj * 128 + n * 16); *(f32x4*)(out + off + bj * 128 + n * 16) = bs + acc[ai][bj][m][n] * sc; } }
    } };
__device__ __forceinline__ void ph_outproj(const Params& p, int l, LAS unsigned char* lds) {
    const float* rowss = (const float*)(p.ws + WS_ROWSS);
    SchedOut S; S.o.init(64, 4, gridDim.x, blockIdx.x); S.A = (const bf16_t*)(p.ws + WS_MIX); S.B = (const bf16_t*)(p.ws + WS_WOUT);
    pg8::gemm_phase<EpiOut, SchedOut, false>(lds, 1024, 2048, 2048, S, EpiOut{(l == 0) ? p.x : p.X, p.X, rowss, 0});
    S.A += 1024; S.B += 1024;
    pg8::gemm_phase<EpiOut, SchedOut, false>(lds, 1024, 2048, 2048, S, EpiOut{p.X, p.X, rowss, 1});
}

__device__ __forceinline__ float conv4(const bf16_t* proj, int R0, int t0, int l, int col, const float* cw, int cwld, float cb) {
    float acc = cb;
#pragma unroll
    for (int k = 0; k < 4; ++k) { const int tt = t0 + l - 3 + k; if (tt >= 0) acc += cw[k * cwld] * bf2f(proj[(size_t)(R0 + l - 3 + k) * PROJW + col]); }
    return acc;
}

__device__ __forceinline__ void lru_head_av(const Params& p, int l_, const bf16_t* proj, int R0, int t0, int h, LAS float* ub, LAS float* was, LAS float* wxs, LAS float* av, LAS float* vv) {
    const int tid = opaque_tid();
    const float* cw = p.lru_conv_w + (size_t)l_ * 4 * 1024; const float* cb = p.lru_conv_b + l_ * 1024;
    for (int i = tid; i < 64 * 64; i += NTHR) { was[i] = p.lru_wa[((size_t)l_ * 16 + h) * 4096 + i]; wxs[i] = p.lru_wx[((size_t)l_ * 16 + h) * 4096 + i]; }
    for (int i = tid; i < 128 * 64; i += NTHR) { const int l = i >> 6, j = i & 63, col = h * 64 + j; ub[i] = conv4(proj, R0, t0, l, O_LX + col, cw + col, 1024, cb[col]); }
    __syncthreads();
    { const int l = tid >> 2, jb = (tid & 3) * 16;
        float ra[16], ia[16];
#pragma unroll
        for (int q = 0; q < 16; ++q) { ra[q] = 0.f; ia[q] = 0.f; }
        for (int i = 0; i < 64; ++i) { const float uv = ub[l * 64 + i];
#pragma unroll
            for (int q = 0; q < 16; ++q) { ra[q] += uv * was[i * 64 + jb + q]; ia[q] += uv * wxs[i * 64 + jb + q]; } }
#pragma unroll
        for (int q = 0; q < 16; ++q) { const int j = jb + q, col = h * 64 + j;
            const float r = sigmoid_f(ra[q] + p.lru_ba[l_ * 1024 + col]), ig = sigmoid_f(ia[q] + p.lru_bx[l_ * 1024 + col]);
            const float lam = p.lru_lambda[l_ * 1024 + col];
            const float log_a = 8.f * r * (-softplus_f(-lam));
            const float a = __expf(log_a); const float mult = sqrtf(fmaxf(0.f, -expm1f(2.f * log_a)));
            av[l * 64 + j] = a; vv[l * 64 + j] = mult * (ig * ub[l * 64 + j]); }
    }
    __syncthreads();
}

__device__ __forceinline__ void ssd_dt(const Params& p, int l_, int R0, int g, LAS float* dtv, LAS float* acs) {
    const int tid = opaque_tid(); const float* dtraw = (const float*)(p.ws + WS_DTRAW);
    if (tid < 4) { const int h = 4 * g + tid; const float bias = p.ssd_dt_bias[l_ * 16 + h], A = -__expf(p.ssd_a_log[l_ * 16 + h]); float cum = 0.f;
        for (int l = 0; l < 128; ++l) { const float dt = softplus_f(dtraw[(size_t)(R0 + l) * 16 + h] + bias); cum += dt * A; dtv[tid * 128 + l] = dt; acs[tid * 128 + l] = cum; } }
}

__device__ __forceinline__ void ph_mixA(const Params& p, int l_, LAS unsigned char* lds) {
    const int tid = opaque_tid();
    const bf16_t* proj = (const bf16_t*)(p.ws + WS_PROJ);
    float* states = (float*)(p.ws + WS_STATES); float* decay = (float*)(p.ws + WS_DECAY); float* lsum = (float*)(p.ws + WS_LSUM);
    LAS float* xh = (LAS float*)(lds);
    LAS float* Bc = (LAS float*)(lds + 32768);
    LAS float* dtv = (LAS float*)(lds + 98304);
    LAS float* acs = (LAS float*)(lds + 100352);
    LAS float* was = (LAS float*)(lds + 102400);
    LAS float* wxs = (LAS float*)(lds + 118784);
    const float* cw = p.ssd_conv_w + (size_t)l_ * 4 * SSD_CD; const float* cb = p.ssd_conv_b + l_ * SSD_CD;
    for (int u = blockIdx.x; u < NB * NCH * 4; u += gridDim.x) {
        const int g = u & 3, c = (u >> 2) & 63, b = u >> 8; const int t0 = c * CH, R0 = b * SEQ + t0;
        for (int i = tid; i < 128 * 128; i += NTHR) { const int l = i >> 7, n = i & 127, cc = 1024 + g * 128 + n;
            Bc[i] = silu_f(conv4(proj, R0, t0, l, O_XS + cc, cw + cc, SSD_CD, cb[cc])); }
        ssd_dt(p, l_, R0, g, dtv, acs);
        __syncthreads();
        for (int hh = 0; hh < 4; ++hh) { const int h = 4 * g + hh;
            const float alast = acs[hh * 128 + 127];
            for (int i = tid; i < 128 * 64; i += NTHR) { const int l = i >> 6, pp = i & 63, cc = h * 64 + pp;
                xh[i] = silu_f(conv4(proj, R0, t0, l, O_XS + cc, cw + cc, SSD_CD, cb[cc])) * dtv[hh * 128 + l] * __expf(alast - acs[hh * 128 + l]); }
            __syncthreads();
            { const int pp = tid >> 3, nb = (tid & 7) * 16; float a16[16];
#pragma unroll
                for (int q = 0; q < 16; ++q) a16[q] = 0.f;
                for (int l = 0; l < 128; ++l) { const float xv = xh[l * 64 + pp];
#pragma unroll
                    for (int q = 0; q < 16; ++q) a16[q] += xv * Bc[l * 128 + nb + q]; }
                float* st = states + ((size_t)((b * NCH + c) * 16 + h)) * 8192 + pp * 128 + nb;
#pragma unroll
                for (int q = 0; q < 16; q += 4) *(f32x4*)(st + q) = (f32x4){a16[q], a16[q + 1], a16[q + 2], a16[q + 3]};
                if (tid == 0) decay[(b * NCH + c) * 16 + h] = __expf(alast);
            }
            __syncthreads();
        }
        LAS float* av = Bc; LAS float* vv = Bc + 128 * 64;
        for (int hh = 0; hh < 4; ++hh) { const int h = 4 * g + hh;
            lru_head_av(p, l_, proj, R0, t0, h, xh, was, wxs, av, vv);
            if (tid < 64) { float P = 1.f, hc = 0.f;
                for (int l = 0; l < 128; ++l) { const float a = av[l * 64 + tid]; hc = a * hc + vv[l * 64 + tid]; P *= a; }
                float* o = lsum + ((size_t)(b * NCH + c) * 1024 + h * 64 + tid) * 2; o[0] = P; o[1] = hc; }
            __syncthreads();
        }
    }
}

__device__ __forceinline__ void ph_scan(const Params& p) {
    float* states = (float*)(p.ws + WS_STATES); const float* decay = (const float*)(p.ws + WS_DECAY);
    const float* lsum = (const float*)(p.ws + WS_LSUM); float* lcarry = (float*)(p.ws + WS_LCARRY);
    const int gt = blockIdx.x * NTHR + opaque_tid(), NGT = gridDim.x * NTHR;
    for (int e = gt; e < NB * 16 * 8192 / 4; e += NGT) {
        const int q = e & 2047, h = (e >> 11) & 15, b = e >> 15;
        f32x4 r = (f32x4){0.f, 0.f, 0.f, 0.f};
        for (int c = 0; c < NCH; ++c) { f32x4* sp = (f32x4*)(states + ((size_t)((b * NCH + c) * 16 + h)) * 8192) + q; const f32x4 t = *sp; *sp = r; r = r * decay[(b * NCH + c) * 16 + h] + t; }
    }
    for (int e = gt; e < NB * 1024; e += NGT) { const int ch = e & 1023, b = e >> 10; float r = 0.f;
        for (int c = 0; c < NCH; ++c) { const size_t i = (size_t)(b * NCH + c) * 1024 + ch; lcarry[i] = r; r = lsum[i * 2] * r + lsum[i * 2 + 1]; } }
}

__device__ __forceinline__ void ph_mixB(const Params& p, int l_, LAS unsigned char* lds) {
    const int tid = opaque_tid();
    const bf16_t* proj = (const bf16_t*)(p.ws + WS_PROJ); bf16_t* mix = (bf16_t*)(p.ws + WS_MIX); float* rowss = (float*)(p.ws + WS_ROWSS);
    const float* states = (const float*)(p.ws + WS_STATES); const float* lcarry = (const float*)(p.ws + WS_LCARRY);
    LAS bf16_t* Bc = (LAS bf16_t*)(lds);
    LAS bf16_t* Cc = (LAS bf16_t*)(lds + 32768);
    LAS bf16_t* Sc = (LAS bf16_t*)(lds + 65536);
    LAS float* xh = (LAS float*)(lds + 98304);
    LAS bf16_t* pv = (LAS bf16_t*)(lds + 131072);
    LAS float* dtv = (LAS float*)(lds + 147456);
    LAS float* acs = (LAS float*)(lds + 149504);
    LAS float* was = (LAS float*)(lds); LAS float* wxs = (LAS float*)(lds + 16384); LAS float* av = (LAS float*)(lds + 32768); LAS float* vv = (LAS float*)(lds + 65536);
    const float* cw = p.ssd_conv_w + (size_t)l_ * 4 * SSD_CD; const float* cb = p.ssd_conv_b + l_ * SSD_CD;
    for (int u = blockIdx.x; u < NB * NCH * 4; u += gridDim.x) {
        const int g = u & 3, c = (u >> 2) & 63, b = u >> 8; const int t0 = c * CH, R0 = b * SEQ + t0;
        for (int i = tid; i < 128 * 128; i += NTHR) { const int l = i >> 7, n = i & 127, cb_ = 1024 + g * 128 + n, cc_ = 1536 + g * 128 + n;
            Bc[i] = (bf16_t)f2bf(silu_f(conv4(proj, R0, t0, l, O_XS + cb_, cw + cb_, SSD_CD, cb[cb_])));
            Cc[i] = (bf16_t)f2bf(silu_f(conv4(proj, R0, t0, l, O_XS + cc_, cw + cc_, SSD_CD, cb[cc_]))); }
        ssd_dt(p, l_, R0, g, dtv, acs);
        __syncthreads();
        { const int l = tid >> 2, sb = (tid & 3) * 32;
            for (int s = sb; s < sb + 32; ++s) { float d = 0.f;
                if (s <= l) { for (int n = 0; n < 128; ++n) d += bf2f(Cc[l * 128 + n]) * bf2f(Bc[s * 128 + n]); }
                Sc[l * 128 + s] = (bf16_t)f2bf(d); } }
        __syncthreads();
        float ssq = 0.f;
        for (int hh = 0; hh < 4; ++hh) { const int h = 4 * g + hh;
            for (int i = tid; i < 128 * 64; i += NTHR) { const int l = i >> 6, pp = i & 63, cc = h * 64 + pp; xh[i] = silu_f(conv4(proj, R0, t0, l, O_XS + cc, cw + cc, SSD_CD, cb[cc])); }
            { const float* st = states + ((size_t)((b * NCH + c) * 16 + h)) * 8192; for (int i = tid; i < 8192; i += NTHR) pv[i] = (bf16_t)f2bf(st[i]); }
            __syncthreads();
            { const int l = tid >> 2, pb = (tid & 3) * 16; float yd[16], yo[16];
#pragma unroll
                for (int q = 0; q < 16; ++q) { yd[q] = 0.f; yo[q] = 0.f; }
                const float al = acs[hh * 128 + l];
                for (int s = 0; s <= l; ++s) { const float w = bf2f(Sc[l * 128 + s]) * __expf(al - acs[hh * 128 + s]) * dtv[hh * 128 + s];
#pragma unroll
                    for (int q = 0; q < 16; ++q) yd[q] += w * xh[s * 64 + pb + q]; }
                for (int n = 0; n < 128; ++n) { const float cv = bf2f(Cc[l * 128 + n]);
#pragma unroll
                    for (int q = 0; q < 16; ++q) yo[q] += cv * bf2f(pv[(pb + q) * 128 + n]); }
                const float eal = __expf(al), Dh = p.ssd_d[l_ * 16 + h];
#pragma unroll
                for (int q = 0; q < 16; ++q) { const int pp = pb + q;
                    float y = yd[q] + eal * yo[q] + Dh * xh[l * 64 + pp];
                    const float z = bf2f(proj[(size_t)(R0 + l) * PROJW + O_Z + h * 64 + pp]);
                    y *= silu_f(z); ssq += y * y;
                    mix[(size_t)(R0 + l) * 2048 + 1024 + h * 64 + pp] = (bf16_t)f2bf(y); }
            }
            __syncthreads();
        }
        ssq += SWZ_XOR(ssq, 1); ssq += SWZ_XOR(ssq, 2);
        if ((tid & 3) == 0) rowss[(size_t)(R0 + (tid >> 2)) * 8 + 4 + g] = ssq;
        float lsq = 0.f;
        for (int hh = 0; hh < 4; ++hh) { const int h = 4 * g + hh;
            lru_head_av(p, l_, proj, R0, t0, h, xh, was, wxs, av, vv);
            if (tid < 64) { float hc = lcarry[(size_t)(b * NCH + c) * 1024 + h * 64 + tid];
                for (int l = 0; l < 128; ++l) { hc = av[l * 64 + tid] * hc + vv[l * 64 + tid]; vv[l * 64 + tid] = hc; } }
            __syncthreads();
            { const int l = tid >> 2, jb = (tid & 3) * 16;
#pragma unroll
                for (int q = 0; q < 16; ++q) { const int j = jb + q; const float gt = bf2f(proj[(size_t)(R0 + l) * PROJW + O_LG + h * 64 + j]);
                    const float y = gelu_tanh_f(gt) * vv[l * 64 + j]; lsq += y * y; mix[(size_t)(R0 + l) * 2048 + h * 64 + j] = (bf16_t)f2bf(y); } }
            __syncthreads();
        }
        lsq += SWZ_XOR(lsq, 1); lsq += SWZ_XOR(lsq, 2);
        if ((tid & 3) == 0) rowss[(size_t)(R0 + (tid >> 2)) * 8 + g] = lsq;
        __syncthreads();
    }
}

__device__ __forceinline__ void ph_router(const Params& p, int l) {
    const int tid = opaque_tid(), lane = tid & 63, wave = tid >> 6;
    const int gw = blockIdx.x * 8 + wave, NGW = gridDim.x * 8;
    bf16_t* hb = (bf16_t*)(p.ws + WS_H); int* cnt = (int*)(p.ws + WS_CTL); int* ltok = (int*)(p.ws + WS_LTOK); float* lw = (float*)(p.ws + WS_LW);
    const float* nw = p.norm_ffn + l * DM; const float* wc = p.w_coarse + (size_t)l * DM * 4; const float* wf = p.w_fine + (size_t)l * 4 * DM * 8;
    for (int row = gw; row < NTOK; row += NGW) {
        f32x4 v[4]; float ss = 0.f;
#pragma unroll
        for (int j = 0; j < 4; ++j) { v[j] = *(const f32x4*)(p.X + (size_t)row * DM + j * 256 + lane * 4); ss += (v[j].x * v[j].x + v[j].y * v[j].y) + (v[j].z * v[j].z + v[j].w * v[j].w); }
        const float rstd = rsqrtf(wave_sum(ss) * (1.f / DM) + 1e-6f);
        float cl[4] = {0.f, 0.f, 0.f, 0.f};
#pragma unroll
        for (int j = 0; j < 4; ++j) { const f32x4 w = *(const f32x4*)(nw + j * 256 + lane * 4); v[j] = v[j] * rstd * w;
            u32x2 o; o.x = pk2(v[j].x, v[j].y); o.y = pk2(v[j].z, v[j].w); *(u32x2*)(hb + (size_t)row * DM + j * 256 + lane * 4) = o;
#pragma unroll
            for (int e = 0; e < 4; ++e) { const f32x4 c4 = *(const f32x4*)(wc + (size_t)(j * 256 + lane * 4 + e) * 4); const float xv = v[j][e];
                cl[0] += xv * c4.x; cl[1] += xv * c4.y; cl[2] += xv * c4.z; cl[3] += xv * c4.w; } }
#pragma unroll
        for (int q = 0; q < 4; ++q) cl[q] = wave_sum(cl[q]) + p.b_coarse[l * 4 + q];
        int gi = 0; float cm = cl[0];
#pragma unroll
        for (int q = 1; q < 4; ++q) if (cl[q] > cm) { cm = cl[q]; gi = q; }
        float den = 0.f;
#pragma unroll
        for (int q = 0; q < 4; ++q) den += __expf(cl[q] - cm);
        const float gwt = 1.f / den;
        float fl[8];
#pragma unroll
        for (int q = 0; q < 8; ++q) fl[q] = 0.f;
        const float* wfg = wf + (size_t)gi * DM * 8;
#pragma unroll
        for (int j = 0; j < 4; ++j)
#pragma unroll
            for (int e = 0; e < 4; ++e) { const float* wp = wfg + (size_t)(j * 256 + lane * 4 + e) * 8; const f32x4 a = *(const f32x4*)wp, b2 = *(const f32x4*)(wp + 4); const float xv = v[j][e];
                fl[0] += xv * a.x; fl[1] += xv * a.y; fl[2] += xv * a.z; fl[3] += xv * a.w; fl[4] += xv * b2.x; fl[5] += xv * b2.y; fl[6] += xv * b2.z; fl[7] += xv * b2.w; }
#pragma unroll
        for (int q = 0; q < 8; ++q) fl[q] = wave_sum(fl[q]) + p.b_fine[(l * 4 + gi) * 8 + q];
        int i0 = 0; float v0 = fl[0];
#pragma unroll
        for (int q = 1; q < 8; ++q) if (fl[q] > v0) { v0 = fl[q]; i0 = q; }
        int i1 = -1; float v1 = -3.0e38f;
#pragma unroll
        for (int q = 0; q < 8; ++q) if (q != i0 && fl[q] > v1) { v1 = fl[q]; i1 = q; }
        const float e1 = __expf(v1 - v0), w0 = gwt / (1.f + e1), w1 = gwt * e1 / (1.f + e1);
        if (lane == 0) {
            const int ex0 = gi * 8 + i0, ex1 = gi * 8 + i1;
            const int p0 = atomicAdd(cnt + ex0, 1); ltok[(size_t)ex0 * LISTCAP + p0] = row * 2 + 0; lw[(size_t)ex0 * LISTCAP + p0] = w0;
            const int p1 = atomicAdd(cnt + ex1, 1); ltok[(size_t)ex1 * LISTCAP + p1] = row * 2 + 1; lw[(size_t)ex1 * LISTCAP + p1] = w1;
        }
    }
}

__device__ __forceinline__ int moe_tiles(const Params& p, LAS int* tb) {
    const int* cnt = (const int*)(p.ws + WS_CTL);
    __syncthreads();
    if (opaque_tid() == 0) { int s = 0; for (int e = 0; e < NEXP; ++e) { tb[e] = s; s += (cnt[e] + 255) >> 8; } tb[NEXP] = s; }
    __syncthreads();
    return tb[NEXP];
}
struct SchedMoe { LAS const int* tb; int G, c, up; const int* cnt; const int* ltok; const bf16_t* A; const bf16_t* B;
    __device__ __forceinline__ bool next(int i, pg8::Unit& u) const {
        const int L = i * G + c; if (L >= tb[NEXP] * 4) return false;
        const int t = L >> 2, pn = L & 3; int e = 0; while (tb[e + 1] <= t) ++e;
        const int pos0 = (t - tb[e]) * 256;
        u.pm = t; u.pn = pn; u.rows = ltok + (size_t)e * LISTCAP + pos0; u.nrows = cnt[e] - pos0;
        if (up) { u.a = A; u.b = B + ((size_t)e * 1024 + pn * 256) * DM; } else { u.a = A + (size_t)t * 256 * DEXP; u.b = B + ((size_t)e * 1024 + pn * 256) * DEXP; }
        return true; } };
struct EpiUp { static constexpr bool PERM = true; bf16_t* hid;
    __device__ __forceinline__ void operator()(const f32x4 (&acc)[2][2][4][2], const pg8::Unit& u, int wr, int wc, int fr, int fq) const {
        const int row0 = u.pm * 256 + wr * 64 + fr, col0 = u.pn * 128 + wc * 32 + 8 * fq;
#pragma unroll
        for (int ai = 0; ai < 2; ++ai)
#pragma unroll
            for (int m = 0; m < 4; ++m) { float o[8];
#pragma unroll
                for (int n = 0; n < 2; ++n)
#pragma unroll
                    for (int j = 0; j < 4; ++j) o[n * 4 + j] = silu_f(acc[ai][0][m][n][j]) * acc[ai][1][m][n][j];
                u32x4 w; w.x = pg8::cvt_pk_bf16(o[0], o[1]); w.y = pg8::cvt_pk_bf16(o[2], o[3]); w.z = pg8::cvt_pk_bf16(o[4], o[5]); w.w = pg8::cvt_pk_bf16(o[6], o[7]);
                *(u32x4*)(hid + (size_t)(row0 + ai * 128 + m * 16) * DEXP + col0) = w; }
    } };
__device__ __forceinline__ void ph_moe_up(const Params& p, LAS unsigned char* lds) {
    LAS int* tb = (LAS int*)(lds + LDS_TB);
    moe_tiles(p, tb);
    SchedMoe S{tb, (int)gridDim.x, (int)blockIdx.x, 1, (const int*)(p.ws + WS_CTL), (const int*)(p.ws + WS_LTOK), (const bf16_t*)(p.ws + WS_H), (const bf16_t*)(p.ws + WS_WGU)};
    pg8::gemm_phase<EpiUp, SchedMoe, true>(lds, DM, DM, DM, S, EpiUp{(bf16_t*)(p.ws + WS_HID)});
}
struct EpiDown { static constexpr bool PERM = true; bf16_t* ys; const float* lw; const int* ltok;
    __device__ __forceinline__ void operator()(const f32x4 (&acc)[2][2][4][2], const pg8::Unit& u, int wr, int wc, int fr, int fq) const {
        const int col0 = u.pn * 256 + wc * 32 + 8 * fq; const float* lwr = lw + (u.rows - ltok);
#pragma unroll
        for (int ai = 0; ai < 2; ++ai)
#pragma unroll
            for (int m = 0; m < 4; ++m) { const int r = ai * 128 + wr * 64 + m * 16 + fr;
                if (r < u.nrows) { const int tk = u.rows[r]; const float w = lwr[r]; bf16_t* o = ys + ((size_t)(tk & 1) * NTOK + (tk >> 1)) * DM + col0;
#pragma unroll
                    for (int bj = 0; bj < 2; ++bj) { const f32x4 v0 = acc[ai][bj][m][0] * w, v1 = acc[ai][bj][m][1] * w; u32x4 q;
                        q.x = pg8::cvt_pk_bf16(v0[0], v0[1]); q.y = pg8::cvt_pk_bf16(v0[2], v0[3]); q.z = pg8::cvt_pk_bf16(v1[0], v1[1]); q.w = pg8::cvt_pk_bf16(v1[2], v1[3]);
                        *(u32x4*)(o + bj * 128) = q; } } }
    } };
__device__ __forceinline__ void ph_moe_down(const Params& p, LAS unsigned char* lds) {
    LAS int* tb = (LAS int*)(lds + LDS_TB);
    moe_tiles(p, tb);
    SchedMoe S{tb, (int)gridDim.x, (int)blockIdx.x, 0, (const int*)(p.ws + WS_CTL), (const int*)(p.ws + WS_LTOK), (const bf16_t*)(p.ws + WS_HID), (const bf16_t*)(p.ws + WS_WD)};
    pg8::gemm_phase<EpiDown, SchedMoe, false>(lds, DEXP, DEXP, DEXP, S, EpiDown{(bf16_t*)(p.ws + WS_YSLOT), (const float*)(p.ws + WS_LW), (const int*)(p.ws + WS_LTOK)});
}

__device__ __forceinline__ void ph_final(const Params& p) {
    const int tid = opaque_tid(), lane = tid & 63, wave = tid >> 6;
    const int gw = blockIdx.x * 8 + wave, NGW = gridDim.x * 8;
    const bf16_t* ys = (const bf16_t*)(p.ws + WS_YSLOT);
    for (int row = gw; row < NTOK; row += NGW) {
        f32x4 v[4];
#pragma unroll
        for (int j = 0; j < 4; ++j) v[j] = *(const f32x4*)(p.X + (size_t)row * DM + j * 256 + lane * 4);
#pragma unroll
        for (int s = 0; s < 2; ++s)
#pragma unroll
            for (int j = 0; j < 4; ++j) { const u32x2 y = *(const u32x2*)(ys + ((size_t)s * NTOK + row) * DM + j * 256 + lane * 4);
                v[j].x += __uint_as_float(y.x << 16); v[j].y += __uint_as_float(y.x & 0xffff0000u); v[j].z += __uint_as_float(y.y << 16); v[j].w += __uint_as_float(y.y & 0xffff0000u); }
        float ss = 0.f;
#pragma unroll
        for (int j = 0; j < 4; ++j) ss += (v[j].x * v[j].x + v[j].y * v[j].y) + (v[j].z * v[j].z + v[j].w * v[j].w);
        const float rstd = rsqrtf(wave_sum(ss) * (1.f / DM) + 1e-6f);
#pragma unroll
        for (int j = 0; j < 4; ++j) { const f32x4 w = *(const f32x4*)(p.final_norm + j * 256 + lane * 4); *(f32x4*)(p.X + (size_t)row * DM + j * 256 + lane * 4) = v[j] * rstd * w; }
    }
}


#ifndef DBG
#define DBG 0
#endif
#ifndef DBGA
#define DBGA 12
#define DBGB 12
#endif
#if DBG
constexpr size_t WS_MIX2 = 404 * MiB;
constexpr size_t WS_DBG = 470 * MiB;
__global__ void __launch_bounds__(64) dbg_lru_seq(Params p, int l_) {
    const int b = blockIdx.x >> 4, h = blockIdx.x & 15, j = threadIdx.x, col = h * 64 + j;
    const bf16_t* proj = (const bf16_t*)(p.ws + WS_PROJ); bf16_t* mix2 = (bf16_t*)(p.ws + WS_MIX2);
    __shared__ float us[64];
    const float* cw = p.lru_conv_w + (size_t)l_ * 4 * 1024 + col; const float cb = p.lru_conv_b[l_ * 1024 + col];
    const float* wa = p.lru_wa + ((size_t)l_ * 16 + h) * 4096; const float* wx = p.lru_wx + ((size_t)l_ * 16 + h) * 4096;
    const float ba = p.lru_ba[l_ * 1024 + col], bx = p.lru_bx[l_ * 1024 + col], lam = p.lru_lambda[l_ * 1024 + col];
    const float ls = -log1pf(expf(-lam));
    float hc = 0.f;
    for (int t = 0; t < SEQ; ++t) {
        float u = cb;
        for (int k = 0; k < 4; ++k) { const int tt = t - 3 + k; if (tt >= 0) u += cw[k * 1024] * bf2f(proj[(size_t)(b * SEQ + tt) * PROJW + O_LX + col]); }
        __syncthreads(); us[j] = u; __syncthreads();
        float ra = ba, ia = bx;
        for (int i = 0; i < 64; ++i) { ra += us[i] * wa[i * 64 + j]; ia += us[i] * wx[i * 64 + j]; }
        const float r = 1.f / (1.f + expf(-ra)), ig = 1.f / (1.f + expf(-ia));
        const float log_a = 8.f * r * ls, a = expf(log_a), mult = sqrtf(fmaxf(0.f, -expm1f(2.f * log_a)));
        hc = a * hc + mult * (ig * u);
        const float gt = bf2f(proj[(size_t)(b * SEQ + t) * PROJW + O_LG + col]);
        mix2[(size_t)(b * SEQ + t) * 2048 + col] = (bf16_t)f2bf(gelu_tanh_f(gt) * hc);
    }
}
__global__ void __launch_bounds__(512) dbg_ssd_seq(Params p, int l_) {
    const int b = blockIdx.x >> 4, h = blockIdx.x & 15, g = h >> 2, tid = threadIdx.x;
    const bf16_t* proj = (const bf16_t*)(p.ws + WS_PROJ); bf16_t* mix2 = (bf16_t*)(p.ws + WS_MIX2); const float* dtraw = (const float*)(p.ws + WS_DTRAW);
    __shared__ float xs[64], Bs[128], Cs[128];
    const float* cw = p.ssd_conv_w + (size_t)l_ * 4 * SSD_CD; const float* cb = p.ssd_conv_b + l_ * SSD_CD;
    const float bias = p.ssd_dt_bias[l_ * 16 + h], A = -expf(p.ssd_a_log[l_ * 16 + h]), Dh = p.ssd_d[l_ * 16 + h];
    const int pp = tid >> 3, nb = (tid & 7) * 16;
    float st[16];
    for (int q = 0; q < 16; ++q) st[q] = 0.f;
    for (int t = 0; t < SEQ; ++t) {
        __syncthreads();
        if (tid < 320) { int cc; if (tid < 64) cc = h * 64 + tid; else if (tid < 192) cc = 1024 + g * 128 + (tid - 64); else cc = 1536 + g * 128 + (tid - 192);
            float u = cb[cc];
            for (int k = 0; k < 4; ++k) { const int tt = t - 3 + k; if (tt >= 0) u += cw[k * SSD_CD + cc] * bf2f(proj[(size_t)(b * SEQ + tt) * PROJW + O_XS + cc]); }
            u = u / (1.f + expf(-u));
            if (tid < 64) xs[tid] = u; else if (tid < 192) Bs[tid - 64] = u; else Cs[tid - 192] = u; }
        __syncthreads();
        const float dtp = dtraw[(size_t)(b * SEQ + t) * 16 + h] + bias; const float dt = dtp > 20.f ? dtp : log1pf(expf(dtp));
        const float dec = expf(dt * A), xv = xs[pp] * dt;
        float y = 0.f;
        for (int q = 0; q < 16; ++q) { st[q] = dec * st[q] + xv * Bs[nb + q]; y += Cs[nb + q] * st[q]; }
        y += __shfl_xor(y, 1); y += __shfl_xor(y, 2); y += __shfl_xor(y, 4);
        if ((tid & 7) == 0) { y += Dh * xs[pp]; const float z = bf2f(proj[(size_t)(b * SEQ + t) * PROJW + O_Z + h * 64 + pp]); y *= z / (1.f + expf(-z));
            mix2[(size_t)(b * SEQ + t) * 2048 + 1024 + h * 64 + pp] = (bf16_t)f2bf(y); }
    }
}
__global__ void dbg_cmp_mix(Params p) {
    const bf16_t* a = (const bf16_t*)(p.ws + WS_MIX); const bf16_t* b2 = (const bf16_t*)(p.ws + WS_MIX2); float* acc = (float*)(p.ws + WS_DBG);
    float s[4] = {0.f, 0.f, 0.f, 0.f};
    for (size_t i = (size_t)blockIdx.x * blockDim.x + threadIdx.x; i < (size_t)NTOK * 2048; i += (size_t)gridDim.x * blockDim.x) {
        const int col = (int)(i & 2047); const float x = bf2f(a[i]), y = bf2f(b2[i]); const int o = col < 1024 ? 0 : 2; s[o] += (x - y) * (x - y); s[o + 1] += y * y; }
    for (int q = 0; q < 4; ++q) { const float v = wave_sum(s[q]); if ((threadIdx.x & 63) == 0) atomicAdd(acc + q, v); }
}

__global__ void dbg_chk_inproj(Params p, int l) {
    const int sidx = blockIdx.x * blockDim.x + threadIdx.x; float* acc = (float*)(p.ws + WS_DBG);
    const bf16_t* proj = (const bf16_t*)(p.ws + WS_PROJ); const float* dtraw = (const float*)(p.ws + WS_DTRAW);
    unsigned hsh = (unsigned)sidx * 2654435761u + 12345u; hsh ^= hsh >> 13; hsh *= 0x5bd1e995u; hsh ^= hsh >> 15;
    const int row = hsh % NTOK, col = (hsh >> 14) % INC;
    const float* xr = (l == 0 ? p.x : p.X) + (size_t)row * DM; float ss = 0.f;
    for (int k = 0; k < DM; ++k) ss += xr[k] * xr[k];
    const float rstd = 1.f / sqrtf(ss / DM + 1e-6f);
    float d = 0.f;
    for (int k = 0; k < DM; ++k) d += (xr[k] * rstd * p.norm_mix[l * DM + k]) * p.w_in[((size_t)l * DM + k) * INC + col];
    if (col < PROJW) { const float got = bf2f(proj[(size_t)row * PROJW + col]); atomicAdd(acc + 4, (got - d) * (got - d)); atomicAdd(acc + 5, d * d); }
    else { const float got = dtraw[(size_t)row * 16 + col - PROJW]; atomicAdd(acc + 6, (got - d) * (got - d)); atomicAdd(acc + 7, d * d); }
}
__global__ void dbg_chk_outproj(Params p, int l) {
    const int sidx = blockIdx.x * blockDim.x + threadIdx.x; float* acc = (float*)(p.ws + WS_DBG);
    const bf16_t* mix = (const bf16_t*)(p.ws + WS_MIX);
    unsigned hsh = (unsigned)sidx * 2654435761u + 777u; hsh ^= hsh >> 13; hsh *= 0x5bd1e995u; hsh ^= hsh >> 15;
    const int row = hsh % NTOK, col = (hsh >> 14) % DM;
    const bf16_t* mr = mix + (size_t)row * 2048; float s1 = 0.f, s2 = 0.f;
    for (int k = 0; k < 1024; ++k) { const float a = bf2f(mr[k]), b = bf2f(mr[1024 + k]); s1 += a * a; s2 += b * b; }
    const float r1 = 1.f / sqrtf(s1 / 1024.f + 1e-6f), r2 = 1.f / sqrtf(s2 / 1024.f + 1e-6f);
    float d = 0.f;
    for (int k = 0; k < 1024; ++k) { d += bf2f(mr[k]) * r1 * p.lru_norm[l * 1024 + k] * p.w_out[((size_t)l * 2048 + k) * DM + col]; d += bf2f(mr[1024 + k]) * r2 * p.ssd_norm[l * 1024 + k] * p.w_out[((size_t)l * 2048 + 1024 + k) * DM + col]; }
    const float* xb = (l == 0) ? p.x : (const float*)(p.ws + WS_MIX2); const float ref = d, got = p.X[(size_t)row * DM + col] - xb[(size_t)row * DM + col];
    atomicAdd(acc + 8, (got - ref) * (got - ref)); atomicAdd(acc + 9, ref * ref);
}

__global__ void __launch_bounds__(256) dbg_chk_moe(Params p, int l) {
    const int tid = threadIdx.x; float* acc = (float*)(p.ws + WS_DBG); const bf16_t* ys = (const bf16_t*)(p.ws + WS_YSLOT);
    unsigned hsh = (unsigned)blockIdx.x * 2654435761u + 4242u; hsh ^= hsh >> 13; hsh *= 0x5bd1e995u; hsh ^= hsh >> 15;
    const int row = hsh % NTOK;
    __shared__ float hs[1024], hid[512], red[256], outv[4]; __shared__ int ex[2]; __shared__ float ew[2];
    float ss = 0.f; for (int k = tid; k < DM; k += 256) { const float v = p.X[(size_t)row * DM + k]; ss += v * v; }
    red[tid] = ss; __syncthreads(); if (tid == 0) { float t = 0.f; for (int i = 0; i < 256; ++i) t += red[i]; red[0] = 1.f / sqrtf(t / DM + 1e-6f); } __syncthreads();
    const float rstd = red[0];
    for (int k = tid; k < DM; k += 256) hs[k] = p.X[(size_t)row * DM + k] * rstd * p.norm_ffn[l * DM + k];
    __syncthreads();
    if (tid == 0) { float cl[4]; for (int q = 0; q < 4; ++q) { float d = p.b_coarse[l * 4 + q]; for (int k = 0; k < DM; ++k) d += hs[k] * p.w_coarse[((size_t)l * DM + k) * 4 + q]; cl[q] = d; }
        int gi = 0; for (int q = 1; q < 4; ++q) if (cl[q] > cl[gi]) gi = q; float den = 0.f; for (int q = 0; q < 4; ++q) den += expf(cl[q] - cl[gi]);
        float fl[8]; for (int q = 0; q < 8; ++q) { float d = p.b_fine[(l * 4 + gi) * 8 + q]; for (int k = 0; k < DM; ++k) d += hs[k] * p.w_fine[(((size_t)l * 4 + gi) * DM + k) * 8 + q]; fl[q] = d; }
        int i0 = 0; for (int q = 1; q < 8; ++q) if (fl[q] > fl[i0]) i0 = q; int i1 = -1; for (int q = 0; q < 8; ++q) if (q != i0 && (i1 < 0 || fl[q] > fl[i1])) i1 = q;
        const float e1 = expf(fl[i1] - fl[i0]); ex[0] = gi * 8 + i0; ex[1] = gi * 8 + i1; ew[0] = (1.f / den) / (1.f + e1); ew[1] = (1.f / den) * e1 / (1.f + e1); }
    __syncthreads();
    if (tid < 4) outv[tid] = 0.f;
    for (int s2 = 0; s2 < 2; ++s2) { const int e = ex[s2]; const float* wg = p.w_gate + ((size_t)l * NEXP + e) * DM * DEXP; const float* wu = p.w_up + ((size_t)l * NEXP + e) * DM * DEXP; const float* wd = p.w_down + ((size_t)l * NEXP + e) * DEXP * DM;
        __syncthreads();
        for (int j = tid; j < DEXP; j += 256) { float g = 0.f, u = 0.f; for (int k = 0; k < DM; ++k) { g += hs[k] * wg[(size_t)k * DEXP + j]; u += hs[k] * wu[(size_t)k * DEXP + j]; } hid[j] = g / (1.f + expf(-g)) * u; }
        __syncthreads();
        if (tid < 4) { const int col = (hsh >> 16) % 256 + tid * 256; float d = 0.f; for (int j = 0; j < DEXP; ++j) d += hid[j] * wd[(size_t)j * DM + col]; outv[tid] += ew[s2] * d; } }
    __syncthreads();
    if (tid < 4) { const int col = (hsh >> 16) % 256 + tid * 256; const float got = bf2f(ys[(size_t)row * DM + col]) + bf2f(ys[((size_t)NTOK + row) * DM + col]); const float ref = outv[tid];
        atomicAdd(acc + 10, (got - ref) * (got - ref)); atomicAdd(acc + 11, ref * ref); }
}

__global__ void dbg_chk_final(Params p) {
    const int sidx = blockIdx.x * blockDim.x + threadIdx.x; float* acc = (float*)(p.ws + WS_DBG); const bf16_t* ys = (const bf16_t*)(p.ws + WS_YSLOT);
    unsigned hsh = (unsigned)sidx * 2654435761u + 99u; hsh ^= hsh >> 13; hsh *= 0x5bd1e995u; hsh ^= hsh >> 15;
    const int row = hsh % NTOK, col = (hsh >> 14) % DM; const float* xb = (const float*)(p.ws + WS_MIX2) + (size_t)row * DM;
    float ss = 0.f; for (int k = 0; k < DM; ++k) { const float v = xb[k] + bf2f(ys[(size_t)row * DM + k]) + bf2f(ys[((size_t)NTOK + row) * DM + k]); ss += v * v; }
    const float v = xb[col] + bf2f(ys[(size_t)row * DM + col]) + bf2f(ys[((size_t)NTOK + row) * DM + col]);
    const float ref = v / sqrtf(ss / DM + 1e-6f) * p.final_norm[col], got = p.X[(size_t)row * DM + col];
    atomicAdd(acc + 12, (got - ref) * (got - ref)); atomicAdd(acc + 13, ref * ref);
}
__global__ void dbg_zero(Params p) { float* acc = (float*)(p.ws + WS_DBG); if (threadIdx.x < 64) acc[threadIdx.x] = 0.f; }
__device__ __forceinline__ int dbg_digit(float num, float den) { const float d = sqrtf(num / fmaxf(den, 1e-30f)); if (!(d == d)) return 0; const float v = -2.f * log10f(fmaxf(d, 1e-10f)); return v < 0.f ? 0 : (v > 8.f ? 8 : (int)v); }
__global__ void dbg_report(Params p) {
    const float* acc = (const float*)(p.ws + WS_DBG);
    const size_t i = (size_t)blockIdx.x * blockDim.x + threadIdx.x;
    if (i < (size_t)NTOK * DM) p.X[i] = 0.f;
    if (i == 0) { const int a = dbg_digit(acc[DBGA], acc[DBGA + 1]), b = dbg_digit(acc[DBGB], acc[DBGB + 1]); p.X[0] = sqrtf((float)NTOK * DM * (9.f + 10.f * a + b)); }
}
#endif

#define XB_TMO      128
#define XB_XCNT(j)  (256  + 64 * (j))
#define XB_XSUB(j)  (1280 + 64 * (j))
#define XB_XGEN(j)  (2304 + 64 * (j))
#define XB_TOP      3328
#define XB_TOPGEN   3392
#define XCD_BAR_WORDS 3456
#define XB_SPIN_CAP (1u << 22)
constexpr int CW_BAR = 4096;
constexpr size_t CTL_ZERO_BYTES = 65536;
__device__ __forceinline__ unsigned xb_ld(unsigned* p)              { return __hip_atomic_load(p, __ATOMIC_RELAXED, __HIP_MEMORY_SCOPE_AGENT); }
__device__ __forceinline__ unsigned xb_add(unsigned* p, unsigned v) { return __hip_atomic_fetch_add(p, v, __ATOMIC_RELAXED, __HIP_MEMORY_SCOPE_AGENT); }
__device__ __forceinline__ unsigned xb_xcc_id() { return (unsigned)__builtin_amdgcn_s_getreg((3 << 11) | 20) & 0xFu; }
#define XB_SPIN(cond, bar) do { unsigned _sp = 0; while (cond) { __builtin_amdgcn_s_sleep(1); \
    if ((++_sp & 255u) == 0u) { if (xb_ld(&(bar)[XB_TMO])) break; if (_sp > XB_SPIN_CAP) { atomicAdd(&(bar)[XB_TMO], 1u); break; } } } } while (0)
struct XcdBarrier { unsigned* bar; unsigned x; volatile LAS unsigned* st; };
__device__ __forceinline__ XcdBarrier xcd_barrier_post(unsigned* bar, volatile LAS unsigned* st) {
    XcdBarrier b; b.bar = bar; b.x = xb_xcc_id(); b.st = st;
    if (threadIdx.x == 0) (void)xb_add(&bar[XB_XCNT(b.x)], 1u);
    return b;
}
__device__ __forceinline__ void xcd_barrier_complete(unsigned* bar, unsigned x, unsigned G, unsigned& nloc, unsigned& nx) {
    unsigned sum, cnt, mine, sp = 0u;
    for (;;) {
        sum = 0u; cnt = 0u; mine = 0u;
#pragma unroll
        for (unsigned j = 0; j < 16; ++j) { const unsigned c = xb_ld(&bar[XB_XCNT(j)]); sum += c; cnt += (c > 0u) ? 1u : 0u; mine = (j == x) ? c : mine; }
        if (sum == G) break;
        __builtin_amdgcn_s_sleep(1);
        if ((++sp & 255u) == 0u) { if (xb_ld(&bar[XB_TMO])) break; if (sp > XB_SPIN_CAP) { atomicAdd(&bar[XB_TMO], 1u); break; } }
    }
    nloc = mine > 0u ? mine : 1u; nx = cnt > 0u ? cnt : 1u;
}
__device__ __forceinline__ void xcd_barrier(const XcdBarrier& b) {
    asm volatile("s_waitcnt vmcnt(0)" ::: "memory");
    __syncthreads();
    if (threadIdx.x == 0) {
        size_t zb_; asm volatile("s_mov_b64 %0, 0" : "=s"(zb_)); unsigned* bar = b.bar + zb_;
        __builtin_amdgcn_s_waitcnt(0);
        const unsigned nloc = b.st[0], nx = b.st[1];
        unsigned bx = b.x; asm volatile("" : "+s"(bx));
        const unsigned old = xb_add(&bar[XB_XSUB(bx)], 1u);
        const unsigned gen = old / nloc;
        if (old + 1u == (gen + 1u) * nloc) {
            __builtin_amdgcn_fence(__ATOMIC_RELEASE, "agent");
            asm volatile("s_waitcnt vmcnt(0)" ::: "memory");
            const unsigned og = xb_add(&bar[XB_TOP], 1u);
            const unsigned tg = og / nx;
            if (og + 1u == (tg + 1u) * nx) xb_add(&bar[XB_TOPGEN], 1u);
            else XB_SPIN(xb_ld(&bar[XB_TOPGEN]) == tg, bar);
            __builtin_amdgcn_fence(__ATOMIC_ACQUIRE, "agent");
            xb_add(&bar[XB_XGEN(bx)], 1u);
            asm volatile("s_waitcnt vmcnt(0)" ::: "memory");
        } else {
            XB_SPIN(xb_ld(&bar[XB_XGEN(bx)]) == gen, bar);
            __builtin_amdgcn_fence(__ATOMIC_ACQUIRE, "agent");
            asm volatile("s_waitcnt vmcnt(0)" ::: "memory");
        }
    }
    __syncthreads();
}
enum { PH_CONVERT = 0, PH_NORM, PH_INPROJ, PH_MIXA, PH_SCAN, PH_MIXB, PH_OUTPROJ, PH_ROUTER, PH_MOEUP, PH_MOEDOWN, PH_FINAL };

template <int PH>
__device__ __forceinline__ void run_phase(const Params& p, int l, LAS unsigned char* lds) {
    if (PH == PH_CONVERT) ph_convert(p, l, lds);
    if (PH == PH_NORM) ph_norm(p, l);
    if (PH == PH_INPROJ) ph_inproj(p, lds);
    if (PH == PH_MIXA) ph_mixA(p, l, lds);
    if (PH == PH_SCAN) ph_scan(p);
    if (PH == PH_MIXB) ph_mixB(p, l, lds);
    if (PH == PH_OUTPROJ) ph_outproj(p, l, lds);
    if (PH == PH_ROUTER) ph_router(p, l);
    if (PH == PH_MOEUP) ph_moe_up(p, lds);
    if (PH == PH_MOEDOWN) ph_moe_down(p, lds);
    if (PH == PH_FINAL) ph_final(p);
}

template <int PH>
__global__ void __launch_bounds__(NTHR) k_phase(Params p, int l) {
    extern __shared__ __attribute__((aligned(16))) unsigned char lds_raw[];
    run_phase<PH>(p, l, (LAS unsigned char*)lds_raw);
}

#if ONE_LAUNCH
#ifndef USE_CG
#define USE_CG 0
#endif
__global__ void __launch_bounds__(NTHR, 2) k_mega(Params p) {
    extern __shared__ __attribute__((aligned(16))) unsigned char lds_raw[];
    LAS unsigned char* lds = (LAS unsigned char*)lds_raw;
#if USE_CG
    cg::grid_group grid = cg::this_grid();
#define GRID_BAR() grid.sync()
#else
    if (threadIdx.x < 64) ((volatile LAS unsigned*)(lds + LDS_MISC))[threadIdx.x] = 0u;
    __syncthreads();
    const XcdBarrier bar = xcd_barrier_post((unsigned*)(p.ws + WS_CTL) + CW_BAR, (volatile LAS unsigned*)(lds + LDS_MISC));
    { const unsigned Gn = gridDim.x; if (threadIdx.x == 0) { unsigned nloc, nx; xcd_barrier_complete(bar.bar, bar.x, Gn, nloc, nx); bar.st[0] = nloc; bar.st[1] = nx; } }
    __syncthreads();
#define GRID_BAR() xcd_barrier(bar)
#endif
#define FRESH() Params q = p; int lv; { size_t z_; int lz_; asm volatile("s_mov_b64 %0, 0\n\ts_mov_b32 %1, 0" : "=s"(z_), "=s"(lz_)); q.ws = p.ws + z_; lv = l + lz_; }
#pragma unroll 1
    for (int l = 0; l < DEPTH; ++l) {
        { FRESH(); ph_convert(q, lv, lds); } { FRESH(); ph_norm(q, lv); } GRID_BAR();
        { FRESH(); ph_inproj(q, lds); } GRID_BAR();
        { FRESH(); ph_mixA(q, lv, lds); } GRID_BAR();
        { FRESH(); ph_scan(q); } GRID_BAR();
        { FRESH(); ph_mixB(q, lv, lds); } GRID_BAR();
        { FRESH(); ph_outproj(q, lv, lds); } GRID_BAR();
        { FRESH(); ph_router(q, lv); } GRID_BAR();
        { FRESH(); ph_moe_up(q, lds); } GRID_BAR();
        { FRESH(); ph_moe_down(q, lds); } GRID_BAR();
    }
    { const int l = 0; FRESH(); (void)lv; ph_final(q); }
}
#endif

template <int PH> static void launch_phase(const Params& p, int l, int grid, hipStream_t stream) {
    static bool attr = false;
    if (!attr) { (void)hipFuncSetAttribute((const void*)k_phase<PH>, hipFuncAttributeMaxDynamicSharedMemorySize, LDS_BYTES); attr = true; }
    hipLaunchKernelGGL(k_phase<PH>, dim3(grid), dim3(NTHR), LDS_BYTES, stream, p, l);
}

extern "C" void kernel_launch(void* const* d_in, const int* in_sizes, int n_in, void* d_out, int out_size, void* d_ws, size_t ws_size, hipStream_t stream) {
    if (n_in != 27 || in_sizes[0] != NTOK * DM || out_size != NTOK * DM || ws_size < WS_END) {
        fprintf(stderr, "kernel_launch: unexpected shapes (n_in %d, in0 %d, out %d, ws %zu)\n", n_in, n_in > 0 ? in_sizes[0] : -1, out_size, ws_size); return; }
    Params p{};
    const float** f = (const float**)&p;
    for (int i = 0; i < 27; ++i) f[i] = (const float*)d_in[i];
    p.X = (float*)d_out; p.ws = (unsigned char*)d_ws;
#if DBG
    { const int G = 256;
      launch_phase<PH_CONVERT>(p, 0, G, stream); launch_phase<PH_NORM>(p, 0, G, stream); launch_phase<PH_INPROJ>(p, 0, G, stream);
      launch_phase<PH_MIXA>(p, 0, G, stream); launch_phase<PH_SCAN>(p, 0, G, stream); launch_phase<PH_MIXB>(p, 0, G, stream);
      launch_phase<PH_OUTPROJ>(p, 0, G, stream);
      launch_phase<PH_ROUTER>(p, 0, G, stream); launch_phase<PH_MOEUP>(p, 0, G, stream); launch_phase<PH_MOEDOWN>(p, 0, G, stream);
      launch_phase<PH_CONVERT>(p, 1, G, stream); launch_phase<PH_NORM>(p, 1, G, stream); launch_phase<PH_INPROJ>(p, 1, G, stream);
      launch_phase<PH_MIXA>(p, 1, G, stream); launch_phase<PH_SCAN>(p, 1, G, stream); launch_phase<PH_MIXB>(p, 1, G, stream);
      launch_phase<PH_OUTPROJ>(p, 1, G, stream);
      launch_phase<PH_ROUTER>(p, 1, G, stream); launch_phase<PH_MOEUP>(p, 1, G, stream); launch_phase<PH_MOEDOWN>(p, 1, G, stream);
      (void)hipMemcpyAsync(p.ws + WS_MIX2, p.X, (size_t)NTOK * DM * 4, hipMemcpyDeviceToDevice, stream);
      launch_phase<PH_FINAL>(p, 0, G, stream);
      hipLaunchKernelGGL(dbg_zero, dim3(1), dim3(64), 0, stream, p);
      hipLaunchKernelGGL(dbg_chk_final, dim3(64), dim3(64), 0, stream, p);
      hipLaunchKernelGGL(dbg_report, dim3(NTOK * DM / 256), dim3(256), 0, stream, p);
      return; }
#endif
#if ONE_LAUNCH
    static int grid = 0;
    if (!grid) { int dev = 0, cus = 0, per_cu = 0; (void)hipGetDevice(&dev); (void)hipDeviceGetAttribute(&cus, hipDeviceAttributeMultiprocessorCount, dev);
        (void)hipFuncSetAttribute((const void*)k_mega, hipFuncAttributeMaxDynamicSharedMemorySize, LDS_BYTES);
        (void)hipOccupancyMaxActiveBlocksPerMultiprocessor(&per_cu, (const void*)k_mega, NTHR, LDS_BYTES);
        if (per_cu < 1) fprintf(stderr, "kernel_launch: occupancy query says %d blocks/CU\n", per_cu);
        (void)hipGetLastError();
        grid = cus; }
#if USE_CG
    void* args[] = {&p};
    hipError_t e = hipLaunchCooperativeKernel((const void*)k_mega, dim3(grid), dim3(NTHR), args, LDS_BYTES, stream);
    if (e != hipSuccess) fprintf(stderr, "cooperative launch failed: %s (grid %d)\n", hipGetErrorString(e), grid);
#else
    (void)hipMemsetAsync((char*)d_ws + WS_CTL, 0, CTL_ZERO_BYTES, stream);
    hipLaunchKernelGGL(k_mega, dim3(grid), dim3(NTHR), LDS_BYTES, stream, p);
#endif
#else
    const int G = 256;
    for (int l = 0; l < DEPTH; ++l) {
        launch_phase<PH_CONVERT>(p, l, G, stream);
        launch_phase<PH_NORM>(p, l, G, stream);
        launch_phase<PH_INPROJ>(p, l, G, stream);
        launch_phase<PH_MIXA>(p, l, G, stream);
        launch_phase<PH_SCAN>(p, l, G, stream);
        launch_phase<PH_MIXB>(p, l, G, stream);
        launch_phase<PH_OUTPROJ>(p, l, G, stream);
        launch_phase<PH_ROUTER>(p, l, G, stream);
        launch_phase<PH_MOEUP>(p, l, G, stream);
        launch_phase<PH_MOEDOWN>(p, l, G, stream);
    }
    launch_phase<PH_FINAL>(p, 0, G, stream);
#endif
}
```

```cpp
#include <hip/hip_runtime.h>
#include <hip/hip_cooperative_groups.h>
#include <cstdint>
#include <cstdio>
namespace cg = cooperative_groups;

#ifndef ONE_LAUNCH
#define ONE_LAUNCH 1
#endif

#define LAS __attribute__((address_space(3)))
typedef unsigned short bf16_t;
typedef short bf16x8 __attribute__((ext_vector_type(8)));
typedef float f32x4 __attribute__((ext_vector_type(4)));
typedef unsigned u32x2 __attribute__((ext_vector_type(2)));
typedef unsigned u32x4 __attribute__((ext_vector_type(4)));

constexpr int NB = 2, SEQ = 8192, DM = 1024, NTOK = NB * SEQ, DEPTH = 2;
constexpr int INC = 5136, PROJW = 5120;
constexpr int SSD_CD = 2048;
constexpr int O_LX = 0, O_LG = 1024, O_Z = 2048, O_XS = 3072, O_B = 4096, O_C = 4608;
constexpr int NEXP = 32, DEXP = 512, NCH = 64, CH = 128;
constexpr int NTHR = 512;
constexpr int MAXTILES = 160;
constexpr int LISTCAP = NTOK;

constexpr size_t MiB = 1u << 20;
constexpr size_t WS_CTL = 0;
constexpr size_t WS_WIN = 1 * MiB;
constexpr size_t WS_WOUT = 11 * MiB;
constexpr size_t WS_WGU = 15 * MiB;
constexpr size_t WS_WD = 79 * MiB;
constexpr size_t WS_PROJ = 111 * MiB;
constexpr size_t WS_H = WS_PROJ;
constexpr size_t WS_HID = WS_PROJ + 32 * MiB;
constexpr size_t WS_YSLOT = WS_PROJ + 72 * MiB;
constexpr size_t WS_LTOK = WS_PROJ + 136 * MiB;
constexpr size_t WS_LW = WS_PROJ + 138 * MiB;
constexpr size_t WS_MIX = 271 * MiB;
constexpr size_t WS_XN = WS_MIX;
constexpr size_t WS_STATES = 335 * MiB;
constexpr size_t WS_DTRAW = 399 * MiB;
constexpr size_t WS_ROWSS = 400 * MiB;
constexpr size_t WS_LSUM = 401 * MiB;
constexpr size_t WS_LCARRY = 402 * MiB;
constexpr size_t WS_DECAY = 403 * MiB;
constexpr size_t WS_PREV = 472 * MiB;
constexpr size_t WS_WAT = 504 * MiB;
constexpr size_t WS_END = 505 * MiB;

constexpr int LDS_BYTES = 152 * 1024;
constexpr int LDS_TB = 151552 + 256;
constexpr int LDS_MISC = 151552;

struct Params {
    const float *x, *norm_mix, *w_in, *lru_conv_w, *lru_conv_b, *lru_wa, *lru_ba, *lru_wx, *lru_bx, *lru_lambda, *lru_norm,
        *ssd_conv_w, *ssd_conv_b, *ssd_dt_bias, *ssd_a_log, *ssd_d, *ssd_norm, *w_out, *norm_ffn, *w_coarse, *b_coarse, *w_fine, *b_fine,
        *w_gate, *w_up, *w_down, *final_norm;
    float* X;
    unsigned char* ws;
};

__device__ __forceinline__ float bf2f(bf16_t v) { return __uint_as_float((unsigned)v << 16); }
__device__ __forceinline__ unsigned f2bf(float f) { unsigned u = __float_as_uint(f); return (u + 0x7fffu + ((u >> 16) & 1u)) >> 16; }
__device__ __forceinline__ unsigned pk2(float lo, float hi) { return f2bf(lo) | (f2bf(hi) << 16); }
#define SWZ_XOR(v, m) __builtin_bit_cast(float, __builtin_amdgcn_ds_swizzle(__builtin_bit_cast(int, (v)), ((m) << 10) | 0x1f))
__device__ __forceinline__ float wave_sum(float v) {
    v += SWZ_XOR(v, 1); v += SWZ_XOR(v, 2); v += SWZ_XOR(v, 4); v += SWZ_XOR(v, 8); v += SWZ_XOR(v, 16);
    return __builtin_bit_cast(float, __builtin_amdgcn_readlane(__builtin_bit_cast(int, v), 0)) + __builtin_bit_cast(float, __builtin_amdgcn_readlane(__builtin_bit_cast(int, v), 32));
}
__device__ __forceinline__ float sigmoid_f(float x) { return 1.f / (1.f + __expf(-x)); }
__device__ __forceinline__ float silu_f(float x) { return x * sigmoid_f(x); }
__device__ __forceinline__ float softplus_f(float x) { return x > 20.f ? x : log1pf(__expf(x)); }
__device__ __forceinline__ float gelu_tanh_f(float x) { const float u = 0.7978845608028654f * (x + 0.044715f * x * x * x); return 0.5f * x * (1.f + tanhf(u)); }

__device__ __forceinline__ int opaque_tid() { int t = threadIdx.x; asm volatile("" : "+v"(t)); return t; }
#define LDS_WAIT() asm volatile("s_waitcnt lgkmcnt(0)" ::: "memory")
#define VM_WAIT() asm volatile("s_waitcnt vmcnt(0)" ::: "memory")

__device__ __forceinline__ void tr_item(const float* src, int ld, int k0, int c0, bf16_t* dst, int ldd, int r0, const float* kscale, LAS float* scr, int lane) {
#pragma unroll 8
    for (int i = 0; i < 32; ++i) {
        const int kk = 2 * i + (lane >> 5), nn = lane & 31;
        float v = src[(size_t)(k0 + kk) * ld + c0 + nn];
        if (kscale) v *= kscale[k0 + kk];
        scr[kk * 33 + nn] = v;
    }
    LDS_WAIT();
    const int c = lane & 7;
#pragma unroll
    for (int j = 0; j < 4; ++j) {
        const int n = (lane >> 3) + 8 * j; const LAS float* s = scr + (8 * c) * 33 + n;
        u32x4 o; o.x = pk2(s[0 * 33], s[1 * 33]); o.y = pk2(s[2 * 33], s[3 * 33]); o.z = pk2(s[4 * 33], s[5 * 33]); o.w = pk2(s[6 * 33], s[7 * 33]);
        *(u32x4*)(dst + (size_t)(r0 + n) * ldd + k0 + 8 * c) = o;
    }
    LDS_WAIT();
}

__device__ __forceinline__ void ph_convert(const Params& p, int l, LAS unsigned char* lds) {
    const int tid = opaque_tid(), lane = tid & 63, wave = tid >> 6;
    LAS float* scr = (LAS float*)(lds + wave * 16384);
    const int gw = blockIdx.x * 8 + wave, NGW = gridDim.x * 8;
    bf16_t* WinT = (bf16_t*)(p.ws + WS_WIN); bf16_t* WoutT = (bf16_t*)(p.ws + WS_WOUT); bf16_t* WguT = (bf16_t*)(p.ws + WS_WGU); bf16_t* WdT = (bf16_t*)(p.ws + WS_WD);
    constexpr int I_IN = 16 * 160, I_OUT = 32 * 32, I_GU = 32 * 512, I_D = 32 * 256, I_W = 64;
    for (int it = gw; it < I_W + I_IN + I_OUT + I_GU + I_D; it += NGW) {
        int r = it;
        if (r < I_W) { const int m = r >> 1, nb = r & 1, head = m >> 1, which = m & 1;
            tr_item((which ? p.lru_wx : p.lru_wa) + ((size_t)l * 16 + head) * 4096, 64, 0, nb * 32, (bf16_t*)(p.ws + WS_WAT) + (head * 2 + which) * 4096, 64, nb * 32, nullptr, scr, lane); continue; }
        r -= I_W;
        if (r < I_IN) { const int kb = r / 160, nb = r % 160; tr_item(p.w_in + (size_t)l * DM * INC, INC, kb * 64, nb * 32, WinT, DM, nb * 32, nullptr, scr, lane); continue; }
        r -= I_IN;
        if (r < I_OUT) { const int kb = r / 32, nb = r % 32; const int k0 = kb * 64;
            const float* ks = (k0 < 1024) ? (p.lru_norm + l * 1024) : (p.ssd_norm + l * 1024 - 1024);
            tr_item(p.w_out + (size_t)l * 2048 * DM, DM, k0, nb * 32, WoutT, 2048, nb * 32, ks, scr, lane); continue; }
        r -= I_OUT;
        if (r < I_GU) { const int e = r / 512, q = r % 512, kb = q / 32, rb = q % 32, pn = rb >> 3, jb = rb & 7;
            const float* src = (jb < 4 ? p.w_gate : p.w_up) + ((size_t)l * NEXP + e) * DM * DEXP;
            const int c0 = 128 * pn + 32 * (jb & 3);
            tr_item(src, DEXP, kb * 64, c0, WguT + (size_t)e * 1024 * 1024, DM, rb * 32, nullptr, scr, lane); continue; }
        r -= I_GU;
        { const int e = r / 256, q = r % 256, kb = q / 32, nb = q % 32;
            tr_item(p.w_down + ((size_t)l * NEXP + e) * DEXP * DM, DM, kb * 64, nb * 32, WdT + (size_t)e * 1024 * 512, DEXP, nb * 32, nullptr, scr, lane); }
    }
}

__device__ __forceinline__ void ph_norm(const Params& p, int l) {
    const int tid = opaque_tid(), lane = tid & 63, wave = tid >> 6;
    const int gw = blockIdx.x * 8 + wave, NGW = gridDim.x * 8;
    bf16_t* xn = (bf16_t*)(p.ws + WS_XN); float* dtraw = (float*)(p.ws + WS_DTRAW);
    const bf16_t* ys = (const bf16_t*)(p.ws + WS_YSLOT);
    const float* nw = p.norm_mix + l * DM;
    const float* wdt = p.w_in + (size_t)l * DM * INC + PROJW;
    if (blockIdx.x == 0 && tid < 64) ((int*)(p.ws + WS_CTL))[tid] = 0;
    for (int row = gw; row < NTOK; row += NGW) {
        f32x4 v[4];
        const float* src = (l == 0 ? p.x : p.X) + (size_t)row * DM;
#pragma unroll
        for (int j = 0; j < 4; ++j) v[j] = *(const f32x4*)(src + j * 256 + lane * 4);
        if (l > 0) {
#pragma unroll
            for (int s = 0; s < 2; ++s)
#pragma unroll
                for (int j = 0; j < 4; ++j) { const u32x2 y = *(const u32x2*)(ys + ((size_t)s * NTOK + row) * DM + j * 256 + lane * 4);
                    v[j].x += __uint_as_float(y.x << 16); v[j].y += __uint_as_float(y.x & 0xffff0000u); v[j].z += __uint_as_float(y.y << 16); v[j].w += __uint_as_float(y.y & 0xffff0000u); }
#pragma unroll
            for (int j = 0; j < 4; ++j) *(f32x4*)(p.X + (size_t)row * DM + j * 256 + lane * 4) = v[j];
        }
        float ss = 0.f;
#pragma unroll
        for (int j = 0; j < 4; ++j) ss += (v[j].x * v[j].x + v[j].y * v[j].y) + (v[j].z * v[j].z + v[j].w * v[j].w);
        const float rstd = rsqrtf(wave_sum(ss) * (1.f / DM) + 1e-6f);
#pragma unroll
        for (int j = 0; j < 4; ++j) { const f32x4 w = *(const f32x4*)(nw + j * 256 + lane * 4); v[j] = v[j] * rstd * w;
            u32x2 o; o.x = pk2(v[j].x, v[j].y); o.y = pk2(v[j].z, v[j].w); *(u32x2*)(xn + (size_t)row * DM + j * 256 + lane * 4) = o; }
        float dacc[16];
#pragma unroll
        for (int h = 0; h < 16; ++h) dacc[h] = 0.f;
#pragma unroll
        for (int j = 0; j < 4; ++j)
#pragma unroll
            for (int e = 0; e < 4; ++e) { const int k = j * 256 + lane * 4 + e; const float xv = v[j][e];
#pragma unroll
                for (int q = 0; q < 4; ++q) { const f32x4 w = *(const f32x4*)(wdt + (size_t)k * INC + q * 4);
                    dacc[q * 4 + 0] += xv * w.x; dacc[q * 4 + 1] += xv * w.y; dacc[q * 4 + 2] += xv * w.z; dacc[q * 4 + 3] += xv * w.w; } }
        float mine = 0.f;
#pragma unroll
        for (int h = 0; h < 16; ++h) { const float s = wave_sum(dacc[h]); if (lane == h) mine = s; }
        if (lane < 16) dtraw[(size_t)row * 16 + lane] = mine;
    }
}

namespace pg8 {
constexpr int BM = 256, BK = 64, HALF = 128, HTB = HALF * BK * 2, STAGE_BYTES = 8 * HTB, NXCD = 8, WGM = 8;
__host__ __device__ __forceinline__ int lds_byte(int r, int c) { const int st = (r >> 4) * 2 + (c >> 5), rr = r & 15, cc = c & 31, ob = rr * 64 + cc * 2; return st * 1024 + (ob ^ (((ob >> 9) & 1) << 5)); }
__host__ __device__ __forceinline__ void stage_rc(int b, int& R, int& C) { const int st = b / 1024, sb = b % 1024, swz = sb ^ (((sb >> 9) & 1) << 5); R = (st >> 1) * 16 + swz / 64; C = (st & 1) * 32 + (swz % 64) / 2; }
__host__ __device__ __forceinline__ int perm32(int rho) { const int n = rho >> 4, i = rho & 15; return 8 * (i >> 2) + 4 * n + (i & 3); }
struct Unit { int pm, pn; const bf16_t* a; const bf16_t* b; const int* rows; int nrows; };
__device__ __forceinline__ unsigned cvt_pk_bf16(float lo, float hi) { unsigned r; asm volatile("v_cvt_pk_bf16_f32 %0, %1, %2" : "=v"(r) : "v"(lo), "v"(hi)); return r; }

struct GridOrder {
    int nM, nN, nwg, G, c;
    __device__ void init(int nM_, int nN_, int G_, int c_) { nM = nM_; nN = nN_; nwg = nM * nN; G = G_; c = c_; }
    __device__ bool tile(int i, int& pm, int& pn) const {
        const long L = (long)i * G + c; if (L >= nwg) return false;
        int wgid = (int)L; { const int q = nwg / NXCD, r = nwg % NXCD, xcd = wgid % NXCD, off = wgid / NXCD; wgid = (xcd < r ? xcd * (q + 1) : r * (q + 1) + (xcd - r) * q) + off; }
        const int nig = WGM * nN, gid = wgid / nig, fm = gid * WGM, gsz = (nM - fm) < WGM ? (nM - fm) : WGM;
        pm = fm + ((wgid % nig) % gsz); pn = (wgid % nig) / gsz; return true;
    }
};

template <class Epi, class Sched, bool GATHER>
__device__ __forceinline__ void gemm_phase(LAS unsigned char* lds, const int K, const int lda, const int ldb, const Sched& S, const Epi& E) {
    const int tid = opaque_tid(), wid = __builtin_amdgcn_readfirstlane(tid >> 6), lane = tid & 63, wr = wid >> 2, wc = wid & 3, fr = lane & 15, fq = lane >> 4;
    const int nt = K / BK;
    unsigned voffA[2], voffB[2];
#pragma unroll
    for (int i = 0; i < 2; ++i) { int R, C; stage_rc(tid * 16 + i * 8192, R, C); const int Rb = Epi::PERM ? ((R & ~31) + perm32(R & 31)) : R;
        voffA[i] = (unsigned)(R * lda + C) * 2u; voffB[i] = (unsigned)(Rb * ldb + C) * 2u; }
    const size_t hstepA = (size_t)HALF * lda * 2, hstepB = (size_t)HALF * ldb * 2;
    const size_t kstep = (size_t)(BK * 2);
    const unsigned ldsw = (unsigned)wid * 1024u;
    const int aoff = lds_byte(wr * 64 + fr, fq * 8), boff = lds_byte(wc * 32 + fr, fq * 8);
#define PG8_SA(b, h) (((b) * 2 + (h)) * HTB)
#define PG8_SB(b, h) ((4 + (b) * 2 + (h)) * HTB)
#define PG8_GLDS(bufoff, gp, i_) __builtin_amdgcn_global_load_lds((const unsigned*)(gp), (LAS unsigned*)(lds + (bufoff) + ldsw + (i_) * 8192), 16, 0, 0)
#define PG8_STAGE_B(bufoff, gbase, h) do { PG8_GLDS(bufoff, (const char*)(gbase) + (h) * hstepB + voffB[0], 0); PG8_GLDS(bufoff, (const char*)(gbase) + (h) * hstepB + voffB[1], 1); } while (0)
#define PG8_STAGE_A(bufoff, gbase, h, nx) do { if (GATHER) { PG8_GLDS(bufoff, (const char*)(gbase) + ((nx) ? nvo[h][0] : vo[h][0]), 0); PG8_GLDS(bufoff, (const char*)(gbase) + ((nx) ? nvo[h][1] : vo[h][1]), 1); } \
        else { PG8_GLDS(bufoff, (const char*)(gbase) + (h) * hstepA + voffA[0], 0); PG8_GLDS(bufoff, (const char*)(gbase) + (h) * hstepA + voffA[1], 1); } } while (0)
#define PG8_LDA(dst, b, h) do { _Pragma("unroll") for (int m = 0; m < 4; ++m) _Pragma("unroll") for (int k = 0; k < 2; ++k) dst[m][k] = *(const LAS bf16x8*)(lds + PG8_SA(b, h) + aoff + m * 2048 + k * 1024); } while (0)
#define PG8_LDB(dst, b, h) do { _Pragma("unroll") for (int n = 0; n < 2; ++n) _Pragma("unroll") for (int k = 0; k < 2; ++k) dst[n][k] = *(const LAS bf16x8*)(lds + PG8_SB(b, h) + boff + n * 2048 + k * 1024); } while (0)
#define PG8_MMA(ai, bj, At, Bt) do { __builtin_amdgcn_s_setprio(1); _Pragma("unroll") for (int m = 0; m < 4; ++m) _Pragma("unroll") for (int n = 0; n < 2; ++n) _Pragma("unroll") for (int k = 0; k < 2; ++k) \
        acc[ai][bj][m][n] = __builtin_amdgcn_mfma_f32_16x16x32_bf16(Bt[n][k], At[m][k], acc[ai][bj][m][n], 0, 0, 0); __builtin_amdgcn_s_setprio(0); } while (0)
#define PG8_WAIT_V(n) asm volatile("s_waitcnt vmcnt(" #n ")" ::: "memory")
#define PG8_WAIT_L(n) asm volatile("s_waitcnt lgkmcnt(" #n ")" ::: "memory")
#define PG8_BAR __builtin_amdgcn_s_barrier()
#define PG8_SCHED __builtin_amdgcn_sched_barrier(0)
#define PG8_GVO(dst, u) do { if (GATHER) { _Pragma("unroll") for (int h = 0; h < 2; ++h) _Pragma("unroll") for (int i = 0; i < 2; ++i) { int R, C; stage_rc(tid * 16 + i * 8192, R, C); \
        const int rr = h * HALF + R; const int tok = (rr < (u).nrows) ? ((u).rows[rr] >> 1) : 0; dst[h][i] = (unsigned)(tok * lda + C) * 2u; } } } while (0)
    Unit cur, nxt; int ui = 0;
    if (!S.next(0, cur)) return;
    f32x4 acc[2][2][4][2];
#pragma unroll
    for (int a = 0; a < 2; ++a)
#pragma unroll
        for (int b = 0; b < 2; ++b)
#pragma unroll
            for (int m = 0; m < 4; ++m)
#pragma unroll
                for (int n = 0; n < 2; ++n) acc[a][b][m][n] = (f32x4){0.f, 0.f, 0.f, 0.f};
    bf16x8 At[4][2], B0[2][2], B1[2][2];
    unsigned vo[2][2] = {{0u, 0u}, {0u, 0u}}, nvo[2][2] = {{0u, 0u}, {0u, 0u}};
    PG8_GVO(vo, cur);
    if (GATHER) {
#pragma unroll
        for (int h = 0; h < 2; ++h) { nvo[h][0] = vo[h][0]; nvo[h][1] = vo[h][1]; } }
    const char* cA = (const char*)cur.a; const char* cB = (const char*)cur.b;
    PG8_STAGE_B(PG8_SB(0, 0), cB, 0); PG8_STAGE_B(PG8_SB(0, 1), cB, 1); PG8_STAGE_A(PG8_SA(0, 0), cA, 0, false); PG8_STAGE_A(PG8_SA(0, 1), cA, 1, false);
    if (wr == 1) PG8_BAR;
    PG8_WAIT_V(2); PG8_BAR;
    PG8_STAGE_B(PG8_SB(1, 0), cB + kstep, 0); PG8_STAGE_A(PG8_SA(1, 0), cA + kstep, 0, false); PG8_STAGE_B(PG8_SB(1, 1), cB + kstep, 1);
    PG8_WAIT_V(6); PG8_BAR;
    for (;;) {
        const bool has_next = S.next(ui + 1, nxt);
        const char* nA = has_next ? (const char*)nxt.a : cA; const char* nB = has_next ? (const char*)nxt.b : cB;
        if (GATHER && has_next) PG8_GVO(nvo, nxt);
        for (int t = 0; t < nt; t += 2) {
            const bool last = (t == nt - 2);
            const char* a1 = cA + (size_t)(t + 1) * kstep;
            const char* a2 = last ? nA : cA + (size_t)(t + 2) * kstep; const char* b2 = last ? nB : cB + (size_t)(t + 2) * kstep;
            const char* a3 = a2 + kstep; const char* b3 = b2 + kstep;
            const bool nx = GATHER && last;
            PG8_LDB(B0, 0, 0); PG8_LDB(B1, 0, 1); PG8_SCHED; PG8_LDA(At, 0, 0); PG8_STAGE_A(PG8_SA(1, 1), a1, 1, false);
            PG8_WAIT_V(8); PG8_WAIT_L(0); PG8_BAR; PG8_MMA(0, 0, At, B0); PG8_MMA(0, 1, At, B1); PG8_BAR; PG8_SCHED;
            PG8_LDA(At, 0, 1); PG8_STAGE_B(PG8_SB(0, 0), b2, 0); PG8_STAGE_B(PG8_SB(0, 1), b2, 1); PG8_STAGE_A(PG8_SA(0, 0), a2, 0, nx);
            PG8_WAIT_V(8); PG8_WAIT_L(0); PG8_BAR; PG8_MMA(1, 0, At, B0); PG8_MMA(1, 1, At, B1); PG8_BAR; PG8_SCHED;
            PG8_LDB(B0, 1, 0); PG8_LDB(B1, 1, 1); PG8_SCHED; PG8_LDA(At, 1, 0); PG8_STAGE_A(PG8_SA(0, 1), a2, 1, nx);
            PG8_WAIT_V(8); PG8_WAIT_L(0); PG8_BAR; PG8_MMA(0, 0, At, B0); PG8_MMA(0, 1, At, B1); PG8_BAR; PG8_SCHED;
            PG8_LDA(At, 1, 1); PG8_STAGE_B(PG8_SB(1, 0), b3, 0); PG8_STAGE_B(PG8_SB(1, 1), b3, 1); PG8_STAGE_A(PG8_SA(1, 0), a3, 0, nx);
            PG8_WAIT_V(8); PG8_WAIT_L(0); PG8_BAR; PG8_MMA(1, 0, At, B0); PG8_MMA(1, 1, At, B1); PG8_BAR; PG8_SCHED;
        }
        if (wr == 0) PG8_BAR;
        E(acc, cur, wr, wc, fr, fq);
        if (!has_next) break;
#pragma unroll
        for (int a = 0; a < 2; ++a)
#pragma unroll
            for (int b = 0; b < 2; ++b)
#pragma unroll
                for (int m = 0; m < 4; ++m)
#pragma unroll
                    for (int n = 0; n < 2; ++n) acc[a][b][m][n] = (f32x4){0.f, 0.f, 0.f, 0.f};
        cur = nxt; cA = nA; cB = nB; ++ui;
        if (GATHER) {
#pragma unroll
            for (int h = 0; h < 2; ++h) { vo[h][0] = nvo[h][0]; vo[h][1] = nvo[h][1]; } }
        if (wr == 1) PG8_BAR;
    }
    PG8_WAIT_V(0);
    PG8_BAR;
#undef PG8_SA
#undef PG8_SB
#undef PG8_GLDS
#undef PG8_STAGE_A
#undef PG8_STAGE_B
#undef PG8_LDA
#undef PG8_LDB
#undef PG8_MMA
#undef PG8_WAIT_V
#undef PG8_WAIT_L
#undef PG8_BAR
#undef PG8_SCHED
#undef PG8_GVO
}
}

struct SchedIn { pg8::GridOrder o; const bf16_t* A; const bf16_t* B;
    __device__ __forceinline__ bool next(int i, pg8::Unit& u) const { int pm, pn; if (!o.tile(i, pm, pn)) return false; u.pm = pm; u.pn = pn; u.a = A + (size_t)pm * 256 * DM; u.b = B + (size_t)pn * 256 * DM; u.rows = nullptr; u.nrows = 0; return true; } };
struct EpiProj { static constexpr bool PERM = true; bf16_t* O;
    __device__ __forceinline__ void operator()(const f32x4 (&acc)[2][2][4][2], const pg8::Unit& u, int wr, int wc, int fr, int fq) const {
        const int row0 = u.pm * 256 + wr * 64 + fr, col0 = u.pn * 256 + wc * 32 + 8 * fq;
#pragma unroll
        for (int ai = 0; ai < 2; ++ai)
#pragma unroll
            for (int m = 0; m < 4; ++m) { bf16_t* rowp = O + (size_t)(row0 + ai * 128 + m * 16) * PROJW + col0;
#pragma unroll
                for (int bj = 0; bj < 2; ++bj) { const f32x4 v0 = acc[ai][bj][m][0], v1 = acc[ai][bj][m][1]; u32x4 w;
                    w.x = pg8::cvt_pk_bf16(v0[0], v0[1]); w.y = pg8::cvt_pk_bf16(v0[2], v0[3]); w.z = pg8::cvt_pk_bf16(v1[0], v1[1]); w.w = pg8::cvt_pk_bf16(v1[2], v1[3]);
                    *(u32x4*)(rowp + bj * 128) = w; } }
    } };
__device__ __forceinline__ void ph_inproj(const Params& p, LAS unsigned char* lds) {
    SchedIn S; S.o.init(64, 20, gridDim.x, blockIdx.x); S.A = (const bf16_t*)(p.ws + WS_XN); S.B = (const bf16_t*)(p.ws + WS_WIN);
    pg8::gemm_phase<EpiProj, SchedIn, false>(lds, DM, DM, DM, S, EpiProj{(bf16_t*)(p.ws + WS_PROJ)});
}

__device__ __forceinline__ void row_rstd(const float* rowss, int row, float& rl, float& rs) {
    const f32x4 a = *(const f32x4*)(rowss + (size_t)row * 8), b = *(const f32x4*)(rowss + (size_t)row * 8 + 4);
    rl = rsqrtf(((a.x + a.y) + (a.z + a.w)) * (1.f / 1024.f) + 1e-6f); rs = rsqrtf(((b.x + b.y) + (b.z + b.w)) * (1.f / 1024.f) + 1e-6f);
}
struct SchedOut { pg8::GridOrder o; const bf16_t* A; const bf16_t* B;
    __device__ __forceinline__ bool next(int i, pg8::Unit& u) const { int pm, pn; if (!o.tile(i, pm, pn)) return false; u.pm = pm; u.pn = pn; u.a = A + (size_t)pm * 256 * 2048; u.b = B + (size_t)pn * 256 * 2048; u.rows = nullptr; u.nrows = 0; return true; } };
struct EpiOut { static constexpr bool PERM = false; const float* resid; float* out; const float* rowss; int half;
    __device__ __forceinline__ void operator()(const f32x4 (&acc)[2][2][4][2], const pg8::Unit& u, int wr, int wc, int fr, int fq) const {
        const int row0 = u.pm * 256 + wr * 64 + fr, col0 = u.pn * 256 + wc * 32 + 4 * fq;
#pragma unroll
        for (int ai = 0; ai < 2; ++ai)
#pragma unroll
            for (int m = 0; m < 4; ++m) { const int row = row0 + ai * 128 + m * 16; float rl, rs; row_rstd(rowss, row, rl, rs); const float sc = half ? rs : rl; const size_t off = (size_t)row * DM + col0;
#pragma unroll
                for (int bj = 0; bj < 2; ++bj)
#pragma unroll
                    for (int n = 0; n < 2; ++n) { const f32x4 bs = *(const f32x4*)(resid + off + bj * 128 + n * 16); *(f32x4*)(out + off + bj * 128 + n * 16) = bs + acc[ai][bj][m][n] * sc; } }
    } };
__device__ __forceinline__ void ph_outproj(const Params& p, int l, LAS unsigned char* lds) {
    const float* rowss = (const float*)(p.ws + WS_ROWSS);
    SchedOut S; S.o.init(64, 4, gridDim.x, blockIdx.x); S.A = (const bf16_t*)(p.ws + WS_MIX); S.B = (const bf16_t*)(p.ws + WS_WOUT);
    pg8::gemm_phase<EpiOut, SchedOut, false>(lds, 1024, 2048, 2048, S, EpiOut{(l == 0) ? p.x : p.X, p.X, rowss, 0});
    S.A += 1024; S.B += 1024;
    pg8::gemm_phase<EpiOut, SchedOut, false>(lds, 1024, 2048, 2048, S, EpiOut{p.X, p.X, rowss, 1});
}

constexpr int TS = 272;
constexpr int US = 528;
constexpr int L_TAB = 139264;
constexpr int L_RPART = L_TAB + 6144;
__device__ __forceinline__ float bperm_f(int srclane, float v) { return __builtin_bit_cast(float, __builtin_amdgcn_ds_bpermute(srclane << 2, __builtin_bit_cast(int, v))); }
__device__ __forceinline__ float fast_gelu(float x) { return x * sigmoid_f(1.5957691216057308f * (x + 0.044715f * x * x * x)); }
__device__ __forceinline__ float bflo(unsigned v) { return __uint_as_float(v << 16); }
__device__ __forceinline__ float bfhi(unsigned v) { return __uint_as_float(v & 0xffff0000u); }

template <int MODE, bool ACT>
__device__ __forceinline__ void stage_conv(const bf16_t* proj, int R0, int t0, int pcol0, int NC, const float* cw, int cwld, const float* cb, LAS unsigned char* dst, int RS, const LAS float* wt, int tid) {
    const int npair = NC >> 1;
    for (int it = tid; it < npair * 16; it += NTHR) {
        const int pr = it % npair, oct = it / npair, cc = pr * 2, l0 = oct * 8;
        float w0[4], w1[4];
#pragma unroll
        for (int k = 0; k < 4; ++k) { w0[k] = cw[k * cwld + cc]; w1[k] = cw[k * cwld + cc + 1]; }
        const float b0 = cb[cc], b1 = cb[cc + 1];
        float x0[11], x1[11];
#pragma unroll
        for (int k = 0; k < 11; ++k) { const int tt = t0 + l0 - 3 + k; const int row = R0 + l0 - 3 + k;
            const unsigned v = (tt >= 0) ? *(const unsigned*)(proj + (size_t)row * PROJW + pcol0 + cc) : 0u; x0[k] = bflo(v); x1[k] = bfhi(v); }
        float y0[8], y1[8];
#pragma unroll
        for (int i = 0; i < 8; ++i) { float a = b0, b = b1;
#pragma unroll
            for (int k = 0; k < 4; ++k) { a += w0[k] * x0[i + k]; b += w1[k] * x1[i + k]; }
            if (ACT) { a = silu_f(a); b = silu_f(b); }
            if (MODE == 1 && wt) { const float sc = wt[(cc >> 6) * 128 + l0 + i]; a *= sc; b *= sc; }
            y0[i] = a; y1[i] = b; }
        if (MODE == 0) {
#pragma unroll
            for (int i = 0; i < 8; ++i) *(LAS unsigned*)(dst + (l0 + i) * RS + cc * 2) = pg8::cvt_pk_bf16(y0[i], y1[i]);
        } else {
            u32x4 q0, q1; q0.x = pg8::cvt_pk_bf16(y0[0], y0[1]); q0.y = pg8::cvt_pk_bf16(y0[2], y0[3]); q0.z = pg8::cvt_pk_bf16(y0[4], y0[5]); q0.w = pg8::cvt_pk_bf16(y0[6], y0[7]);
            q1.x = pg8::cvt_pk_bf16(y1[0], y1[1]); q1.y = pg8::cvt_pk_bf16(y1[2], y1[3]); q1.z = pg8::cvt_pk_bf16(y1[4], y1[5]); q1.w = pg8::cvt_pk_bf16(y1[6], y1[7]);
            *(LAS u32x4*)(dst + cc * TS + l0 * 2) = q0; *(LAS u32x4*)(dst + (cc + 1) * TS + l0 * 2) = q1;
        }
    }
}

template <bool WT>
__device__ __forceinline__ void ssd_tables(const Params& p, int l_, int R0, int g, LAS unsigned char* lds, int wid, int lane) {
    if (wid < 4) { const int h = 4 * g + wid; const float* dtraw = (const float*)(p.ws + WS_DTRAW);
        LAS float* dtv = (LAS float*)(lds + L_TAB) + wid * 128; LAS float* acs = (LAS float*)(lds + L_TAB + 2048) + wid * 128; LAS float* wt = (LAS float*)(lds + L_TAB + 4096) + wid * 128;
        const float bias = p.ssd_dt_bias[l_ * 16 + h], A = -__expf(p.ssd_a_log[l_ * 16 + h]);
        const float dt0 = softplus_f(dtraw[(size_t)(R0 + 2 * lane) * 16 + h] + bias), dt1 = softplus_f(dtraw[(size_t)(R0 + 2 * lane + 1) * 16 + h] + bias);
        const float v0 = dt0 * A, v1 = dt1 * A; float sc = v0 + v1;
#pragma unroll
        for (int d = 1; d < 64; d <<= 1) { const float t = bperm_f(lane - d, sc); if (lane >= d) sc += t; }
        const float a0 = sc - v1, a1 = sc;
        dtv[2 * lane] = dt0; dtv[2 * lane + 1] = dt1; acs[2 * lane] = a0; acs[2 * lane + 1] = a1;
        if (WT) { const float alast = __builtin_bit_cast(float, __builtin_amdgcn_readlane(__builtin_bit_cast(int, sc), 63)); wt[2 * lane] = dt0 * __expf(alast - a0); wt[2 * lane + 1] = dt1 * __expf(alast - a1);
            if (lane == 0) ((float*)(p.ws + WS_DECAY))[(R0 >> 7) * 16 + h] = __expf(alast); }
    }
}

template <bool FINAL>
__device__ __forceinline__ void lru_wave(const Params& p, int l_, int bc  , int g, const LAS unsigned char* U, LAS unsigned char* H, int wid, int lane) {
    const int hh = wid >> 1, sub = wid & 1, h = 4 * g + hh, jj = lane & 15, quad = lane >> 4;
    const bf16_t* wat = (const bf16_t*)(p.ws + WS_WAT) + (size_t)h * 2 * 4096;
    bf16x8 wa[2][2], wx[2][2];
    float ba[2], bx[2], c8[2], hin[2], P[2];
#pragma unroll
    for (int nt = 0; nt < 2; ++nt) { const int j = 32 * sub + 16 * nt + jj, col = h * 64 + j;
#pragma unroll
        for (int kc = 0; kc < 2; ++kc) { wa[nt][kc] = *(const bf16x8*)(wat + j * 64 + kc * 32 + quad * 8); wx[nt][kc] = *(const bf16x8*)(wat + 4096 + j * 64 + kc * 32 + quad * 8); }
        ba[nt] = p.lru_ba[l_ * 1024 + col]; bx[nt] = p.lru_bx[l_ * 1024 + col]; c8[nt] = -8.f * softplus_f(-p.lru_lambda[l_ * 1024 + col]);
        hin[nt] = FINAL ? ((const float*)(p.ws + WS_LCARRY))[(size_t)bc * 1024 + col] : 0.f; P[nt] = 1.f; }
#pragma unroll 1
    for (int mt = 0; mt < 8; ++mt) {
        bf16x8 ua[2];
#pragma unroll
        for (int kc = 0; kc < 2; ++kc) ua[kc] = *(const LAS bf16x8*)(U + (16 * mt + jj) * US + (hh * 64 + kc * 32 + quad * 8) * 2);
#pragma unroll
        for (int nt = 0; nt < 2; ++nt) {
            f32x4 R = (f32x4){0.f, 0.f, 0.f, 0.f}, I = R;
            R = __builtin_amdgcn_mfma_f32_16x16x32_bf16(ua[0], wa[nt][0], R, 0, 0, 0); R = __builtin_amdgcn_mfma_f32_16x16x32_bf16(ua[1], wa[nt][1], R, 0, 0, 0);
            I = __builtin_amdgcn_mfma_f32_16x16x32_bf16(ua[0], wx[nt][0], I, 0, 0, 0); I = __builtin_amdgcn_mfma_f32_16x16x32_bf16(ua[1], wx[nt][1], I, 0, 0, 0);
            const int j = 32 * sub + 16 * nt + jj;
            float a[4], v[4];
#pragma unroll
            for (int r = 0; r < 4; ++r) { const int l = 16 * mt + 4 * quad + r;
                const float uval = bf2f(*(const LAS bf16_t*)(U + l * US + (hh * 64 + j) * 2));
                const float rr = sigmoid_f(R[r] + ba[nt]), ig = sigmoid_f(I[r] + bx[nt]);
                const float av = __expf(c8[nt] * rr);
                a[r] = av; v[r] = sqrtf(fmaxf(0.f, 1.f - av * av)) * (ig * uval); }
            const float A4 = (a[0] * a[1]) * (a[2] * a[3]);
            const float B4 = ((v[0] * a[1] + v[1]) * a[2] + v[2]) * a[3] + v[3];
            float hs = hin[nt], hstart = 0.f, Pm = 1.f;
#pragma unroll
            for (int q = 0; q < 4; ++q) { const float Aq = bperm_f(jj + 16 * q, A4), Bq = bperm_f(jj + 16 * q, B4); if (q == quad) hstart = hs; hs = Aq * hs + Bq; Pm *= Aq; }
            hin[nt] = hs; P[nt] *= Pm;
            if (FINAL) { float hc = hstart;
#pragma unroll
                for (int r = 0; r < 4; ++r) { hc = a[r] * hc + v[r]; *(LAS bf16_t*)(H + (16 * mt + 4 * quad + r) * US + (hh * 64 + j) * 2) = (bf16_t)f2bf(hc); } }
        }
    }
    if (!FINAL && quad == 0) {
#pragma unroll
        for (int nt = 0; nt < 2; ++nt) { float* o = (float*)(p.ws + WS_LSUM) + ((size_t)bc * 1024 + h * 64 + 32 * sub + 16 * nt + jj) * 2; o[0] = P[nt]; o[1] = hin[nt]; } }
}

__device__ __forceinline__ void ph_mixA(const Params& p, int l_, LAS unsigned char* lds) {
    const int tid = opaque_tid(), wid = __builtin_amdgcn_readfirstlane(tid >> 6), lane = tid & 63, jj = lane & 15, quad = lane >> 4;
    const bf16_t* proj = (const bf16_t*)(p.ws + WS_PROJ); float* states = (float*)(p.ws + WS_STATES);
    const float* scw = p.ssd_conv_w + (size_t)l_ * 4 * SSD_CD; const float* scb = p.ssd_conv_b + l_ * SSD_CD;
    const float* lcw = p.lru_conv_w + (size_t)l_ * 4 * 1024; const float* lcb = p.lru_conv_b + l_ * 1024;
    for (int u = blockIdx.x; u < NB * NCH * 4; u += gridDim.x) {
        const int g = u & 3, c = (u >> 2) & 63, b = u >> 8; const int t0 = c * CH, R0 = b * SEQ + t0;
        stage_conv<0, false>(proj, R0, t0, O_LX + 256 * g, 256, lcw + 256 * g, 1024, lcb + 256 * g, lds, US, nullptr, tid);
        ssd_tables<true>(p, l_, R0, g, lds, wid, lane);
        __syncthreads();
        lru_wave<false>(p, l_, b * NCH + c, g, lds, nullptr, wid, lane);
        __syncthreads();
        stage_conv<1, true>(proj, R0, t0, O_XS + 256 * g, 256, scw + 256 * g, SSD_CD, scb + 256 * g, lds, 0, (const LAS float*)(lds + L_TAB + 4096), tid);
        stage_conv<1, true>(proj, R0, t0, O_B + 128 * g, 128, scw + 1024 + 128 * g, SSD_CD, scb + 1024 + 128 * g, lds + 69632, 0, nullptr, tid);
        __syncthreads();
        { const int hh = wid >> 1, sub = wid & 1, h = 4 * g + hh;
            f32x4 acc[4][4];
#pragma unroll
            for (int mt = 0; mt < 4; ++mt)
#pragma unroll
                for (int n = 0; n < 4; ++n) acc[mt][n] = (f32x4){0.f, 0.f, 0.f, 0.f};
#pragma unroll
            for (int kc = 0; kc < 4; ++kc) { bf16x8 bfr[4];
#pragma unroll
                for (int n = 0; n < 4; ++n) bfr[n] = *(const LAS bf16x8*)(lds + 69632 + (16 * (4 * sub + n) + jj) * TS + (32 * kc + 8 * quad) * 2);
#pragma unroll
                for (int mt = 0; mt < 4; ++mt) { const bf16x8 xa = *(const LAS bf16x8*)(lds + (hh * 64 + 16 * mt + jj) * TS + (32 * kc + 8 * quad) * 2);
#pragma unroll
                    for (int n = 0; n < 4; ++n) acc[mt][n] = __builtin_amdgcn_mfma_f32_16x16x32_bf16(xa, bfr[n], acc[mt][n], 0, 0, 0); } }
            float* st = states + ((size_t)((b * NCH + c) * 16 + h)) * 8192;
#pragma unroll
            for (int mt = 0; mt < 4; ++mt)
#pragma unroll
                for (int n = 0; n < 4; ++n)
#pragma unroll
                    for (int r = 0; r < 4; ++r) st[(16 * mt + 4 * quad + r) * 128 + 16 * (4 * sub + n) + jj] = acc[mt][n][r];
        }
        __syncthreads();
    }
}

__device__ __forceinline__ void ph_scan(const Params& p) {
    const float* states = (const float*)(p.ws + WS_STATES); const float* decay = (const float*)(p.ws + WS_DECAY); bf16_t* prevb = (bf16_t*)(p.ws + WS_PREV);
    const float* lsum = (const float*)(p.ws + WS_LSUM); float* lcarry = (float*)(p.ws + WS_LCARRY);
    const int gt = blockIdx.x * NTHR + opaque_tid(), NGT = gridDim.x * NTHR;
    for (int e = gt; e < NB * 16 * 8192 / 4; e += NGT) {
        const int q = e & 2047, h = (e >> 11) & 15, b = e >> 15;
        f32x4 r = (f32x4){0.f, 0.f, 0.f, 0.f};
#pragma unroll 4
        for (int c = 0; c < NCH; ++c) { const size_t o = ((size_t)((b * NCH + c) * 16 + h)) * 8192 + q * 4; const f32x4 t = *(const f32x4*)(states + o);
            u32x2 w; w.x = pg8::cvt_pk_bf16(r.x, r.y); w.y = pg8::cvt_pk_bf16(r.z, r.w); *(u32x2*)(prevb + o) = w; r = r * decay[(b * NCH + c) * 16 + h] + t; }
    }
    for (int e = gt; e < NB * 1024; e += NGT) { const int ch = e & 1023, b = e >> 10; float r = 0.f;
        for (int c = 0; c < NCH; ++c) { const size_t i = (size_t)(b * NCH + c) * 1024 + ch; lcarry[i] = r; r = lsum[i * 2] * r + lsum[i * 2 + 1]; } }
}

__device__ __forceinline__ void ph_mixB(const Params& p, int l_, LAS unsigned char* lds) {
    const int tid = opaque_tid(), wid = __builtin_amdgcn_readfirstlane(tid >> 6), lane = tid & 63, jj = lane & 15, quad = lane >> 4;
    const bf16_t* proj = (const bf16_t*)(p.ws + WS_PROJ); bf16_t* mix = (bf16_t*)(p.ws + WS_MIX); float* rowss = (float*)(p.ws + WS_ROWSS);
    const float* scw = p.ssd_conv_w + (size_t)l_ * 4 * SSD_CD; const float* scb = p.ssd_conv_b + l_ * SSD_CD;
    const float* lcw = p.lru_conv_w + (size_t)l_ * 4 * 1024; const float* lcb = p.lru_conv_b + l_ * 1024;
    LAS unsigned char* Bm = lds; LAS unsigned char* Cm = lds + 34816; LAS unsigned char* Xt = lds + 69632;
    const LAS float* dtv = (const LAS float*)(lds + L_TAB); const LAS float* acs = (const LAS float*)(lds + L_TAB + 2048); LAS float* rpart = (LAS float*)(lds + L_RPART);
    for (int u = blockIdx.x; u < NB * NCH * 4; u += gridDim.x) {
        const int g = u & 3, c = (u >> 2) & 63, b = u >> 8; const int t0 = c * CH, R0 = b * SEQ + t0;
        stage_conv<0, true>(proj, R0, t0, O_B + 128 * g, 128, scw + 1024 + 128 * g, SSD_CD, scb + 1024 + 128 * g, Bm, TS, nullptr, tid);
        stage_conv<0, true>(proj, R0, t0, O_C + 128 * g, 128, scw + 1536 + 128 * g, SSD_CD, scb + 1536 + 128 * g, Cm, TS, nullptr, tid);
        stage_conv<1, true>(proj, R0, t0, O_XS + 256 * g, 256, scw + 256 * g, SSD_CD, scb + 256 * g, Xt, 0, nullptr, tid);
        ssd_tables<false>(p, l_, R0, g, lds, wid, lane);
        __syncthreads();
        { const int hh = wid >> 1, sub = wid & 1, h = 4 * g + hh;
            const float Dh = p.ssd_d[l_ * 16 + h];
            const bf16_t* prev = (const bf16_t*)(p.ws + WS_PREV) + ((size_t)((b * NCH + c) * 16 + h)) * 8192;
            const LAS float* dth = dtv + hh * 128; const LAS float* ach = acs + hh * 128;
            int lts[4]; lts[0] = sub ? 1 : 0; lts[1] = sub ? 2 : 3; lts[2] = sub ? 5 : 4; lts[3] = sub ? 6 : 7;
            f32x4 acc[4][4];
#pragma unroll
            for (int mt = 0; mt < 4; ++mt)
#pragma unroll
                for (int li = 0; li < 4; ++li) acc[mt][li] = (f32x4){0.f, 0.f, 0.f, 0.f};
#pragma unroll
            for (int kc = 0; kc < 4; ++kc) { bf16x8 pa[4];
#pragma unroll
                for (int mt = 0; mt < 4; ++mt) pa[mt] = *(const bf16x8*)(prev + (16 * mt + jj) * 128 + 32 * kc + 8 * quad);
#pragma unroll
                for (int li = 0; li < 4; ++li) { const bf16x8 cf = *(const LAS bf16x8*)(Cm + (16 * lts[li] + jj) * TS + (32 * kc + 8 * quad) * 2);
#pragma unroll
                    for (int mt = 0; mt < 4; ++mt) acc[mt][li] = __builtin_amdgcn_mfma_f32_16x16x32_bf16(pa[mt], cf, acc[mt][li], 0, 0, 0); } }
#pragma unroll
            for (int li = 0; li < 4; ++li) { const float e = __expf(ach[16 * lts[li] + jj]);
#pragma unroll
                for (int mt = 0; mt < 4; ++mt) acc[mt][li] = acc[mt][li] * e; }
#pragma unroll
            for (int li = 0; li < 4; ++li) { const int lt = lts[li];
                bf16x8 cfr[4];
#pragma unroll
                for (int kc = 0; kc < 4; ++kc) cfr[kc] = *(const LAS bf16x8*)(Cm + (16 * lt + jj) * TS + (32 * kc + 8 * quad) * 2);
                const float al = ach[16 * lt + jj];
#pragma unroll 1
                for (int sc = 0; sc <= (lt >> 1); ++sc) {
                    float gv[8];
#pragma unroll
                    for (int t2 = 0; t2 < 2; ++t2) { const int st = 2 * sc + t2;
                        f32x4 S = (f32x4){0.f, 0.f, 0.f, 0.f};
                        if (st <= lt) {
#pragma unroll
                            for (int kc = 0; kc < 4; ++kc) { const bf16x8 bf_ = *(const LAS bf16x8*)(Bm + (16 * st + jj) * TS + (32 * kc + 8 * quad) * 2); S = __builtin_amdgcn_mfma_f32_16x16x32_bf16(bf_, cfr[kc], S, 0, 0, 0); }
                            const f32x4 dt4 = *(const LAS f32x4*)(dth + 16 * st + 4 * quad), as4 = *(const LAS f32x4*)(ach + 16 * st + 4 * quad);
                            const bool diag = (st == lt);
#pragma unroll
                            for (int r = 0; r < 4; ++r) { float val = S[r] * __expf(al - as4[r]) * dt4[r];
                                if (diag) { const int sr = 4 * quad + r; val = (sr > jj) ? 0.f : val; val = (sr == jj) ? val + Dh : val; }
                                gv[t2 * 4 + r] = val; }
                        } else {
#pragma unroll
                            for (int r = 0; r < 4; ++r) gv[t2 * 4 + r] = 0.f; }
                    }
                    u32x4 gq; gq.x = pg8::cvt_pk_bf16(gv[0], gv[1]); gq.y = pg8::cvt_pk_bf16(gv[2], gv[3]); gq.z = pg8::cvt_pk_bf16(gv[4], gv[5]); gq.w = pg8::cvt_pk_bf16(gv[6], gv[7]);
                    const bf16x8 gb = __builtin_bit_cast(bf16x8, gq);
#pragma unroll
                    for (int mt = 0; mt < 4; ++mt) { const LAS unsigned char* xp = Xt + (hh * 64 + 16 * mt + jj) * TS + (32 * sc + 4 * quad) * 2;
                        const u32x2 x0 = *(const LAS u32x2*)xp, x1 = *(const LAS u32x2*)(xp + 32);
                        u32x4 xq; xq.x = x0.x; xq.y = x0.y; xq.z = x1.x; xq.w = x1.y;
                        acc[mt][li] = __builtin_amdgcn_mfma_f32_16x16x32_bf16(__builtin_bit_cast(bf16x8, xq), gb, acc[mt][li], 0, 0, 0); }
                }
            }
#pragma unroll
            for (int li = 0; li < 4; ++li) { const int l = 16 * lts[li] + jj; float ssq = 0.f; u32x2 zr[4];
#pragma unroll
                for (int mt = 0; mt < 4; ++mt) zr[mt] = *(const u32x2*)(proj + (size_t)(R0 + l) * PROJW + O_Z + h * 64 + 16 * mt + 4 * quad);
#pragma unroll
                for (int mt = 0; mt < 4; ++mt) { const u32x2 z = zr[mt]; const f32x4 a4 = acc[mt][li];
                    const float y0 = a4[0] * silu_f(bflo(z.x)), y1 = a4[1] * silu_f(bfhi(z.x)), y2 = a4[2] * silu_f(bflo(z.y)), y3 = a4[3] * silu_f(bfhi(z.y));
                    ssq += (y0 * y0 + y1 * y1) + (y2 * y2 + y3 * y3);
                    u32x2 o; o.x = pg8::cvt_pk_bf16(y0, y1); o.y = pg8::cvt_pk_bf16(y2, y3);
                    *(u32x2*)(mix + (size_t)(R0 + l) * 2048 + 1024 + h * 64 + 16 * mt + 4 * quad) = o; }
                ssq += bperm_f(lane ^ 16, ssq); ssq += bperm_f(lane ^ 32, ssq);
                if (quad == 0) rpart[hh * 128 + l] = ssq; }
        }
        __syncthreads();
        if (tid < 128) rowss[(size_t)(R0 + tid) * 8 + 4 + g] = (rpart[tid] + rpart[128 + tid]) + (rpart[256 + tid] + rpart[384 + tid]);
        stage_conv<0, false>(proj, R0, t0, O_LX + 256 * g, 256, lcw + 256 * g, 1024, lcb + 256 * g, lds, US, nullptr, tid);
        __syncthreads();
        lru_wave<true>(p, l_, b * NCH + c, g, lds, lds + 67584, wid, lane);
        __syncthreads();
#pragma unroll 2
        for (int k = 0; k < 8; ++k) { const int it = tid + k * NTHR, l = it >> 5, ch = it & 31;
            const u32x4 hv = *(const LAS u32x4*)(lds + 67584 + l * US + ch * 16);
            const u32x4 gt = *(const u32x4*)(proj + (size_t)(R0 + l) * PROJW + O_LG + 256 * g + ch * 8);
            float y[8];
            y[0] = fast_gelu(bflo(gt.x)) * bflo(hv.x); y[1] = fast_gelu(bfhi(gt.x)) * bfhi(hv.x); y[2] = fast_gelu(bflo(gt.y)) * bflo(hv.y); y[3] = fast_gelu(bfhi(gt.y)) * bfhi(hv.y);
            y[4] = fast_gelu(bflo(gt.z)) * bflo(hv.z); y[5] = fast_gelu(bfhi(gt.z)) * bfhi(hv.z); y[6] = fast_gelu(bflo(gt.w)) * bflo(hv.w); y[7] = fast_gelu(bfhi(gt.w)) * bfhi(hv.w);
            float sq = 0.f;
#pragma unroll
            for (int i = 0; i < 8; ++i) sq += y[i] * y[i];
            u32x4 o; o.x = pg8::cvt_pk_bf16(y[0], y[1]); o.y = pg8::cvt_pk_bf16(y[2], y[3]); o.z = pg8::cvt_pk_bf16(y[4], y[5]); o.w = pg8::cvt_pk_bf16(y[6], y[7]);
            *(u32x4*)(mix + (size_t)(R0 + l) * 2048 + 256 * g + ch * 8) = o;
            sq += SWZ_XOR(sq, 1); sq += SWZ_XOR(sq, 2); sq += SWZ_XOR(sq, 4); sq += SWZ_XOR(sq, 8); sq += SWZ_XOR(sq, 16);
            if ((lane & 31) == 0) rowss[(size_t)(R0 + l) * 8 + g] = sq; }
        __syncthreads();
    }
}

__device__ __forceinline__ void ph_router(const Params& p, int l) {
    const int tid = opaque_tid(), lane = tid & 63, wave = tid >> 6;
    const int gw = blockIdx.x * 8 + wave, NGW = gridDim.x * 8;
    bf16_t* hb = (bf16_t*)(p.ws + WS_H); int* cnt = (int*)(p.ws + WS_CTL); int* ltok = (int*)(p.ws + WS_LTOK); float* lw = (float*)(p.ws + WS_LW);
    const float* nw = p.norm_ffn + l * DM; const float* wc = p.w_coarse + (size_t)l * DM * 4; const float* wf = p.w_fine + (size_t)l * 4 * DM * 8;
    for (int row = gw; row < NTOK; row += NGW) {
        f32x4 v[4]; float ss = 0.f;
#pragma unroll
        for (int j = 0; j < 4; ++j) { v[j] = *(const f32x4*)(p.X + (size_t)row * DM + j * 256 + lane * 4); ss += (v[j].x * v[j].x + v[j].y * v[j].y) + (v[j].z * v[j].z + v[j].w * v[j].w); }
        const float rstd = rsqrtf(wave_sum(ss) * (1.f / DM) + 1e-6f);
        float cl[4] = {0.f, 0.f, 0.f, 0.f};
#pragma unroll
        for (int j = 0; j < 4; ++j) { const f32x4 w = *(const f32x4*)(nw + j * 256 + lane * 4); v[j] = v[j] * rstd * w;
            u32x2 o; o.x = pk2(v[j].x, v[j].y); o.y = pk2(v[j].z, v[j].w); *(u32x2*)(hb + (size_t)row * DM + j * 256 + lane * 4) = o;
#pragma unroll
            for (int e = 0; e < 4; ++e) { const f32x4 c4 = *(const f32x4*)(wc + (size_t)(j * 256 + lane * 4 + e) * 4); const float xv = v[j][e];
                cl[0] += xv * c4.x; cl[1] += xv * c4.y; cl[2] += xv * c4.z; cl[3] += xv * c4.w; } }
#pragma unroll
        for (int q = 0; q < 4; ++q) cl[q] = wave_sum(cl[q]) + p.b_coarse[l * 4 + q];
        int gi = 0; float cm = cl[0];
#pragma unroll
        for (int q = 1; q < 4; ++q) if (cl[q] > cm) { cm = cl[q]; gi = q; }
        float den = 0.f;
#pragma unroll
        for (int q = 0; q < 4; ++q) den += __expf(cl[q] - cm);
        const float gwt = 1.f / den;
        float fl[8];
#pragma unroll
        for (int q = 0; q < 8; ++q) fl[q] = 0.f;
        const float* wfg = wf + (size_t)gi * DM * 8;
#pragma unroll
        for (int j = 0; j < 4; ++j)
#pragma unroll
            for (int e = 0; e < 4; ++e) { const float* wp = wfg + (size_t)(j * 256 + lane * 4 + e) * 8; const f32x4 a = *(const f32x4*)wp, b2 = *(const f32x4*)(wp + 4); const float xv = v[j][e];
                fl[0] += xv * a.x; fl[1] += xv * a.y; fl[2] += xv * a.z; fl[3] += xv * a.w; fl[4] += xv * b2.x; fl[5] += xv * b2.y; fl[6] += xv * b2.z; fl[7] += xv * b2.w; }
#pragma unroll
        for (int q = 0; q < 8; ++q) fl[q] = wave_sum(fl[q]) + p.b_fine[(l * 4 + gi) * 8 + q];
        int i0 = 0; float v0 = fl[0];
#pragma unroll
        for (int q = 1; q < 8; ++q) if (fl[q] > v0) { v0 = fl[q]; i0 = q; }
        int i1 = -1; float v1 = -3.0e38f;
#pragma unroll
        for (int q = 0; q < 8; ++q) if (q != i0 && fl[q] > v1) { v1 = fl[q]; i1 = q; }
        const float e1 = __expf(v1 - v0), w0 = gwt / (1.f + e1), w1 = gwt * e1 / (1.f + e1);
        if (lane == 0) {
            const int ex0 = gi * 8 + i0, ex1 = gi * 8 + i1;
            const int p0 = atomicAdd(cnt + ex0, 1); ltok[(size_t)ex0 * LISTCAP + p0] = row * 2 + 0; lw[(size_t)ex0 * LISTCAP + p0] = w0;
            const int p1 = atomicAdd(cnt + ex1, 1); ltok[(size_t)ex1 * LISTCAP + p1] = row * 2 + 1; lw[(size_t)ex1 * LISTCAP + p1] = w1;
        }
    }
}

__device__ __forceinline__ int moe_tiles(const Params& p, LAS int* tb) {
    const int* cnt = (const int*)(p.ws + WS_CTL);
    __syncthreads();
    if (opaque_tid() == 0) { int s = 0; for (int e = 0; e < NEXP; ++e) { tb[e] = s; s += (cnt[e] + 255) >> 8; } tb[NEXP] = s; }
    __syncthreads();
    return tb[NEXP];
}
struct SchedMoe { LAS const int* tb; int G, c, up; const int* cnt; const int* ltok; const bf16_t* A; const bf16_t* B;
    __device__ __forceinline__ bool next(int i, pg8::Unit& u) const {
        const int L = i * G + c; if (L >= tb[NEXP] * 4) return false;
        const int t = L >> 2, pn = L & 3; int e = 0; while (tb[e + 1] <= t) ++e;
        const int pos0 = (t - tb[e]) * 256;
        u.pm = t; u.pn = pn; u.rows = ltok + (size_t)e * LISTCAP + pos0; u.nrows = cnt[e] - pos0;
        if (up) { u.a = A; u.b = B + ((size_t)e * 1024 + pn * 256) * DM; } else { u.a = A + (size_t)t * 256 * DEXP; u.b = B + ((size_t)e * 1024 + pn * 256) * DEXP; }
        return true; } };
struct EpiUp { static constexpr bool PERM = true; bf16_t* hid;
    __device__ __forceinline__ void operator()(const f32x4 (&acc)[2][2][4][2], const pg8::Unit& u, int wr, int wc, int fr, int fq) const {
        const int row0 = u.pm * 256 + wr * 64 + fr, col0 = u.pn * 128 + wc * 32 + 8 * fq;
#pragma unroll
        for (int ai = 0; ai < 2; ++ai)
#pragma unroll
            for (int m = 0; m < 4; ++m) { float o[8];
#pragma unroll
                for (int n = 0; n < 2; ++n)
#pragma unroll
                    for (int j = 0; j < 4; ++j) o[n * 4 + j] = silu_f(acc[ai][0][m][n][j]) * acc[ai][1][m][n][j];
                u32x4 w; w.x = pg8::cvt_pk_bf16(o[0], o[1]); w.y = pg8::cvt_pk_bf16(o[2], o[3]); w.z = pg8::cvt_pk_bf16(o[4], o[5]); w.w = pg8::cvt_pk_bf16(o[6], o[7]);
                *(u32x4*)(hid + (size_t)(row0 + ai * 128 + m * 16) * DEXP + col0) = w; }
    } };
__device__ __forceinline__ void ph_moe_up(const Params& p, LAS unsigned char* lds) {
    LAS int* tb = (LAS int*)(lds + LDS_TB);
    moe_tiles(p, tb);
    SchedMoe S{tb, (int)gridDim.x, (int)blockIdx.x, 1, (const int*)(p.ws + WS_CTL), (const int*)(p.ws + WS_LTOK), (const bf16_t*)(p.ws + WS_H), (const bf16_t*)(p.ws + WS_WGU)};
    pg8::gemm_phase<EpiUp, SchedMoe, true>(lds, DM, DM, DM, S, EpiUp{(bf16_t*)(p.ws + WS_HID)});
}
struct EpiDown { static constexpr bool PERM = true; bf16_t* ys; const float* lw; const int* ltok;
    __device__ __forceinline__ void operator()(const f32x4 (&acc)[2][2][4][2], const pg8::Unit& u, int wr, int wc, int fr, int fq) const {
        const int col0 = u.pn * 256 + wc * 32 + 8 * fq; const float* lwr = lw + (u.rows - ltok);
#pragma unroll
        for (int ai = 0; ai < 2; ++ai)
#pragma unroll
            for (int m = 0; m < 4; ++m) { const int r = ai * 128 + wr * 64 + m * 16 + fr;
                if (r < u.nrows) { const int tk = u.rows[r]; const float w = lwr[r]; bf16_t* o = ys + ((size_t)(tk & 1) * NTOK + (tk >> 1)) * DM + col0;
#pragma unroll
                    for (int bj = 0; bj < 2; ++bj) { const f32x4 v0 = acc[ai][bj][m][0] * w, v1 = acc[ai][bj][m][1] * w; u32x4 q;
                        q.x = pg8::cvt_pk_bf16(v0[0], v0[1]); q.y = pg8::cvt_pk_bf16(v0[2], v0[3]); q.z = pg8::cvt_pk_bf16(v1[0], v1[1]); q.w = pg8::cvt_pk_bf16(v1[2], v1[3]);
                        *(u32x4*)(o + bj * 128) = q; } } }
    } };
__device__ __forceinline__ void ph_moe_down(const Params& p, LAS unsigned char* lds) {
    LAS int* tb = (LAS int*)(lds + LDS_TB);
    moe_tiles(p, tb);
    SchedMoe S{tb, (int)gridDim.x, (int)blockIdx.x, 0, (const int*)(p.ws + WS_CTL), (const int*)(p.ws + WS_LTOK), (const bf16_t*)(p.ws + WS_HID), (const bf16_t*)(p.ws + WS_WD)};
    pg8::gemm_phase<EpiDown, SchedMoe, false>(lds, DEXP, DEXP, DEXP, S, EpiDown{(bf16_t*)(p.ws + WS_YSLOT), (const float*)(p.ws + WS_LW), (const int*)(p.ws + WS_LTOK)});
}

__device__ __forceinline__ void ph_final(const Params& p) {
    const int tid = opaque_tid(), lane = tid & 63, wave = tid >> 6;
    const int gw = blockIdx.x * 8 + wave, NGW = gridDim.x * 8;
    const bf16_t* ys = (const bf16_t*)(p.ws + WS_YSLOT);
    for (int row = gw; row < NTOK; row += NGW) {
        f32x4 v[4];
#pragma unroll
        for (int j = 0; j < 4; ++j) v[j] = *(const f32x4*)(p.X + (size_t)row * DM + j * 256 + lane * 4);
#pragma unroll
        for (int s = 0; s < 2; ++s)
#pragma unroll
            for (int j = 0; j < 4; ++j) { const u32x2 y = *(const u32x2*)(ys + ((size_t)s * NTOK + row) * DM + j * 256 + lane * 4);
                v[j].x += __uint_as_float(y.x << 16); v[j].y += __uint_as_float(y.x & 0xffff0000u); v[j].z += __uint_as_float(y.y << 16); v[j].w += __uint_as_float(y.y & 0xffff0000u); }
        float ss = 0.f;
#pragma unroll
        for (int j = 0; j < 4; ++j) ss += (v[j].x * v[j].x + v[j].y * v[j].y) + (v[j].z * v[j].z + v[j].w * v[j].w);
        const float rstd = rsqrtf(wave_sum(ss) * (1.f / DM) + 1e-6f);
#pragma unroll
        for (int j = 0; j < 4; ++j) { const f32x4 w = *(const f32x4*)(p.final_norm + j * 256 + lane * 4); *(f32x4*)(p.X + (size_t)row * DM + j * 256 + lane * 4) = v[j] * rstd * w; }
    }
}


#ifndef DBG
#define DBG 0
#endif
#ifndef DBGA
#define DBGA 12
#define DBGB 12
#endif
#if DBG
constexpr size_t WS_MIX2 = 404 * MiB;
constexpr size_t WS_DBG = 470 * MiB;
__global__ void __launch_bounds__(64) dbg_lru_seq(Params p, int l_) {
    const int b = blockIdx.x >> 4, h = blockIdx.x & 15, j = threadIdx.x, col = h * 64 + j;
    const bf16_t* proj = (const bf16_t*)(p.ws + WS_PROJ); bf16_t* mix2 = (bf16_t*)(p.ws + WS_MIX2);
    __shared__ float us[64];
    const float* cw = p.lru_conv_w + (size_t)l_ * 4 * 1024 + col; const float cb = p.lru_conv_b[l_ * 1024 + col];
    const float* wa = p.lru_wa + ((size_t)l_ * 16 + h) * 4096; const float* wx = p.lru_wx + ((size_t)l_ * 16 + h) * 4096;
    const float ba = p.lru_ba[l_ * 1024 + col], bx = p.lru_bx[l_ * 1024 + col], lam = p.lru_lambda[l_ * 1024 + col];
    const float ls = -log1pf(expf(-lam));
    float hc = 0.f;
    for (int t = 0; t < SEQ; ++t) {
        float u = cb;
        for (int k = 0; k < 4; ++k) { const int tt = t - 3 + k; if (tt >= 0) u += cw[k * 1024] * bf2f(proj[(size_t)(b * SEQ + tt) * PROJW + O_LX + col]); }
        __syncthreads(); us[j] = u; __syncthreads();
        float ra = ba, ia = bx;
        for (int i = 0; i < 64; ++i) { ra += us[i] * wa[i * 64 + j]; ia += us[i] * wx[i * 64 + j]; }
        const float r = 1.f / (1.f + expf(-ra)), ig = 1.f / (1.f + expf(-ia));
        const float log_a = 8.f * r * ls, a = expf(log_a), mult = sqrtf(fmaxf(0.f, -expm1f(2.f * log_a)));
        hc = a * hc + mult * (ig * u);
        const float gt = bf2f(proj[(size_t)(b * SEQ + t) * PROJW + O_LG + col]);
        mix2[(size_t)(b * SEQ + t) * 2048 + col] = (bf16_t)f2bf(gelu_tanh_f(gt) * hc);
    }
}
__global__ void __launch_bounds__(512) dbg_ssd_seq(Params p, int l_) {
    const int b = blockIdx.x >> 4, h = blockIdx.x & 15, g = h >> 2, tid = threadIdx.x;
    const bf16_t* proj = (const bf16_t*)(p.ws + WS_PROJ); bf16_t* mix2 = (bf16_t*)(p.ws + WS_MIX2); const float* dtraw = (const float*)(p.ws + WS_DTRAW);
    __shared__ float xs[64], Bs[128], Cs[128];
    const float* cw = p.ssd_conv_w + (size_t)l_ * 4 * SSD_CD; const float* cb = p.ssd_conv_b + l_ * SSD_CD;
    const float bias = p.ssd_dt_bias[l_ * 16 + h], A = -expf(p.ssd_a_log[l_ * 16 + h]), Dh = p.ssd_d[l_ * 16 + h];
    const int pp = tid >> 3, nb = (tid & 7) * 16;
    float st[16];
    for (int q = 0; q < 16; ++q) st[q] = 0.f;
    for (int t = 0; t < SEQ; ++t) {
        __syncthreads();
        if (tid < 320) { int cc; if (tid < 64) cc = h * 64 + tid; else if (tid < 192) cc = 1024 + g * 128 + (tid - 64); else cc = 1536 + g * 128 + (tid - 192);
            float u = cb[cc];
            for (int k = 0; k < 4; ++k) { const int tt = t - 3 + k; if (tt >= 0) u += cw[k * SSD_CD + cc] * bf2f(proj[(size_t)(b * SEQ + tt) * PROJW + O_XS + cc]); }
            u = u / (1.f + expf(-u));
            if (tid < 64) xs[tid] = u; else if (tid < 192) Bs[tid - 64] = u; else Cs[tid - 192] = u; }
        __syncthreads();
        const float dtp = dtraw[(size_t)(b * SEQ + t) * 16 + h] + bias; const float dt = dtp > 20.f ? dtp : log1pf(expf(dtp));
        const float dec = expf(dt * A), xv = xs[pp] * dt;
        float y = 0.f;
        for (int q = 0; q < 16; ++q) { st[q] = dec * st[q] + xv * Bs[nb + q]; y += Cs[nb + q] * st[q]; }
        y += __shfl_xor(y, 1); y += __shfl_xor(y, 2); y += __shfl_xor(y, 4);
        if ((tid & 7) == 0) { y += Dh * xs[pp]; const float z = bf2f(proj[(size_t)(b * SEQ + t) * PROJW + O_Z + h * 64 + pp]); y *= z / (1.f + expf(-z));
            mix2[(size_t)(b * SEQ + t) * 2048 + 1024 + h * 64 + pp] = (bf16_t)f2bf(y); }
    }
}
__global__ void dbg_cmp_mix(Params p) {
    const bf16_t* a = (const bf16_t*)(p.ws + WS_MIX); const bf16_t* b2 = (const bf16_t*)(p.ws + WS_MIX2); float* acc = (float*)(p.ws + WS_DBG);
    float s[4] = {0.f, 0.f, 0.f, 0.f};
    for (size_t i = (size_t)blockIdx.x * blockDim.x + threadIdx.x; i < (size_t)NTOK * 2048; i += (size_t)gridDim.x * blockDim.x) {
        const int col = (int)(i & 2047); const float x = bf2f(a[i]), y = bf2f(b2[i]); const int o = col < 1024 ? 0 : 2; s[o] += (x - y) * (x - y); s[o + 1] += y * y; }
    for (int q = 0; q < 4; ++q) { const float v = wave_sum(s[q]); if ((threadIdx.x & 63) == 0) atomicAdd(acc + q, v); }
}

__global__ void dbg_chk_inproj(Params p, int l) {
    const int sidx = blockIdx.x * blockDim.x + threadIdx.x; float* acc = (float*)(p.ws + WS_DBG);
    const bf16_t* proj = (const bf16_t*)(p.ws + WS_PROJ); const float* dtraw = (const float*)(p.ws + WS_DTRAW);
    unsigned hsh = (unsigned)sidx * 2654435761u + 12345u; hsh ^= hsh >> 13; hsh *= 0x5bd1e995u; hsh ^= hsh >> 15;
    const int row = hsh % NTOK, col = (hsh >> 14) % INC;
    const float* xr = (l == 0 ? p.x : p.X) + (size_t)row * DM; float ss = 0.f;
    for (int k = 0; k < DM; ++k) ss += xr[k] * xr[k];
    const float rstd = 1.f / sqrtf(ss / DM + 1e-6f);
    float d = 0.f;
    for (int k = 0; k < DM; ++k) d += (xr[k] * rstd * p.norm_mix[l * DM + k]) * p.w_in[((size_t)l * DM + k) * INC + col];
    if (col < PROJW) { const float got = bf2f(proj[(size_t)row * PROJW + col]); atomicAdd(acc + 4, (got - d) * (got - d)); atomicAdd(acc + 5, d * d); }
    else { const float got = dtraw[(size_t)row * 16 + col - PROJW]; atomicAdd(acc + 6, (got - d) * (got - d)); atomicAdd(acc + 7, d * d); }
}
__global__ void dbg_chk_outproj(Params p, int l) {
    const int sidx = blockIdx.x * blockDim.x + threadIdx.x; float* acc = (float*)(p.ws + WS_DBG);
    const bf16_t* mix = (const bf16_t*)(p.ws + WS_MIX);
    unsigned hsh = (unsigned)sidx * 2654435761u + 777u; hsh ^= hsh >> 13; hsh *= 0x5bd1e995u; hsh ^= hsh >> 15;
    const int row = hsh % NTOK, col = (hsh >> 14) % DM;
    const bf16_t* mr = mix + (size_t)row * 2048; float s1 = 0.f, s2 = 0.f;
    for (int k = 0; k < 1024; ++k) { const float a = bf2f(mr[k]), b = bf2f(mr[1024 + k]); s1 += a * a; s2 += b * b; }
    const float r1 = 1.f / sqrtf(s1 / 1024.f + 1e-6f), r2 = 1.f / sqrtf(s2 / 1024.f + 1e-6f);
    float d = 0.f;
    for (int k = 0; k < 1024; ++k) { d += bf2f(mr[k]) * r1 * p.lru_norm[l * 1024 + k] * p.w_out[((size_t)l * 2048 + k) * DM + col]; d += bf2f(mr[1024 + k]) * r2 * p.ssd_norm[l * 1024 + k] * p.w_out[((size_t)l * 2048 + 1024 + k) * DM + col]; }
    const float* xb = (l == 0) ? p.x : (const float*)(p.ws + WS_MIX2); const float ref = d, got = p.X[(size_t)row * DM + col] - xb[(size_t)row * DM + col];
    atomicAdd(acc + 8, (got - ref) * (got - ref)); atomicAdd(acc + 9, ref * ref);
}

__global__ void __launch_bounds__(256) dbg_chk_moe(Params p, int l) {
    const int tid = threadIdx.x; float* acc = (float*)(p.ws + WS_DBG); const bf16_t* ys = (const bf16_t*)(p.ws + WS_YSLOT);
    unsigned hsh = (unsigned)blockIdx.x * 2654435761u + 4242u; hsh ^= hsh >> 13; hsh *= 0x5bd1e995u; hsh ^= hsh >> 15;
    const int row = hsh % NTOK;
    __shared__ float hs[1024], hid[512], red[256], outv[4]; __shared__ int ex[2]; __shared__ float ew[2];
    float ss = 0.f; for (int k = tid; k < DM; k += 256) { const float v = p.X[(size_t)row * DM + k]; ss += v * v; }
    red[tid] = ss; __syncthreads(); if (tid == 0) { float t = 0.f; for (int i = 0; i < 256; ++i) t += red[i]; red[0] = 1.f / sqrtf(t / DM + 1e-6f); } __syncthreads();
    const float rstd = red[0];
    for (int k = tid; k < DM; k += 256) hs[k] = p.X[(size_t)row * DM + k] * rstd * p.norm_ffn[l * DM + k];
    __syncthreads();
    if (tid == 0) { float cl[4]; for (int q = 0; q < 4; ++q) { float d = p.b_coarse[l * 4 + q]; for (int k = 0; k < DM; ++k) d += hs[k] * p.w_coarse[((size_t)l * DM + k) * 4 + q]; cl[q] = d; }
        int gi = 0; for (int q = 1; q < 4; ++q) if (cl[q] > cl[gi]) gi = q; float den = 0.f; for (int q = 0; q < 4; ++q) den += expf(cl[q] - cl[gi]);
        float fl[8]; for (int q = 0; q < 8; ++q) { float d = p.b_fine[(l * 4 + gi) * 8 + q]; for (int k = 0; k < DM; ++k) d += hs[k] * p.w_fine[(((size_t)l * 4 + gi) * DM + k) * 8 + q]; fl[q] = d; }
        int i0 = 0; for (int q = 1; q < 8; ++q) if (fl[q] > fl[i0]) i0 = q; int i1 = -1; for (int q = 0; q < 8; ++q) if (q != i0 && (i1 < 0 || fl[q] > fl[i1])) i1 = q;
        const float e1 = expf(fl[i1] - fl[i0]); ex[0] = gi * 8 + i0; ex[1] = gi * 8 + i1; ew[0] = (1.f / den) / (1.f + e1); ew[1] = (1.f / den) * e1 / (1.f + e1); }
    __syncthreads();
    if (tid < 4) outv[tid] = 0.f;
    for (int s2 = 0; s2 < 2; ++s2) { const int e = ex[s2]; const float* wg = p.w_gate + ((size_t)l * NEXP + e) * DM * DEXP; const float* wu = p.w_up + ((size_t)l * NEXP + e) * DM * DEXP; const float* wd = p.w_down + ((size_t)l * NEXP + e) * DEXP * DM;
        __syncthreads();
        for (int j = tid; j < DEXP; j += 256) { float g = 0.f, u = 0.f; for (int k = 0; k < DM; ++k) { g += hs[k] * wg[(size_t)k * DEXP + j]; u += hs[k] * wu[(size_t)k * DEXP + j]; } hid[j] = g / (1.f + expf(-g)) * u; }
        __syncthreads();
        if (tid < 4) { const int col = (hsh >> 16) % 256 + tid * 256; float d = 0.f; for (int j = 0; j < DEXP; ++j) d += hid[j] * wd[(size_t)j * DM + col]; outv[tid] += ew[s2] * d; } }
    __syncthreads();
    if (tid < 4) { const int col = (hsh >> 16) % 256 + tid * 256; const float got = bf2f(ys[(size_t)row * DM + col]) + bf2f(ys[((size_t)NTOK + row) * DM + col]); const float ref = outv[tid];
        atomicAdd(acc + 10, (got - ref) * (got - ref)); atomicAdd(acc + 11, ref * ref); }
}

__global__ void dbg_chk_final(Params p) {
    const int sidx = blockIdx.x * blockDim.x + threadIdx.x; float* acc = (float*)(p.ws + WS_DBG); const bf16_t* ys = (const bf16_t*)(p.ws + WS_YSLOT);
    unsigned hsh = (unsigned)sidx * 2654435761u + 99u; hsh ^= hsh >> 13; hsh *= 0x5bd1e995u; hsh ^= hsh >> 15;
    const int row = hsh % NTOK, col = (hsh >> 14) % DM; const float* xb = (const float*)(p.ws + WS_MIX2) + (size_t)row * DM;
    float ss = 0.f; for (int k = 0; k < DM; ++k) { const float v = xb[k] + bf2f(ys[(size_t)row * DM + k]) + bf2f(ys[((size_t)NTOK + row) * DM + k]); ss += v * v; }
    const float v = xb[col] + bf2f(ys[(size_t)row * DM + col]) + bf2f(ys[((size_t)NTOK + row) * DM + col]);
    const float ref = v / sqrtf(ss / DM + 1e-6f) * p.final_norm[col], got = p.X[(size_t)row * DM + col];
    atomicAdd(acc + 12, (got - ref) * (got - ref)); atomicAdd(acc + 13, ref * ref);
}
__global__ void dbg_zero(Params p) { float* acc = (float*)(p.ws + WS_DBG); if (threadIdx.x < 64) acc[threadIdx.x] = 0.f; }
__device__ __forceinline__ int dbg_digit(float num, float den) { const float d = sqrtf(num / fmaxf(den, 1e-30f)); if (!(d == d)) return 0; const float v = -2.f * log10f(fmaxf(d, 1e-10f)); return v < 0.f ? 0 : (v > 8.f ? 8 : (int)v); }
__global__ void dbg_report(Params p) {
    const float* acc = (const float*)(p.ws + WS_DBG);
    const size_t i = (size_t)blockIdx.x * blockDim.x + threadIdx.x;
    if (i < (size_t)NTOK * DM) p.X[i] = 0.f;
    if (i == 0) { const int a = dbg_digit(acc[DBGA], acc[DBGA + 1]), b = dbg_digit(acc[DBGB], acc[DBGB + 1]); p.X[0] = sqrtf((float)NTOK * DM * (9.f + 10.f * a + b)); }
}
#endif

#define XB_TMO      128
#define XB_XCNT(j)  (256  + 64 * (j))
#define XB_XSUB(j)  (1280 + 64 * (j))
#define XB_XGEN(j)  (2304 + 64 * (j))
#define XB_TOP      3328
#define XB_TOPGEN   3392
#define XCD_BAR_WORDS 3456
#define XB_SPIN_CAP (1u << 22)
constexpr int CW_BAR = 4096;
constexpr size_t CTL_ZERO_BYTES = 65536;
__device__ __forceinline__ unsigned xb_ld(unsigned* p)              { return __hip_atomic_load(p, __ATOMIC_RELAXED, __HIP_MEMORY_SCOPE_AGENT); }
__device__ __forceinline__ unsigned xb_add(unsigned* p, unsigned v) { return __hip_atomic_fetch_add(p, v, __ATOMIC_RELAXED, __HIP_MEMORY_SCOPE_AGENT); }
__device__ __forceinline__ unsigned xb_xcc_id() { return (unsigned)__builtin_amdgcn_s_getreg((3 << 11) | 20) & 0xFu; }
#define XB_SPIN(cond, bar) do { unsigned _sp = 0; while (cond) { __builtin_amdgcn_s_sleep(1); \
    if ((++_sp & 255u) == 0u) { if (xb_ld(&(bar)[XB_TMO])) break; if (_sp > XB_SPIN_CAP) { atomicAdd(&(bar)[XB_TMO], 1u); break; } } } } while (0)
struct XcdBarrier { unsigned* bar; unsigned x; volatile LAS unsigned* st; };
__device__ __forceinline__ XcdBarrier xcd_barrier_post(unsigned* bar, volatile LAS unsigned* st) {
    XcdBarrier b; b.bar = bar; b.x = xb_xcc_id(); b.st = st;
    if (threadIdx.x == 0) (void)xb_add(&bar[XB_XCNT(b.x)], 1u);
    return b;
}
__device__ __forceinline__ void xcd_barrier_complete(unsigned* bar, unsigned x, unsigned G, unsigned& nloc, unsigned& nx) {
    unsigned sum, cnt, mine, sp = 0u;
    for (;;) {
        sum = 0u; cnt = 0u; mine = 0u;
#pragma unroll
        for (unsigned j = 0; j < 16; ++j) { const unsigned c = xb_ld(&bar[XB_XCNT(j)]); sum += c; cnt += (c > 0u) ? 1u : 0u; mine = (j == x) ? c : mine; }
        if (sum == G) break;
        __builtin_amdgcn_s_sleep(1);
        if ((++sp & 255u) == 0u) { if (xb_ld(&bar[XB_TMO])) break; if (sp > XB_SPIN_CAP) { atomicAdd(&bar[XB_TMO], 1u); break; } }
    }
    nloc = mine > 0u ? mine : 1u; nx = cnt > 0u ? cnt : 1u;
}
__device__ __forceinline__ void xcd_barrier(const XcdBarrier& b) {
    asm volatile("s_waitcnt vmcnt(0)" ::: "memory");
    __syncthreads();
    if (threadIdx.x == 0) {
        size_t zb_; asm volatile("s_mov_b64 %0, 0" : "=s"(zb_)); unsigned* bar = b.bar + zb_;
        __builtin_amdgcn_s_waitcnt(0);
        const unsigned nloc = b.st[0], nx = b.st[1];
        unsigned bx = b.x; asm volatile("" : "+s"(bx));
        const unsigned old = xb_add(&bar[XB_XSUB(bx)], 1u);
        const unsigned gen = old / nloc;
        if (old + 1u == (gen + 1u) * nloc) {
            __builtin_amdgcn_fence(__ATOMIC_RELEASE, "agent");
            asm volatile("s_waitcnt vmcnt(0)" ::: "memory");
            const unsigned og = xb_add(&bar[XB_TOP], 1u);
            const unsigned tg = og / nx;
            if (og + 1u == (tg + 1u) * nx) xb_add(&bar[XB_TOPGEN], 1u);
            else XB_SPIN(xb_ld(&bar[XB_TOPGEN]) == tg, bar);
            __builtin_amdgcn_fence(__ATOMIC_ACQUIRE, "agent");
            xb_add(&bar[XB_XGEN(bx)], 1u);
            asm volatile("s_waitcnt vmcnt(0)" ::: "memory");
        } else {
            XB_SPIN(xb_ld(&bar[XB_XGEN(bx)]) == gen, bar);
            __builtin_amdgcn_fence(__ATOMIC_ACQUIRE, "agent");
            asm volatile("s_waitcnt vmcnt(0)" ::: "memory");
        }
    }
    __syncthreads();
}
enum { PH_CONVERT = 0, PH_NORM, PH_INPROJ, PH_MIXA, PH_SCAN, PH_MIXB, PH_OUTPROJ, PH_ROUTER, PH_MOEUP, PH_MOEDOWN, PH_FINAL };

template <int PH>
__device__ __forceinline__ void run_phase(const Params& p, int l, LAS unsigned char* lds) {
    if (PH == PH_CONVERT) ph_convert(p, l, lds);
    if (PH == PH_NORM) ph_norm(p, l);
    if (PH == PH_INPROJ) ph_inproj(p, lds);
    if (PH == PH_MIXA) ph_mixA(p, l, lds);
    if (PH == PH_SCAN) ph_scan(p);
    if (PH == PH_MIXB) ph_mixB(p, l, lds);
    if (PH == PH_OUTPROJ) ph_outproj(p, l, lds);
    if (PH == PH_ROUTER) ph_router(p, l);
    if (PH == PH_MOEUP) ph_moe_up(p, lds);
    if (PH == PH_MOEDOWN) ph_moe_down(p, lds);
    if (PH == PH_FINAL) ph_final(p);
}

template <int PH>
__global__ void __launch_bounds__(NTHR) k_phase(Params p, int l) {
    extern __shared__ __attribute__((aligned(16))) unsigned char lds_raw[];
    run_phase<PH>(p, l, (LAS unsigned char*)lds_raw);
}

#if ONE_LAUNCH
#ifndef USE_CG
#define USE_CG 0
#endif
__global__ void __launch_bounds__(NTHR, 2) k_mega(Params p) {
    extern __shared__ __attribute__((aligned(16))) unsigned char lds_raw[];
    LAS unsigned char* lds = (LAS unsigned char*)lds_raw;
#if USE_CG
    cg::grid_group grid = cg::this_grid();
#define GRID_BAR() grid.sync()
#else
    if (threadIdx.x < 64) ((volatile LAS unsigned*)(lds + LDS_MISC))[threadIdx.x] = 0u;
    __syncthreads();
    const XcdBarrier bar = xcd_barrier_post((unsigned*)(p.ws + WS_CTL) + CW_BAR, (volatile LAS unsigned*)(lds + LDS_MISC));
    { const unsigned Gn = gridDim.x; if (threadIdx.x == 0) { unsigned nloc, nx; xcd_barrier_complete(bar.bar, bar.x, Gn, nloc, nx); bar.st[0] = nloc; bar.st[1] = nx; } }
    __syncthreads();
#define GRID_BAR() xcd_barrier(bar)
#endif
#define AS1 __attribute__((address_space(1)))
#define AS4 __attribute__((address_space(4)))
#define KF(i) ((const float*)(const AS1 float*)kp_[i])
#define FRESH() Params q; int lv; { size_t z_; int lz_; asm volatile("s_mov_b64 %0, 0\n\ts_mov_b32 %1, 0" : "=s"(z_), "=s"(lz_)); lv = l + lz_; \
        const AS4 unsigned long long* kp_ = (const AS4 unsigned long long*)((const AS4 char*)__builtin_amdgcn_kernarg_segment_ptr() + z_); \
        q.x = KF(0); q.norm_mix = KF(1); q.w_in = KF(2); q.lru_conv_w = KF(3); q.lru_conv_b = KF(4); q.lru_wa = KF(5); q.lru_ba = KF(6); q.lru_wx = KF(7); q.lru_bx = KF(8); q.lru_lambda = KF(9); \
        q.lru_norm = KF(10); q.ssd_conv_w = KF(11); q.ssd_conv_b = KF(12); q.ssd_dt_bias = KF(13); q.ssd_a_log = KF(14); q.ssd_d = KF(15); q.ssd_norm = KF(16); q.w_out = KF(17); q.norm_ffn = KF(18); \
        q.w_coarse = KF(19); q.b_coarse = KF(20); q.w_fine = KF(21); q.b_fine = KF(22); q.w_gate = KF(23); q.w_up = KF(24); q.w_down = KF(25); q.final_norm = KF(26); \
        q.X = (float*)(AS1 float*)kp_[27]; q.ws = (unsigned char*)(AS1 unsigned char*)kp_[28]; }
#pragma unroll 1
    for (int l = 0; l < DEPTH; ++l) {
        { FRESH(); ph_convert(q, lv, lds); } { FRESH(); ph_norm(q, lv); } GRID_BAR();
        { FRESH(); ph_inproj(q, lds); } GRID_BAR();
        { FRESH(); ph_mixA(q, lv, lds); } GRID_BAR();
        { FRESH(); ph_scan(q); } GRID_BAR();
        { FRESH(); ph_mixB(q, lv, lds); } GRID_BAR();
        { FRESH(); ph_outproj(q, lv, lds); } GRID_BAR();
        { FRESH(); ph_router(q, lv); } GRID_BAR();
        { FRESH(); ph_moe_up(q, lds); } GRID_BAR();
        { FRESH(); ph_moe_down(q, lds); } GRID_BAR();
    }
    { const int l = 0; FRESH(); (void)lv; ph_final(q); }
}
#endif

template <int PH> static void launch_phase(const Params& p, int l, int grid, hipStream_t stream) {
    static bool attr = false;
    if (!attr) { (void)hipFuncSetAttribute((const void*)k_phase<PH>, hipFuncAttributeMaxDynamicSharedMemorySize, LDS_BYTES); attr = true; }
    hipLaunchKernelGGL(k_phase<PH>, dim3(grid), dim3(NTHR), LDS_BYTES, stream, p, l);
}

extern "C" void kernel_launch(void* const* d_in, const int* in_sizes, int n_in, void* d_out, int out_size, void* d_ws, size_t ws_size, hipStream_t stream) {
    if (n_in != 27 || in_sizes[0] != NTOK * DM || out_size != NTOK * DM || ws_size < WS_END) {
        fprintf(stderr, "kernel_launch: unexpected shapes (n_in %d, in0 %d, out %d, ws %zu)\n", n_in, n_in > 0 ? in_sizes[0] : -1, out_size, ws_size); return; }
    Params p{};
    const float** f = (const float**)&p;
    for (int i = 0; i < 27; ++i) f[i] = (const float*)d_in[i];
    p.X = (float*)d_out; p.ws = (unsigned char*)d_ws;
#if DBG
    { const int G = 256;
      launch_phase<PH_CONVERT>(p, 0, G, stream); launch_phase<PH_NORM>(p, 0, G, stream); launch_phase<PH_INPROJ>(p, 0, G, stream);
      launch_phase<PH_MIXA>(p, 0, G, stream); launch_phase<PH_SCAN>(p, 0, G, stream); launch_phase<PH_MIXB>(p, 0, G, stream);
      launch_phase<PH_OUTPROJ>(p, 0, G, stream);
      launch_phase<PH_ROUTER>(p, 0, G, stream); launch_phase<PH_MOEUP>(p, 0, G, stream); launch_phase<PH_MOEDOWN>(p, 0, G, stream);
      launch_phase<PH_CONVERT>(p, 1, G, stream); launch_phase<PH_NORM>(p, 1, G, stream); launch_phase<PH_INPROJ>(p, 1, G, stream);
      launch_phase<PH_MIXA>(p, 1, G, stream); launch_phase<PH_SCAN>(p, 1, G, stream); launch_phase<PH_MIXB>(p, 1, G, stream);
      launch_phase<PH_OUTPROJ>(p, 1, G, stream);
      launch_phase<PH_ROUTER>(p, 1, G, stream); launch_phase<PH_MOEUP>(p, 1, G, stream); launch_phase<PH_MOEDOWN>(p, 1, G, stream);
      (void)hipMemcpyAsync(p.ws + WS_MIX2, p.X, (size_t)NTOK * DM * 4, hipMemcpyDeviceToDevice, stream);
      launch_phase<PH_FINAL>(p, 0, G, stream);
      hipLaunchKernelGGL(dbg_zero, dim3(1), dim3(64), 0, stream, p);
      hipLaunchKernelGGL(dbg_chk_final, dim3(64), dim3(64), 0, stream, p);
      hipLaunchKernelGGL(dbg_report, dim3(NTOK * DM / 256), dim3(256), 0, stream, p);
      return; }
#endif
#if ONE_LAUNCH
    static int grid = 0;
    if (!grid) { int dev = 0, cus = 0, per_cu = 0; (void)hipGetDevice(&dev); (void)hipDeviceGetAttribute(&cus, hipDeviceAttributeMultiprocessorCount, dev);
        (void)hipFuncSetAttribute((const void*)k_mega, hipFuncAttributeMaxDynamicSharedMemorySize, LDS_BYTES);
        (void)hipOccupancyMaxActiveBlocksPerMultiprocessor(&per_cu, (const void*)k_mega, NTHR, LDS_BYTES);
        if (per_cu < 1) fprintf(stderr, "kernel_launch: occupancy query says %d blocks/CU\n", per_cu);
        (void)hipGetLastError();
        grid = cus; }
#if USE_CG
    void* args[] = {&p};
    hipError_t e = hipLaunchCooperativeKernel((const void*)k_mega, dim3(grid), dim3(NTHR), args, LDS_BYTES, stream);
    if (e != hipSuccess) fprintf(stderr, "cooperative launch failed: %s (grid %d)\n", hipGetErrorString(e), grid);
#else
    (void)hipMemsetAsync((char*)d_ws + WS_CTL, 0, CTL_ZERO_BYTES, stream);
    hipLaunchKernelGGL(k_mega, dim3(grid), dim3(NTHR), LDS_BYTES, stream, p);
#endif
#else
    const int G = 256;
    for (int l = 0; l < DEPTH; ++l) {
        launch_phase<PH_CONVERT>(p, l, G, stream);
        launch_phase<PH_NORM>(p, l, G, stream);
        launch_phase<PH_INPROJ>(p, l, G, stream);
        launch_phase<PH_MIXA>(p, l, G, stream);
        launch_phase<PH_SCAN>(p, l, G, stream);
        launch_phase<PH_MIXB>(p, l, G, stream);
        launch_phase<PH_OUTPROJ>(p, l, G, stream);
        launch_phase<PH_ROUTER>(p, l, G, stream);
        launch_phase<PH_MOEUP>(p, l, G, stream);
        launch_phase<PH_MOEDOWN>(p, l, G, stream);
    }
    launch_phase<PH_FINAL>(p, 0, G, stream);
#endif
}
```

```cpp
#include <hip/hip_runtime.h>
#include <hip/hip_cooperative_groups.h>
#include <cstdint>
#include <cstdio>
namespace cg = cooperative_groups;

#ifndef TSEL
#define TSEL 0
#endif
#ifndef ONE_LAUNCH
#define ONE_LAUNCH 1
#endif

#define LAS __attribute__((address_space(3)))
typedef unsigned short bf16_t;
typedef short bf16x8 __attribute__((ext_vector_type(8)));
typedef float f32x4 __attribute__((ext_vector_type(4)));
typedef unsigned u32x2 __attribute__((ext_vector_type(2)));
typedef unsigned u32x4 __attribute__((ext_vector_type(4)));

constexpr int NB = 2, SEQ = 8192, DM = 1024, NTOK = NB * SEQ, DEPTH = 2;
constexpr int INC = 5136, PROJW = 5120;
constexpr int SSD_CD = 2048;
constexpr int O_LX = 0, O_LG = 1024, O_Z = 2048, O_XS = 3072, O_B = 4096, O_C = 4608;
constexpr int NEXP = 32, DEXP = 512, NCH = 64, CH = 128;
constexpr int NTHR = 512;
constexpr int MAXTILES = 160;
constexpr int LISTCAP = NTOK;

constexpr size_t MiB = 1u << 20;
constexpr size_t WS_CTL = 0;
constexpr size_t WS_WIN = 1 * MiB;
constexpr size_t WS_WOUT = 11 * MiB;
constexpr size_t WS_WGU = 15 * MiB;
constexpr size_t WS_WD = 79 * MiB;
constexpr size_t WS_PROJ = 111 * MiB;
constexpr size_t WS_H = WS_PROJ;
constexpr size_t WS_HID = WS_PROJ + 32 * MiB;
constexpr size_t WS_YSLOT = WS_PROJ + 72 * MiB;
constexpr size_t WS_LTOK = WS_PROJ + 136 * MiB;
constexpr size_t WS_LW = WS_PROJ + 138 * MiB;
constexpr size_t WS_MIX = 271 * MiB;
constexpr size_t WS_XN = WS_MIX;
constexpr size_t WS_STATES = 335 * MiB;
constexpr size_t WS_DTRAW = 399 * MiB;
constexpr size_t WS_ROWSS = 400 * MiB;
constexpr size_t WS_LSUM = 401 * MiB;
constexpr size_t WS_LCARRY = 402 * MiB;
constexpr size_t WS_DECAY = 403 * MiB;
constexpr size_t WS_PREV = 472 * MiB;
constexpr size_t WS_WAT = 504 * MiB;
constexpr size_t WS_END = 505 * MiB;

constexpr int LDS_BYTES = 152 * 1024;
constexpr int LDS_TB = 151552 + 256;
constexpr int LDS_MISC = 151552;

struct Params {
    const float *x, *norm_mix, *w_in, *lru_conv_w, *lru_conv_b, *lru_wa, *lru_ba, *lru_wx, *lru_bx, *lru_lambda, *lru_norm,
        *ssd_conv_w, *ssd_conv_b, *ssd_dt_bias, *ssd_a_log, *ssd_d, *ssd_norm, *w_out, *norm_ffn, *w_coarse, *b_coarse, *w_fine, *b_fine,
        *w_gate, *w_up, *w_down, *final_norm;
    float* X;
    unsigned char* ws;
};

__device__ __forceinline__ float bf2f(bf16_t v) { return __uint_as_float((unsigned)v << 16); }
__device__ __forceinline__ unsigned f2bf(float f) { unsigned u = __float_as_uint(f); return (u + 0x7fffu + ((u >> 16) & 1u)) >> 16; }
__device__ __forceinline__ unsigned pk2(float lo, float hi) { return f2bf(lo) | (f2bf(hi) << 16); }
#define SWZ_XOR(v, m) __builtin_bit_cast(float, __builtin_amdgcn_ds_swizzle(__builtin_bit_cast(int, (v)), ((m) << 10) | 0x1f))
__device__ __forceinline__ float wave_sum(float v) {
    v += SWZ_XOR(v, 1); v += SWZ_XOR(v, 2); v += SWZ_XOR(v, 4); v += SWZ_XOR(v, 8); v += SWZ_XOR(v, 16);
    return __builtin_bit_cast(float, __builtin_amdgcn_readlane(__builtin_bit_cast(int, v), 0)) + __builtin_bit_cast(float, __builtin_amdgcn_readlane(__builtin_bit_cast(int, v), 32));
}
__device__ __forceinline__ float sigmoid_f(float x) { return 1.f / (1.f + __expf(-x)); }
__device__ __forceinline__ float silu_f(float x) { return x * sigmoid_f(x); }
__device__ __forceinline__ float softplus_f(float x) { return x > 20.f ? x : log1pf(__expf(x)); }
__device__ __forceinline__ float gelu_tanh_f(float x) { const float u = 0.7978845608028654f * (x + 0.044715f * x * x * x); return 0.5f * x * (1.f + tanhf(u)); }

__device__ __forceinline__ int opaque_tid() { int t = threadIdx.x; asm volatile("" : "+v"(t)); return t; }
#define LDS_WAIT() asm volatile("s_waitcnt lgkmcnt(0)" ::: "memory")
#define VM_WAIT() asm volatile("s_waitcnt vmcnt(0)" ::: "memory")

__device__ __forceinline__ void tr_item(const float* src, int ld, int k0, int c0, bf16_t* dst, int ldd, int r0, const float* kscale, LAS float* scr, int lane) {
#pragma unroll 8
    for (int i = 0; i < 32; ++i) {
        const int kk = 2 * i + (lane >> 5), nn = lane & 31;
        float v = src[(size_t)(k0 + kk) * ld + c0 + nn];
        if (kscale) v *= kscale[k0 + kk];
        scr[kk * 33 + nn] = v;
    }
    LDS_WAIT();
    const int c = lane & 7;
#pragma unroll
    for (int j = 0; j < 4; ++j) {
        const int n = (lane >> 3) + 8 * j; const LAS float* s = scr + (8 * c) * 33 + n;
        u32x4 o; o.x = pk2(s[0 * 33], s[1 * 33]); o.y = pk2(s[2 * 33], s[3 * 33]); o.z = pk2(s[4 * 33], s[5 * 33]); o.w = pk2(s[6 * 33], s[7 * 33]);
        *(u32x4*)(dst + (size_t)(r0 + n) * ldd + k0 + 8 * c) = o;
    }
    LDS_WAIT();
}

__device__ __forceinline__ void ph_convert(const Params& p, int l, LAS unsigned char* lds) {
    const int tid = opaque_tid(), lane = tid & 63, wave = tid >> 6;
    LAS float* scr = (LAS float*)(lds + wave * 16384);
    const int gw = blockIdx.x * 8 + wave, NGW = gridDim.x * 8;
    bf16_t* WinT = (bf16_t*)(p.ws + WS_WIN); bf16_t* WoutT = (bf16_t*)(p.ws + WS_WOUT); bf16_t* WguT = (bf16_t*)(p.ws + WS_WGU); bf16_t* WdT = (bf16_t*)(p.ws + WS_WD);
    constexpr int I_IN = 16 * 160, I_OUT = 32 * 32, I_GU = 32 * 512, I_D = 32 * 256, I_W = 64;
    for (int it = gw; it < I_W + I_IN + I_OUT + I_GU + I_D; it += NGW) {
        int r = it;
        if (r < I_W) { const int m = r >> 1, nb = r & 1, head = m >> 1, which = m & 1;
            tr_item((which ? p.lru_wx : p.lru_wa) + ((size_t)l * 16 + head) * 4096, 64, 0, nb * 32, (bf16_t*)(p.ws + WS_WAT) + (head * 2 + which) * 4096, 64, nb * 32, nullptr, scr, lane); continue; }
        r -= I_W;
        if (r < I_IN) { const int kb = r / 160, nb = r % 160; tr_item(p.w_in + (size_t)l * DM * INC, INC, kb * 64, nb * 32, WinT, DM, nb * 32, nullptr, scr, lane); continue; }
        r -= I_IN;
        if (r < I_OUT) { const int kb = r / 32, nb = r % 32; const int k0 = kb * 64;
            const float* ks = (k0 < 1024) ? (p.lru_norm + l * 1024) : (p.ssd_norm + l * 1024 - 1024);
            tr_item(p.w_out + (size_t)l * 2048 * DM, DM, k0, nb * 32, WoutT, 2048, nb * 32, ks, scr, lane); continue; }
        r -= I_OUT;
        if (r < I_GU) { const int e = r / 512, q = r % 512, kb = q / 32, rb = q % 32, pn = rb >> 3, jb = rb & 7;
            const float* src = (jb < 4 ? p.w_gate : p.w_up) + ((size_t)l * NEXP + e) * DM * DEXP;
            const int c0 = 128 * pn + 32 * (jb & 3);
            tr_item(src, DEXP, kb * 64, c0, WguT + (size_t)e * 1024 * 1024, DM, rb * 32, nullptr, scr, lane); continue; }
        r -= I_GU;
        { const int e = r / 256, q = r % 256, kb = q / 32, nb = q % 32;
            tr_item(p.w_down + ((size_t)l * NEXP + e) * DEXP * DM, DM, kb * 64, nb * 32, WdT + (size_t)e * 1024 * 512, DEXP, nb * 32, nullptr, scr, lane); }
    }
}

__device__ __forceinline__ void ph_norm(const Params& p, int l, LAS unsigned char* lds) {
    const int tid = opaque_tid(), lane = tid & 63, wave = tid >> 6;
    LAS float* wl = (LAS float*)lds;
    __syncthreads();
    for (int i = tid; i < 4096; i += NTHR) { const int k = i >> 2, q4 = i & 3; const f32x4 w = *(const f32x4*)(p.w_in + ((size_t)l * DM + k) * INC + PROJW + q4 * 4);
        wl[(q4 * 4 + 0) * 1024 + k] = w.x; wl[(q4 * 4 + 1) * 1024 + k] = w.y; wl[(q4 * 4 + 2) * 1024 + k] = w.z; wl[(q4 * 4 + 3) * 1024 + k] = w.w; }
    __syncthreads();
    const int gw = blockIdx.x * 8 + wave, NGW = gridDim.x * 8;
    bf16_t* xn = (bf16_t*)(p.ws + WS_XN); float* dtraw = (float*)(p.ws + WS_DTRAW);
    const bf16_t* ys = (const bf16_t*)(p.ws + WS_YSLOT);
    const float* nw = p.norm_mix + l * DM;
    if (blockIdx.x == 0 && tid < 64) ((int*)(p.ws + WS_CTL))[tid] = 0;
    for (int row = gw; row < NTOK; row += NGW) {
        asm volatile("" ::: "memory");
        f32x4 v[4];
        const float* src = (l == 0 ? p.x : p.X) + (size_t)row * DM;
#pragma unroll
        for (int j = 0; j < 4; ++j) v[j] = *(const f32x4*)(src + j * 256 + lane * 4);
        if (l > 0) {
#pragma unroll
            for (int s = 0; s < 2; ++s)
#pragma unroll
                for (int j = 0; j < 4; ++j) { const u32x2 y = *(const u32x2*)(ys + ((size_t)s * NTOK + row) * DM + j * 256 + lane * 4);
                    v[j].x += __uint_as_float(y.x << 16); v[j].y += __uint_as_float(y.x & 0xffff0000u); v[j].z += __uint_as_float(y.y << 16); v[j].w += __uint_as_float(y.y & 0xffff0000u); }
#pragma unroll
            for (int j = 0; j < 4; ++j) *(f32x4*)(p.X + (size_t)row * DM + j * 256 + lane * 4) = v[j];
        }
        float ss = 0.f;
#pragma unroll
        for (int j = 0; j < 4; ++j) ss += (v[j].x * v[j].x + v[j].y * v[j].y) + (v[j].z * v[j].z + v[j].w * v[j].w);
        const float rstd = rsqrtf(wave_sum(ss) * (1.f / DM) + 1e-6f);
#pragma unroll
        for (int j = 0; j < 4; ++j) { const f32x4 w = *(const f32x4*)(nw + j * 256 + lane * 4); v[j] = v[j] * rstd * w;
            u32x2 o; o.x = pk2(v[j].x, v[j].y); o.y = pk2(v[j].z, v[j].w); *(u32x2*)(xn + (size_t)row * DM + j * 256 + lane * 4) = o; }
        float dacc[16];
#pragma unroll
        for (int h = 0; h < 16; ++h) { float a = 0.f;
#pragma unroll
            for (int j = 0; j < 4; ++j) { const f32x4 w = *(const LAS f32x4*)(wl + h * 1024 + j * 256 + lane * 4); a += (v[j].x * w.x + v[j].y * w.y) + (v[j].z * w.z + v[j].w * w.w); }
            dacc[h] = a; }
        float mine = 0.f;
#pragma unroll
        for (int h = 0; h < 16; ++h) { const float s = wave_sum(dacc[h]); if (lane == h) mine = s; }
        if (lane < 16) dtraw[(size_t)row * 16 + lane] = mine;
    }
}

namespace pg8 {
constexpr int BM = 256, BK = 64, HALF = 128, HTB = HALF * BK * 2, STAGE_BYTES = 8 * HTB, NXCD = 8, WGM = 8;
__host__ __device__ __forceinline__ int lds_byte(int r, int c) { const int st = (r >> 4) * 2 + (c >> 5), rr = r & 15, cc = c & 31, ob = rr * 64 + cc * 2; return st * 1024 + (ob ^ (((ob >> 9) & 1) << 5)); }
__host__ __device__ __forceinline__ void stage_rc(int b, int& R, int& C) { const int st = b / 1024, sb = b % 1024, swz = sb ^ (((sb >> 9) & 1) << 5); R = (st >> 1) * 16 + swz / 64; C = (st & 1) * 32 + (swz % 64) / 2; }
__host__ __device__ __forceinline__ int perm32(int rho) { const int n = rho >> 4, i = rho & 15; return 8 * (i >> 2) + 4 * n + (i & 3); }
struct Unit { int pm, pn; const bf16_t* a; const bf16_t* b; const int* rows; int nrows; };
__device__ __forceinline__ unsigned cvt_pk_bf16(float lo, float hi) { unsigned r; asm volatile("v_cvt_pk_bf16_f32 %0, %1, %2" : "=v"(r) : "v"(lo), "v"(hi)); return r; }

struct GridOrder {
    int nM, nN, nwg, G, c;
    __device__ void init(int nM_, int nN_, int G_, int c_) { nM = nM_; nN = nN_; nwg = nM * nN; G = G_; c = c_; }
    __device__ bool tile(int i, int& pm, int& pn) const {
        const long L = (long)i * G + c; if (L >= nwg) return false;
        int wgid = (int)L; { const int q = nwg / NXCD, r = nwg % NXCD, xcd = wgid % NXCD, off = wgid / NXCD; wgid = (xcd < r ? xcd * (q + 1) : r * (q + 1) + (xcd - r) * q) + off; }
        const int nig = WGM * nN, gid = wgid / nig, fm = gid * WGM, gsz = (nM - fm) < WGM ? (nM - fm) : WGM;
        pm = fm + ((wgid % nig) % gsz); pn = (wgid % nig) / gsz; return true;
    }
};

template <class Epi, class Sched, bool GATHER>
__device__ __forceinline__ void gemm_phase(LAS unsigned char* lds, const int K, const int lda, const int ldb, const Sched& S, const Epi& E) {
    const int tid = opaque_tid(), wid = __builtin_amdgcn_readfirstlane(tid >> 6), lane = tid & 63, wr = wid >> 2, wc = wid & 3, fr = lane & 15, fq = lane >> 4;
    const int nt = K / BK;
    unsigned voffA[2], voffB[2];
#pragma unroll
    for (int i = 0; i < 2; ++i) { int R, C; stage_rc(tid * 16 + i * 8192, R, C); const int Rb = Epi::PERM ? ((R & ~31) + perm32(R & 31)) : R;
        voffA[i] = (unsigned)(R * lda + C) * 2u; voffB[i] = (unsigned)(Rb * ldb + C) * 2u; }
    const size_t hstepA = (size_t)HALF * lda * 2, hstepB = (size_t)HALF * ldb * 2;
    const size_t kstep = (size_t)(BK * 2);
    const unsigned ldsw = (unsigned)wid * 1024u;
    const int aoff = lds_byte(wr * 64 + fr, fq * 8), boff = lds_byte(wc * 32 + fr, fq * 8);
#define PG8_SA(b, h) (((b) * 2 + (h)) * HTB)
#define PG8_SB(b, h) ((4 + (b) * 2 + (h)) * HTB)
#define PG8_GLDS(bufoff, gp, i_) __builtin_amdgcn_global_load_lds((const unsigned*)(gp), (LAS unsigned*)(lds + (bufoff) + ldsw + (i_) * 8192), 16, 0, 0)
#define PG8_STAGE_B(bufoff, gbase, h) do { PG8_GLDS(bufoff, (const char*)(gbase) + (h) * hstepB + voffB[0], 0); PG8_GLDS(bufoff, (const char*)(gbase) + (h) * hstepB + voffB[1], 1); } while (0)
#define PG8_STAGE_A(bufoff, gbase, h, nx) do { if (GATHER) { PG8_GLDS(bufoff, (const char*)(gbase) + ((nx) ? nvo[h][0] : vo[h][0]), 0); PG8_GLDS(bufoff, (const char*)(gbase) + ((nx) ? nvo[h][1] : vo[h][1]), 1); } \
        else { PG8_GLDS(bufoff, (const char*)(gbase) + (h) * hstepA + voffA[0], 0); PG8_GLDS(bufoff, (const char*)(gbase) + (h) * hstepA + voffA[1], 1); } } while (0)
#define PG8_LDA(dst, b, h) do { _Pragma("unroll") for (int m = 0; m < 4; ++m) _Pragma("unroll") for (int k = 0; k < 2; ++k) dst[m][k] = *(const LAS bf16x8*)(lds + PG8_SA(b, h) + aoff + m * 2048 + k * 1024); } while (0)
#define PG8_LDB(dst, b, h) do { _Pragma("unroll") for (int n = 0; n < 2; ++n) _Pragma("unroll") for (int k = 0; k < 2; ++k) dst[n][k] = *(const LAS bf16x8*)(lds + PG8_SB(b, h) + boff + n * 2048 + k * 1024); } while (0)
#define PG8_MMA(ai, bj, At, Bt) do { __builtin_amdgcn_s_setprio(1); _Pragma("unroll") for (int m = 0; m < 4; ++m) _Pragma("unroll") for (int n = 0; n < 2; ++n) _Pragma("unroll") for (int k = 0; k < 2; ++k) \
        acc[ai][bj][m][n] = __builtin_amdgcn_mfma_f32_16x16x32_bf16(Bt[n][k], At[m][k], acc[ai][bj][m][n], 0, 0, 0); __builtin_amdgcn_s_setprio(0); } while (0)
#define PG8_WAIT_V(n) asm volatile("s_waitcnt vmcnt(" #n ")" ::: "memory")
#define PG8_WAIT_L(n) asm volatile("s_waitcnt lgkmcnt(" #n ")" ::: "memory")
#define PG8_BAR __builtin_amdgcn_s_barrier()
#define PG8_SCHED __builtin_amdgcn_sched_barrier(0)
#define PG8_GVO(dst, u) do { if (GATHER) { _Pragma("unroll") for (int h = 0; h < 2; ++h) _Pragma("unroll") for (int i = 0; i < 2; ++i) { int R, C; stage_rc(tid * 16 + i * 8192, R, C); \
        const int rr = h * HALF + R; const int tok = (rr < (u).nrows) ? ((u).rows[rr] >> 1) : 0; dst[h][i] = (unsigned)(tok * lda + C) * 2u; } } } while (0)
    Unit cur, nxt; int ui = 0;
    if (!S.next(0, cur)) return;
    f32x4 acc[2][2][4][2];
#pragma unroll
    for (int a = 0; a < 2; ++a)
#pragma unroll
        for (int b = 0; b < 2; ++b)
#pragma unroll
            for (int m = 0; m < 4; ++m)
#pragma unroll
                for (int n = 0; n < 2; ++n) acc[a][b][m][n] = (f32x4){0.f, 0.f, 0.f, 0.f};
    bf16x8 At[4][2], B0[2][2], B1[2][2];
    unsigned vo[2][2] = {{0u, 0u}, {0u, 0u}}, nvo[2][2] = {{0u, 0u}, {0u, 0u}};
    PG8_GVO(vo, cur);
    if (GATHER) {
#pragma unroll
        for (int h = 0; h < 2; ++h) { nvo[h][0] = vo[h][0]; nvo[h][1] = vo[h][1]; } }
    const char* cA = (const char*)cur.a; const char* cB = (const char*)cur.b;
    PG8_STAGE_B(PG8_SB(0, 0), cB, 0); PG8_STAGE_B(PG8_SB(0, 1), cB, 1); PG8_STAGE_A(PG8_SA(0, 0), cA, 0, false); PG8_STAGE_A(PG8_SA(0, 1), cA, 1, false);
    if (wr == 1) PG8_BAR;
    PG8_WAIT_V(2); PG8_BAR;
    PG8_STAGE_B(PG8_SB(1, 0), cB + kstep, 0); PG8_STAGE_A(PG8_SA(1, 0), cA + kstep, 0, false); PG8_STAGE_B(PG8_SB(1, 1), cB + kstep, 1);
    PG8_WAIT_V(6); PG8_BAR;
    for (;;) {
        const bool has_next = S.next(ui + 1, nxt);
        const char* nA = has_next ? (const char*)nxt.a : cA; const char* nB = has_next ? (const char*)nxt.b : cB;
        if (GATHER && has_next) PG8_GVO(nvo, nxt);
        for (int t = 0; t < nt; t += 2) {
            const bool last = (t == nt - 2);
            const char* a1 = cA + (size_t)(t + 1) * kstep;
            const char* a2 = last ? nA : cA + (size_t)(t + 2) * kstep; const char* b2 = last ? nB : cB + (size_t)(t + 2) * kstep;
            const char* a3 = a2 + kstep; const char* b3 = b2 + kstep;
            const bool nx = GATHER && last;
            PG8_LDB(B0, 0, 0); PG8_LDB(B1, 0, 1); PG8_SCHED; PG8_LDA(At, 0, 0); PG8_STAGE_A(PG8_SA(1, 1), a1, 1, false);
            PG8_WAIT_V(8); PG8_WAIT_L(0); PG8_BAR; PG8_MMA(0, 0, At, B0); PG8_MMA(0, 1, At, B1); PG8_BAR; PG8_SCHED;
            PG8_LDA(At, 0, 1); PG8_STAGE_B(PG8_SB(0, 0), b2, 0); PG8_STAGE_B(PG8_SB(0, 1), b2, 1); PG8_STAGE_A(PG8_SA(0, 0), a2, 0, nx);
            PG8_WAIT_V(8); PG8_WAIT_L(0); PG8_BAR; PG8_MMA(1, 0, At, B0); PG8_MMA(1, 1, At, B1); PG8_BAR; PG8_SCHED;
            PG8_LDB(B0, 1, 0); PG8_LDB(B1, 1, 1); PG8_SCHED; PG8_LDA(At, 1, 0); PG8_STAGE_A(PG8_SA(0, 1), a2, 1, nx);
            PG8_WAIT_V(8); PG8_WAIT_L(0); PG8_BAR; PG8_MMA(0, 0, At, B0); PG8_MMA(0, 1, At, B1); PG8_BAR; PG8_SCHED;
            PG8_LDA(At, 1, 1); PG8_STAGE_B(PG8_SB(1, 0), b3, 0); PG8_STAGE_B(PG8_SB(1, 1), b3, 1); PG8_STAGE_A(PG8_SA(1, 0), a3, 0, nx);
            PG8_WAIT_V(8); PG8_WAIT_L(0); PG8_BAR; PG8_MMA(1, 0, At, B0); PG8_MMA(1, 1, At, B1); PG8_BAR; PG8_SCHED;
        }
        if (wr == 0) PG8_BAR;
        E(acc, cur, wr, wc, fr, fq);
        if (!has_next) break;
#pragma unroll
        for (int a = 0; a < 2; ++a)
#pragma unroll
            for (int b = 0; b < 2; ++b)
#pragma unroll
                for (int m = 0; m < 4; ++m)
#pragma unroll
                    for (int n = 0; n < 2; ++n) acc[a][b][m][n] = (f32x4){0.f, 0.f, 0.f, 0.f};
        cur = nxt; cA = nA; cB = nB; ++ui;
        if (GATHER) {
#pragma unroll
            for (int h = 0; h < 2; ++h) { vo[h][0] = nvo[h][0]; vo[h][1] = nvo[h][1]; } }
        if (wr == 1) PG8_BAR;
    }
    PG8_WAIT_V(0);
    PG8_BAR;
#undef PG8_SA
#undef PG8_SB
#undef PG8_GLDS
#undef PG8_STAGE_A
#undef PG8_STAGE_B
#undef PG8_LDA
#undef PG8_LDB
#undef PG8_MMA
#undef PG8_WAIT_V
#undef PG8_WAIT_L
#undef PG8_BAR
#undef PG8_SCHED
#undef PG8_GVO
}
}

struct SchedIn { pg8::GridOrder o; const bf16_t* A; const bf16_t* B;
    __device__ __forceinline__ bool next(int i, pg8::Unit& u) const { int pm, pn; if (!o.tile(i, pm, pn)) return false; u.pm = pm; u.pn = pn; u.a = A + (size_t)pm * 256 * DM; u.b = B + (size_t)pn * 256 * DM; u.rows = nullptr; u.nrows = 0; return true; } };
struct EpiProj { static constexpr bool PERM = true; bf16_t* O;
    __device__ __forceinline__ void operator()(const f32x4 (&acc)[2][2][4][2], const pg8::Unit& u, int wr, int wc, int fr, int fq) const {
        const int row0 = u.pm * 256 + wr * 64 + fr, col0 = u.pn * 256 + wc * 32 + 8 * fq;
#pragma unroll
        for (int ai = 0; ai < 2; ++ai)
#pragma unroll
            for (int m = 0; m < 4; ++m) { bf16_t* rowp = O + (size_t)(row0 + ai * 128 + m * 16) * PROJW + col0;
#pragma unroll
                for (int bj = 0; bj < 2; ++bj) { const f32x4 v0 = acc[ai][bj][m][0], v1 = acc[ai][bj][m][1]; u32x4 w;
                    w.x = pg8::cvt_pk_bf16(v0[0], v0[1]); w.y = pg8::cvt_pk_bf16(v0[2], v0[3]); w.z = pg8::cvt_pk_bf16(v1[0], v1[1]); w.w = pg8::cvt_pk_bf16(v1[2], v1[3]);
                    *(u32x4*)(rowp + bj * 128) = w; } }
    } };
__device__ __forceinline__ void ph_inproj(const Params& p, LAS unsigned char* lds) {
    SchedIn S; S.o.init(64, 20, gridDim.x, blockIdx.x); S.A = (const bf16_t*)(p.ws + WS_XN); S.B = (const bf16_t*)(p.ws + WS_WIN);
    pg8::gemm_phase<EpiProj, SchedIn, false>(lds, DM, DM, DM, S, EpiProj{(bf16_t*)(p.ws + WS_PROJ)});
}

__device__ __forceinline__ void row_rstd(const float* rowss, int row, float& rl, float& rs) {
    const f32x4 a = *(const f32x4*)(rowss + (size_t)row * 8), b = *(const f32x4*)(rowss + (size_t)row * 8 + 4);
    rl = rsqrtf(((a.x + a.y) + (a.z + a.w)) * (1.f / 1024.f) + 1e-6f); rs = rsqrtf(((b.x + b.y) + (b.z + b.w)) * (1.f / 1024.f) + 1e-6f);
}
struct SchedOut { pg8::GridOrder o; const bf16_t* A; const bf16_t* B;
    __device__ __forceinline__ bool next(int i, pg8::Unit& u) const { int pm, pn; if (!o.tile(i, pm, pn)) return false; u.pm = pm; u.pn = pn; u.a = A + (size_t)pm * 256 * 2048; u.b = B + (size_t)pn * 256 * 2048; u.rows = nullptr; u.nrows = 0; return true; } };
struct EpiOut { static constexpr bool PERM = false; const float* resid; float* out; const float* rowss; int half;
    __device__ __forceinline__ void operator()(const f32x4 (&acc)[2][2][4][2], const pg8::Unit& u, int wr, int wc, int fr, int fq) const {
        const int row0 = u.pm * 256 + wr * 64 + fr, col0 = u.pn * 256 + wc * 32 + 4 * fq;
#pragma unroll
        for (int ai = 0; ai < 2; ++ai)
#pragma unroll
            for (int m = 0; m < 4; ++m) { const int row = row0 + ai * 128 + m * 16; float rl, rs; row_rstd(rowss, row, rl, rs); const float sc = half ? rs : rl; const size_t off = (size_t)row * DM + col0;
#pragma unroll
                for (int bj = 0; bj < 2; ++bj)
#pragma unroll
                    for (int n = 0; n < 2; ++n) { const f32x4 bs = *(const f32x4*)(resid + off + bj * 128 + n * 16); *(f32x4*)(out + off + bj * 128 + n * 16) = bs + acc[ai][bj][m][n] * sc; } }
    } };
__device__ __forceinline__ void ph_outproj(const Params& p, int l, LAS unsigned char* lds) {
    const float* rowss = (const float*)(p.ws + WS_ROWSS);
    SchedOut S; S.o.init(64, 4, gridDim.x, blockIdx.x); S.A = (const bf16_t*)(p.ws + WS_MIX); S.B = (const bf16_t*)(p.ws + WS_WOUT);
    pg8::gemm_phase<EpiOut, SchedOut, false>(lds, 1024, 2048, 2048, S, EpiOut{(l == 0) ? p.x : p.X, p.X, rowss, 0});
    S.A += 1024; S.B += 1024;
    pg8::gemm_phase<EpiOut, SchedOut, false>(lds, 1024, 2048, 2048, S, EpiOut{p.X, p.X, rowss, 1});
}

constexpr int TS = 272;
constexpr int US = 528;
constexpr int L_TAB = 139264;
constexpr int L_RPART = L_TAB + 6144;
__device__ __forceinline__ float bperm_f(int srclane, float v) { return __builtin_bit_cast(float, __builtin_amdgcn_ds_bpermute(srclane << 2, __builtin_bit_cast(int, v))); }
__device__ __forceinline__ float fast_gelu(float x) { return x * sigmoid_f(1.5957691216057308f * (x + 0.044715f * x * x * x)); }
__device__ __forceinline__ float bflo(unsigned v) { return __uint_as_float(v << 16); }
__device__ __forceinline__ float bfhi(unsigned v) { return __uint_as_float(v & 0xffff0000u); }

template <int MODE, bool ACT>
__device__ __forceinline__ void stage_conv(const bf16_t* proj, int R0, int t0, int pcol0, int NC, const float* cw, int cwld, const float* cb, LAS unsigned char* dst, int RS, const LAS float* wt, int tid) {
    const int npair = NC >> 1;
    for (int it = tid; it < npair * 16; it += NTHR) {
        const int pr = it % npair, oct = it / npair, cc = pr * 2, l0 = oct * 8;
        float w0[4], w1[4];
#pragma unroll
        for (int k = 0; k < 4; ++k) { w0[k] = cw[k * cwld + cc]; w1[k] = cw[k * cwld + cc + 1]; }
        const float b0 = cb[cc], b1 = cb[cc + 1];
        float x0[11], x1[11];
#pragma unroll
        for (int k = 0; k < 11; ++k) { const int tt = t0 + l0 - 3 + k; const int row = R0 + l0 - 3 + k;
            const unsigned v = (tt >= 0) ? *(const unsigned*)(proj + (size_t)row * PROJW + pcol0 + cc) : 0u; x0[k] = bflo(v); x1[k] = bfhi(v); }
        float y0[8], y1[8];
#pragma unroll
        for (int i = 0; i < 8; ++i) { float a = b0, b = b1;
#pragma unroll
            for (int k = 0; k < 4; ++k) { a += w0[k] * x0[i + k]; b += w1[k] * x1[i + k]; }
            if (ACT) { a = silu_f(a); b = silu_f(b); }
            if (MODE == 1 && wt) { const float sc = wt[(cc >> 6) * 128 + l0 + i]; a *= sc; b *= sc; }
            y0[i] = a; y1[i] = b; }
        if (MODE == 0) {
#pragma unroll
            for (int i = 0; i < 8; ++i) *(LAS unsigned*)(dst + (l0 + i) * RS + cc * 2) = pg8::cvt_pk_bf16(y0[i], y1[i]);
        } else {
            u32x4 q0, q1; q0.x = pg8::cvt_pk_bf16(y0[0], y0[1]); q0.y = pg8::cvt_pk_bf16(y0[2], y0[3]); q0.z = pg8::cvt_pk_bf16(y0[4], y0[5]); q0.w = pg8::cvt_pk_bf16(y0[6], y0[7]);
            q1.x = pg8::cvt_pk_bf16(y1[0], y1[1]); q1.y = pg8::cvt_pk_bf16(y1[2], y1[3]); q1.z = pg8::cvt_pk_bf16(y1[4], y1[5]); q1.w = pg8::cvt_pk_bf16(y1[6], y1[7]);
            *(LAS u32x4*)(dst + cc * TS + l0 * 2) = q0; *(LAS u32x4*)(dst + (cc + 1) * TS + l0 * 2) = q1;
        }
    }
}

template <bool WT>
__device__ __forceinline__ void ssd_tables(const Params& p, int l_, int R0, int g, LAS unsigned char* lds, int wid, int lane) {
    if (wid < 4) { const int h = 4 * g + wid; const float* dtraw = (const float*)(p.ws + WS_DTRAW);
        LAS float* dtv = (LAS float*)(lds + L_TAB) + wid * 128; LAS float* acs = (LAS float*)(lds + L_TAB + 2048) + wid * 128; LAS float* wt = (LAS float*)(lds + L_TAB + 4096) + wid * 128;
        const float bias = p.ssd_dt_bias[l_ * 16 + h], A = -__expf(p.ssd_a_log[l_ * 16 + h]);
        const float dt0 = softplus_f(dtraw[(size_t)(R0 + 2 * lane) * 16 + h] + bias), dt1 = softplus_f(dtraw[(size_t)(R0 + 2 * lane + 1) * 16 + h] + bias);
        const float v0 = dt0 * A, v1 = dt1 * A; float sc = v0 + v1;
#pragma unroll
        for (int d = 1; d < 64; d <<= 1) { const float t = bperm_f(lane - d, sc); if (lane >= d) sc += t; }
        const float a0 = sc - v1, a1 = sc;
        dtv[2 * lane] = dt0; dtv[2 * lane + 1] = dt1; acs[2 * lane] = a0; acs[2 * lane + 1] = a1;
        if (WT) { const float alast = __builtin_bit_cast(float, __builtin_amdgcn_readlane(__builtin_bit_cast(int, sc), 63)); wt[2 * lane] = dt0 * __expf(alast - a0); wt[2 * lane + 1] = dt1 * __expf(alast - a1);
            if (lane == 0) ((float*)(p.ws + WS_DECAY))[(R0 >> 7) * 16 + h] = __expf(alast); }
    }
}

template <bool FINAL>
__device__ __forceinline__ void lru_wave(const Params& p, int l_, int bc  , int g, const LAS unsigned char* U, LAS unsigned char* H, int wid, int lane) {
    const int hh = wid >> 1, sub = wid & 1, h = 4 * g + hh, jj = lane & 15, quad = lane >> 4;
    const bf16_t* wat = (const bf16_t*)(p.ws + WS_WAT) + (size_t)h * 2 * 4096;
    bf16x8 wa[2][2], wx[2][2];
    float ba[2], bx[2], c8[2], hin[2], P[2];
#pragma unroll
    for (int nt = 0; nt < 2; ++nt) { const int j = 32 * sub + 16 * nt + jj, col = h * 64 + j;
#pragma unroll
        for (int kc = 0; kc < 2; ++kc) { wa[nt][kc] = *(const bf16x8*)(wat + j * 64 + kc * 32 + quad * 8); wx[nt][kc] = *(const bf16x8*)(wat + 4096 + j * 64 + kc * 32 + quad * 8); }
        ba[nt] = p.lru_ba[l_ * 1024 + col]; bx[nt] = p.lru_bx[l_ * 1024 + col]; c8[nt] = -8.f * softplus_f(-p.lru_lambda[l_ * 1024 + col]);
        hin[nt] = FINAL ? ((const float*)(p.ws + WS_LCARRY))[(size_t)bc * 1024 + col] : 0.f; P[nt] = 1.f; }
#pragma unroll 1
    for (int mt = 0; mt < 8; ++mt) {
        bf16x8 ua[2];
#pragma unroll
        for (int kc = 0; kc < 2; ++kc) ua[kc] = *(const LAS bf16x8*)(U + (16 * mt + jj) * US + (hh * 64 + kc * 32 + quad * 8) * 2);
#pragma unroll
        for (int nt = 0; nt < 2; ++nt) {
            f32x4 R = (f32x4){0.f, 0.f, 0.f, 0.f}, I = R;
            R = __builtin_amdgcn_mfma_f32_16x16x32_bf16(ua[0], wa[nt][0], R, 0, 0, 0); R = __builtin_amdgcn_mfma_f32_16x16x32_bf16(ua[1], wa[nt][1], R, 0, 0, 0);
            I = __builtin_amdgcn_mfma_f32_16x16x32_bf16(ua[0], wx[nt][0], I, 0, 0, 0); I = __builtin_amdgcn_mfma_f32_16x16x32_bf16(ua[1], wx[nt][1], I, 0, 0, 0);
            const int j = 32 * sub + 16 * nt + jj;
            float a[4], v[4];
#pragma unroll
            for (int r = 0; r < 4; ++r) { const int l = 16 * mt + 4 * quad + r;
                const float uval = bf2f(*(const LAS bf16_t*)(U + l * US + (hh * 64 + j) * 2));
                const float rr = sigmoid_f(R[r] + ba[nt]), ig = sigmoid_f(I[r] + bx[nt]);
                const float av = __expf(c8[nt] * rr);
                a[r] = av; v[r] = sqrtf(fmaxf(0.f, 1.f - av * av)) * (ig * uval); }
            const float A4 = (a[0] * a[1]) * (a[2] * a[3]);
            const float B4 = ((v[0] * a[1] + v[1]) * a[2] + v[2]) * a[3] + v[3];
            float hs = hin[nt], hstart = 0.f, Pm = 1.f;
#pragma unroll
            for (int q = 0; q < 4; ++q) { const float Aq = bperm_f(jj + 16 * q, A4), Bq = bperm_f(jj + 16 * q, B4); if (q == quad) hstart = hs; hs = Aq * hs + Bq; Pm *= Aq; }
            hin[nt] = hs; P[nt] *= Pm;
            if (FINAL) { float hc = hstart;
#pragma unroll
                for (int r = 0; r < 4; ++r) { hc = a[r] * hc + v[r]; *(LAS bf16_t*)(H + (16 * mt + 4 * quad + r) * US + (hh * 64 + j) * 2) = (bf16_t)f2bf(hc); } }
        }
    }
    if (!FINAL && quad == 0) {
#pragma unroll
        for (int nt = 0; nt < 2; ++nt) { float* o = (float*)(p.ws + WS_LSUM) + ((size_t)bc * 1024 + h * 64 + 32 * sub + 16 * nt + jj) * 2; o[0] = P[nt]; o[1] = hin[nt]; } }
}

__device__ __forceinline__ void ph_mixA(const Params& p, int l_, LAS unsigned char* lds) {
    const int tid = opaque_tid(), wid = __builtin_amdgcn_readfirstlane(tid >> 6), lane = tid & 63, jj = lane & 15, quad = lane >> 4;
    const bf16_t* proj = (const bf16_t*)(p.ws + WS_PROJ); float* states = (float*)(p.ws + WS_STATES);
    const float* scw = p.ssd_conv_w + (size_t)l_ * 4 * SSD_CD; const float* scb = p.ssd_conv_b + l_ * SSD_CD;
    const float* lcw = p.lru_conv_w + (size_t)l_ * 4 * 1024; const float* lcb = p.lru_conv_b + l_ * 1024;
    for (int u = blockIdx.x; u < NB * NCH * 4; u += gridDim.x) {
        const int g = u & 3, c = (u >> 2) & 63, b = u >> 8; const int t0 = c * CH, R0 = b * SEQ + t0;
        stage_conv<0, false>(proj, R0, t0, O_LX + 256 * g, 256, lcw + 256 * g, 1024, lcb + 256 * g, lds, US, nullptr, tid);
        ssd_tables<true>(p, l_, R0, g, lds, wid, lane);
        __syncthreads();
        lru_wave<false>(p, l_, b * NCH + c, g, lds, nullptr, wid, lane);
        __syncthreads();
        stage_conv<1, true>(proj, R0, t0, O_XS + 256 * g, 256, scw + 256 * g, SSD_CD, scb + 256 * g, lds, 0, (const LAS float*)(lds + L_TAB + 4096), tid);
        stage_conv<1, true>(proj, R0, t0, O_B + 128 * g, 128, scw + 1024 + 128 * g, SSD_CD, scb + 1024 + 128 * g, lds + 69632, 0, nullptr, tid);
        __syncthreads();
        { const int hh = wid >> 1, sub = wid & 1, h = 4 * g + hh;
            f32x4 acc[4][4];
#pragma unroll
            for (int mt = 0; mt < 4; ++mt)
#pragma unroll
                for (int n = 0; n < 4; ++n) acc[mt][n] = (f32x4){0.f, 0.f, 0.f, 0.f};
#pragma unroll
            for (int kc = 0; kc < 4; ++kc) { bf16x8 bfr[4];
#pragma unroll
                for (int n = 0; n < 4; ++n) bfr[n] = *(const LAS bf16x8*)(lds + 69632 + (16 * (4 * sub + n) + jj) * TS + (32 * kc + 8 * quad) * 2);
#pragma unroll
                for (int mt = 0; mt < 4; ++mt) { const bf16x8 xa = *(const LAS bf16x8*)(lds + (hh * 64 + 16 * mt + jj) * TS + (32 * kc + 8 * quad) * 2);
#pragma unroll
                    for (int n = 0; n < 4; ++n) acc[mt][n] = __builtin_amdgcn_mfma_f32_16x16x32_bf16(xa, bfr[n], acc[mt][n], 0, 0, 0); } }
            float* st = states + ((size_t)((b * NCH + c) * 16 + h)) * 8192;
#pragma unroll
            for (int mt = 0; mt < 4; ++mt)
#pragma unroll
                for (int n = 0; n < 4; ++n)
#pragma unroll
                    for (int r = 0; r < 4; ++r) st[(16 * mt + 4 * quad + r) * 128 + 16 * (4 * sub + n) + jj] = acc[mt][n][r];
        }
        __syncthreads();
    }
}

__device__ __forceinline__ void ph_scan(const Params& p) {
    const float* states = (const float*)(p.ws + WS_STATES); const float* decay = (const float*)(p.ws + WS_DECAY); bf16_t* prevb = (bf16_t*)(p.ws + WS_PREV);
    const float* lsum = (const float*)(p.ws + WS_LSUM); float* lcarry = (float*)(p.ws + WS_LCARRY);
    const int gt = blockIdx.x * NTHR + opaque_tid(), NGT = gridDim.x * NTHR;
    for (int e = gt; e < NB * 16 * 8192 / 4; e += NGT) {
        const int q = e & 2047, h = (e >> 11) & 15, b = e >> 15;
        f32x4 r = (f32x4){0.f, 0.f, 0.f, 0.f};
#pragma unroll 4
        for (int c = 0; c < NCH; ++c) { const size_t o = ((size_t)((b * NCH + c) * 16 + h)) * 8192 + q * 4; const f32x4 t = *(const f32x4*)(states + o);
            u32x2 w; w.x = pg8::cvt_pk_bf16(r.x, r.y); w.y = pg8::cvt_pk_bf16(r.z, r.w); *(u32x2*)(prevb + o) = w; r = r * decay[(b * NCH + c) * 16 + h] + t; }
    }
    for (int e = gt; e < NB * 1024; e += NGT) { const int ch = e & 1023, b = e >> 10; float r = 0.f;
        for (int c = 0; c < NCH; ++c) { const size_t i = (size_t)(b * NCH + c) * 1024 + ch; lcarry[i] = r; r = lsum[i * 2] * r + lsum[i * 2 + 1]; } }
}

__device__ __forceinline__ void ph_mixB(const Params& p, int l_, LAS unsigned char* lds) {
    const int tid = opaque_tid(), wid = __builtin_amdgcn_readfirstlane(tid >> 6), lane = tid & 63, jj = lane & 15, quad = lane >> 4;
    const bf16_t* proj = (const bf16_t*)(p.ws + WS_PROJ); bf16_t* mix = (bf16_t*)(p.ws + WS_MIX); float* rowss = (float*)(p.ws + WS_ROWSS);
    const float* scw = p.ssd_conv_w + (size_t)l_ * 4 * SSD_CD; const float* scb = p.ssd_conv_b + l_ * SSD_CD;
    const float* lcw = p.lru_conv_w + (size_t)l_ * 4 * 1024; const float* lcb = p.lru_conv_b + l_ * 1024;
    LAS unsigned char* Bm = lds; LAS unsigned char* Cm = lds + 34816; LAS unsigned char* Xt = lds + 69632;
    const LAS float* dtv = (const LAS float*)(lds + L_TAB); const LAS float* acs = (const LAS float*)(lds + L_TAB + 2048); LAS float* rpart = (LAS float*)(lds + L_RPART);
    for (int u = blockIdx.x; u < NB * NCH * 4; u += gridDim.x) {
        const int g = u & 3, c = (u >> 2) & 63, b = u >> 8; const int t0 = c * CH, R0 = b * SEQ + t0;
        stage_conv<0, true>(proj, R0, t0, O_B + 128 * g, 128, scw + 1024 + 128 * g, SSD_CD, scb + 1024 + 128 * g, Bm, TS, nullptr, tid);
        stage_conv<0, true>(proj, R0, t0, O_C + 128 * g, 128, scw + 1536 + 128 * g, SSD_CD, scb + 1536 + 128 * g, Cm, TS, nullptr, tid);
        stage_conv<1, true>(proj, R0, t0, O_XS + 256 * g, 256, scw + 256 * g, SSD_CD, scb + 256 * g, Xt, 0, nullptr, tid);
        ssd_tables<false>(p, l_, R0, g, lds, wid, lane);
        __syncthreads();
        { const int hh = wid >> 1, sub = wid & 1, h = 4 * g + hh;
            const float Dh = p.ssd_d[l_ * 16 + h];
            const bf16_t* prev = (const bf16_t*)(p.ws + WS_PREV) + ((size_t)((b * NCH + c) * 16 + h)) * 8192;
            const LAS float* dth = dtv + hh * 128; const LAS float* ach = acs + hh * 128;
            int lts[4]; lts[0] = sub ? 1 : 0; lts[1] = sub ? 2 : 3; lts[2] = sub ? 5 : 4; lts[3] = sub ? 6 : 7;
            f32x4 acc[4][4];
#pragma unroll
            for (int mt = 0; mt < 4; ++mt)
#pragma unroll
                for (int li = 0; li < 4; ++li) acc[mt][li] = (f32x4){0.f, 0.f, 0.f, 0.f};
#pragma unroll
            for (int kc = 0; kc < 4; ++kc) { bf16x8 pa[4];
#pragma unroll
                for (int mt = 0; mt < 4; ++mt) pa[mt] = *(const bf16x8*)(prev + (16 * mt + jj) * 128 + 32 * kc + 8 * quad);
#pragma unroll
                for (int li = 0; li < 4; ++li) { const bf16x8 cf = *(const LAS bf16x8*)(Cm + (16 * lts[li] + jj) * TS + (32 * kc + 8 * quad) * 2);
#pragma unroll
                    for (int mt = 0; mt < 4; ++mt) acc[mt][li] = __builtin_amdgcn_mfma_f32_16x16x32_bf16(pa[mt], cf, acc[mt][li], 0, 0, 0); } }
#pragma unroll
            for (int li = 0; li < 4; ++li) { const float e = __expf(ach[16 * lts[li] + jj]);
#pragma unroll
                for (int mt = 0; mt < 4; ++mt) acc[mt][li] = acc[mt][li] * e; }
#pragma unroll
            for (int li = 0; li < 4; ++li) { const int lt = lts[li];
                bf16x8 cfr[4];
#pragma unroll
                for (int kc = 0; kc < 4; ++kc) cfr[kc] = *(const LAS bf16x8*)(Cm + (16 * lt + jj) * TS + (32 * kc + 8 * quad) * 2);
                const float al = ach[16 * lt + jj];
#pragma unroll 1
                for (int sc = 0; sc <= (lt >> 1); ++sc) {
                    float gv[8];
#pragma unroll
                    for (int t2 = 0; t2 < 2; ++t2) { const int st = 2 * sc + t2;
                        f32x4 S = (f32x4){0.f, 0.f, 0.f, 0.f};
                        if (st <= lt) {
#pragma unroll
                            for (int kc = 0; kc < 4; ++kc) { const bf16x8 bf_ = *(const LAS bf16x8*)(Bm + (16 * st + jj) * TS + (32 * kc + 8 * quad) * 2); S = __builtin_amdgcn_mfma_f32_16x16x32_bf16(bf_, cfr[kc], S, 0, 0, 0); }
                            const f32x4 dt4 = *(const LAS f32x4*)(dth + 16 * st + 4 * quad), as4 = *(const LAS f32x4*)(ach + 16 * st + 4 * quad);
                            const bool diag = (st == lt);
#pragma unroll
                            for (int r = 0; r < 4; ++r) { float val = S[r] * __expf(al - as4[r]) * dt4[r];
                                if (diag) { const int sr = 4 * quad + r; val = (sr > jj) ? 0.f : val; val = (sr == jj) ? val + Dh : val; }
                                gv[t2 * 4 + r] = val; }
                        } else {
#pragma unroll
                            for (int r = 0; r < 4; ++r) gv[t2 * 4 + r] = 0.f; }
                    }
                    u32x4 gq; gq.x = pg8::cvt_pk_bf16(gv[0], gv[1]); gq.y = pg8::cvt_pk_bf16(gv[2], gv[3]); gq.z = pg8::cvt_pk_bf16(gv[4], gv[5]); gq.w = pg8::cvt_pk_bf16(gv[6], gv[7]);
                    const bf16x8 gb = __builtin_bit_cast(bf16x8, gq);
#pragma unroll
                    for (int mt = 0; mt < 4; ++mt) { const LAS unsigned char* xp = Xt + (hh * 64 + 16 * mt + jj) * TS + (32 * sc + 4 * quad) * 2;
                        const u32x2 x0 = *(const LAS u32x2*)xp, x1 = *(const LAS u32x2*)(xp + 32);
                        u32x4 xq; xq.x = x0.x; xq.y = x0.y; xq.z = x1.x; xq.w = x1.y;
                        acc[mt][li] = __builtin_amdgcn_mfma_f32_16x16x32_bf16(__builtin_bit_cast(bf16x8, xq), gb, acc[mt][li], 0, 0, 0); }
                }
            }
#pragma unroll
            for (int li = 0; li < 4; ++li) { const int l = 16 * lts[li] + jj; float ssq = 0.f; u32x2 zr[4];
#pragma unroll
                for (int mt = 0; mt < 4; ++mt) zr[mt] = *(const u32x2*)(proj + (size_t)(R0 + l) * PROJW + O_Z + h * 64 + 16 * mt + 4 * quad);
#pragma unroll
                for (int mt = 0; mt < 4; ++mt) { const u32x2 z = zr[mt]; const f32x4 a4 = acc[mt][li];
                    const float y0 = a4[0] * silu_f(bflo(z.x)), y1 = a4[1] * silu_f(bfhi(z.x)), y2 = a4[2] * silu_f(bflo(z.y)), y3 = a4[3] * silu_f(bfhi(z.y));
                    ssq += (y0 * y0 + y1 * y1) + (y2 * y2 + y3 * y3);
                    u32x2 o; o.x = pg8::cvt_pk_bf16(y0, y1); o.y = pg8::cvt_pk_bf16(y2, y3);
                    *(u32x2*)(mix + (size_t)(R0 + l) * 2048 + 1024 + h * 64 + 16 * mt + 4 * quad) = o; }
                ssq += bperm_f(lane ^ 16, ssq); ssq += bperm_f(lane ^ 32, ssq);
                if (quad == 0) rpart[hh * 128 + l] = ssq; }
        }
        __syncthreads();
        if (tid < 128) rowss[(size_t)(R0 + tid) * 8 + 4 + g] = (rpart[tid] + rpart[128 + tid]) + (rpart[256 + tid] + rpart[384 + tid]);
        stage_conv<0, false>(proj, R0, t0, O_LX + 256 * g, 256, lcw + 256 * g, 1024, lcb + 256 * g, lds, US, nullptr, tid);
        __syncthreads();
        lru_wave<true>(p, l_, b * NCH + c, g, lds, lds + 67584, wid, lane);
        __syncthreads();
#pragma unroll 2
        for (int k = 0; k < 8; ++k) { const int it = tid + k * NTHR, l = it >> 5, ch = it & 31;
            const u32x4 hv = *(const LAS u32x4*)(lds + 67584 + l * US + ch * 16);
            const u32x4 gt = *(const u32x4*)(proj + (size_t)(R0 + l) * PROJW + O_LG + 256 * g + ch * 8);
            float y[8];
            y[0] = fast_gelu(bflo(gt.x)) * bflo(hv.x); y[1] = fast_gelu(bfhi(gt.x)) * bfhi(hv.x); y[2] = fast_gelu(bflo(gt.y)) * bflo(hv.y); y[3] = fast_gelu(bfhi(gt.y)) * bfhi(hv.y);
            y[4] = fast_gelu(bflo(gt.z)) * bflo(hv.z); y[5] = fast_gelu(bfhi(gt.z)) * bfhi(hv.z); y[6] = fast_gelu(bflo(gt.w)) * bflo(hv.w); y[7] = fast_gelu(bfhi(gt.w)) * bfhi(hv.w);
            float sq = 0.f;
#pragma unroll
            for (int i = 0; i < 8; ++i) sq += y[i] * y[i];
            u32x4 o; o.x = pg8::cvt_pk_bf16(y[0], y[1]); o.y = pg8::cvt_pk_bf16(y[2], y[3]); o.z = pg8::cvt_pk_bf16(y[4], y[5]); o.w = pg8::cvt_pk_bf16(y[6], y[7]);
            *(u32x4*)(mix + (size_t)(R0 + l) * 2048 + 256 * g + ch * 8) = o;
            sq += SWZ_XOR(sq, 1); sq += SWZ_XOR(sq, 2); sq += SWZ_XOR(sq, 4); sq += SWZ_XOR(sq, 8); sq += SWZ_XOR(sq, 16);
            if ((lane & 31) == 0) rowss[(size_t)(R0 + l) * 8 + g] = sq; }
        __syncthreads();
    }
}

__device__ __forceinline__ void ph_router(const Params& p, int l, LAS unsigned char* lds) {
    const int tid = opaque_tid(), lane = tid & 63, wave = tid >> 6;
    LAS float* wcl = (LAS float*)lds;
    LAS float* wfl = (LAS float*)(lds + 16384);
    __syncthreads();
    for (int i = tid; i < 1024; i += NTHR) { const f32x4 w = *(const f32x4*)(p.w_coarse + ((size_t)l * DM + i) * 4); wcl[i] = w.x; wcl[1024 + i] = w.y; wcl[2048 + i] = w.z; wcl[3072 + i] = w.w; }
    for (int i = tid; i < 8192; i += NTHR) { const int gk = i >> 1, hf = i & 1, gg = gk >> 10, k = gk & 1023; const f32x4 w = *(const f32x4*)(p.w_fine + (((size_t)l * 4 + gg) * DM + k) * 8 + hf * 4);
        LAS float* d = wfl + (gg * 8 + hf * 4) * 1024 + k; d[0] = w.x; d[1024] = w.y; d[2048] = w.z; d[3072] = w.w; }
    LAS int* lcount = (LAS int*)(lds + 147456); LAS int* lbase = lcount + 32; LAS int* rec_e = lcount + 64; LAS int* rec_tok = rec_e + 128; LAS int* rec_pos = rec_tok + 128; LAS float* rec_w = (LAS float*)(rec_pos + 128);
    if (tid < 32) lcount[tid] = 0;
    if (tid < 128) rec_e[tid] = -1;
    __syncthreads();
    int lr = wave;
    const int gw = blockIdx.x * 8 + wave, NGW = gridDim.x * 8;
    bf16_t* hb = (bf16_t*)(p.ws + WS_H); int* cnt = (int*)(p.ws + WS_CTL); int* ltok = (int*)(p.ws + WS_LTOK); float* lw = (float*)(p.ws + WS_LW);
    const float* nw = p.norm_ffn + l * DM;
    for (int row = gw; row < NTOK; row += NGW) {
        asm volatile("" ::: "memory");
        f32x4 v[4]; float ss = 0.f;
#pragma unroll
        for (int j = 0; j < 4; ++j) { v[j] = *(const f32x4*)(p.X + (size_t)row * DM + j * 256 + lane * 4); ss += (v[j].x * v[j].x + v[j].y * v[j].y) + (v[j].z * v[j].z + v[j].w * v[j].w); }
        const float rstd = rsqrtf(wave_sum(ss) * (1.f / DM) + 1e-6f);
        float cl[4] = {0.f, 0.f, 0.f, 0.f};
#pragma unroll
        for (int j = 0; j < 4; ++j) { const f32x4 w = *(const f32x4*)(nw + j * 256 + lane * 4); v[j] = v[j] * rstd * w;
            u32x2 o; o.x = pk2(v[j].x, v[j].y); o.y = pk2(v[j].z, v[j].w); *(u32x2*)(hb + (size_t)row * DM + j * 256 + lane * 4) = o;
#pragma unroll
            for (int q = 0; q < 4; ++q) { const f32x4 c4 = *(const LAS f32x4*)(wcl + q * 1024 + j * 256 + lane * 4); cl[q] += (v[j].x * c4.x + v[j].y * c4.y) + (v[j].z * c4.z + v[j].w * c4.w); } }
#pragma unroll
        for (int q = 0; q < 4; ++q) cl[q] = wave_sum(cl[q]) + p.b_coarse[l * 4 + q];
        int gi = 0; float cm = cl[0];
#pragma unroll
        for (int q = 1; q < 4; ++q) if (cl[q] > cm) { cm = cl[q]; gi = q; }
        float den = 0.f;
#pragma unroll
        for (int q = 0; q < 4; ++q) den += __expf(cl[q] - cm);
        const float gwt = 1.f / den;
        float fl[8];
#pragma unroll
        for (int q = 0; q < 8; ++q) fl[q] = 0.f;
        const LAS float* wfg = wfl + gi * 8192;
#pragma unroll
        for (int q = 0; q < 8; ++q)
#pragma unroll
            for (int j = 0; j < 4; ++j) { const f32x4 w = *(const LAS f32x4*)(wfg + q * 1024 + j * 256 + lane * 4); fl[q] += (v[j].x * w.x + v[j].y * w.y) + (v[j].z * w.z + v[j].w * w.w); }
#pragma unroll
        for (int q = 0; q < 8; ++q) fl[q] = wave_sum(fl[q]) + p.b_fine[(l * 4 + gi) * 8 + q];
        int i0 = 0; float v0 = fl[0];
#pragma unroll
        for (int q = 1; q < 8; ++q) if (fl[q] > v0) { v0 = fl[q]; i0 = q; }
        int i1 = -1; float v1 = -3.0e38f;
#pragma unroll
        for (int q = 0; q < 8; ++q) if (q != i0 && fl[q] > v1) { v1 = fl[q]; i1 = q; }
        const float e1 = __expf(v1 - v0), w0 = gwt / (1.f + e1), w1 = gwt * e1 / (1.f + e1);
        if (lane == 0) {
            const int ex0 = gi * 8 + i0, ex1 = gi * 8 + i1;
            if (lr < 64) {
                const int p0 = __hip_atomic_fetch_add(lcount + ex0, 1, __ATOMIC_RELAXED, __HIP_MEMORY_SCOPE_WORKGROUP); rec_e[lr * 2] = ex0; rec_tok[lr * 2] = row * 2 + 0; rec_pos[lr * 2] = p0; rec_w[lr * 2] = w0;
                const int p1 = __hip_atomic_fetch_add(lcount + ex1, 1, __ATOMIC_RELAXED, __HIP_MEMORY_SCOPE_WORKGROUP); rec_e[lr * 2 + 1] = ex1; rec_tok[lr * 2 + 1] = row * 2 + 1; rec_pos[lr * 2 + 1] = p1; rec_w[lr * 2 + 1] = w1;
            } else {
                const int p0 = atomicAdd(cnt + ex0, 1); ltok[(size_t)ex0 * LISTCAP + p0] = row * 2 + 0; lw[(size_t)ex0 * LISTCAP + p0] = w0;
                const int p1 = atomicAdd(cnt + ex1, 1); ltok[(size_t)ex1 * LISTCAP + p1] = row * 2 + 1; lw[(size_t)ex1 * LISTCAP + p1] = w1; }
        }
        lr += 8;
    }
    __syncthreads();
    if (tid < 32) { const int n = lcount[tid]; lbase[tid] = n ? atomicAdd(cnt + tid, n) : 0; }
    __syncthreads();
    if (tid < 128) { const int e = rec_e[tid]; if (e >= 0) { const size_t dst = (size_t)e * LISTCAP + lbase[e] + rec_pos[tid]; ltok[dst] = rec_tok[tid]; lw[dst] = rec_w[tid]; } }
}

__device__ __forceinline__ int moe_tiles(const Params& p, LAS int* tb) {
    const int* cnt = (const int*)(p.ws + WS_CTL);
    __syncthreads();
    if (opaque_tid() == 0) { int s = 0; for (int e = 0; e < NEXP; ++e) { tb[e] = s; s += (cnt[e] + 255) >> 8; } tb[NEXP] = s; }
    __syncthreads();
    return tb[NEXP];
}
struct SchedMoe { LAS const int* tb; int G, c, up; const int* cnt; const int* ltok; const bf16_t* A; const bf16_t* B;
    __device__ __forceinline__ bool next(int i, pg8::Unit& u) const {
        const int L = i * G + c; if (L >= tb[NEXP] * 4) return false;
        const int t = L >> 2, pn = L & 3; int e = 0; while (tb[e + 1] <= t) ++e;
        const int pos0 = (t - tb[e]) * 256;
        u.pm = t; u.pn = pn; u.rows = ltok + (size_t)e * LISTCAP + pos0; u.nrows = cnt[e] - pos0;
        if (up) { u.a = A; u.b = B + ((size_t)e * 1024 + pn * 256) * DM; } else { u.a = A + (size_t)t * 256 * DEXP; u.b = B + ((size_t)e * 1024 + pn * 256) * DEXP; }
        return true; } };
struct EpiUp { static constexpr bool PERM = true; bf16_t* hid;
    __device__ __forceinline__ void operator()(const f32x4 (&acc)[2][2][4][2], const pg8::Unit& u, int wr, int wc, int fr, int fq) const {
        const int row0 = u.pm * 256 + wr * 64 + fr, col0 = u.pn * 128 + wc * 32 + 8 * fq;
#pragma unroll
        for (int ai = 0; ai < 2; ++ai)
#pragma unroll
            for (int m = 0; m < 4; ++m) { float o[8];
#pragma unroll
                for (int n = 0; n < 2; ++n)
#pragma unroll
                    for (int j = 0; j < 4; ++j) o[n * 4 + j] = silu_f(acc[ai][0][m][n][j]) * acc[ai][1][m][n][j];
                u32x4 w; w.x = pg8::cvt_pk_bf16(o[0], o[1]); w.y = pg8::cvt_pk_bf16(o[2], o[3]); w.z = pg8::cvt_pk_bf16(o[4], o[5]); w.w = pg8::cvt_pk_bf16(o[6], o[7]);
                *(u32x4*)(hid + (size_t)(row0 + ai * 128 + m * 16) * DEXP + col0) = w; }
    } };
__device__ __forceinline__ void ph_moe_up(const Params& p, LAS unsigned char* lds) {
    LAS int* tb = (LAS int*)(lds + LDS_TB);
    moe_tiles(p, tb);
    SchedMoe S{tb, (int)gridDim.x, (int)blockIdx.x, 1, (const int*)(p.ws + WS_CTL), (const int*)(p.ws + WS_LTOK), (const bf16_t*)(p.ws + WS_H), (const bf16_t*)(p.ws + WS_WGU)};
    pg8::gemm_phase<EpiUp, SchedMoe, true>(lds, DM, DM, DM, S, EpiUp{(bf16_t*)(p.ws + WS_HID)});
}
struct EpiDown { static constexpr bool PERM = true; bf16_t* ys; const float* lw; const int* ltok;
    __device__ __forceinline__ void operator()(const f32x4 (&acc)[2][2][4][2], const pg8::Unit& u, int wr, int wc, int fr, int fq) const {
        const int col0 = u.pn * 256 + wc * 32 + 8 * fq; const float* lwr = lw + (u.rows - ltok);
#pragma unroll
        for (int ai = 0; ai < 2; ++ai)
#pragma unroll
            for (int m = 0; m < 4; ++m) { const int r = ai * 128 + wr * 64 + m * 16 + fr;
                if (r < u.nrows) { const int tk = u.rows[r]; const float w = lwr[r]; bf16_t* o = ys + ((size_t)(tk & 1) * NTOK + (tk >> 1)) * DM + col0;
#pragma unroll
                    for (int bj = 0; bj < 2; ++bj) { const f32x4 v0 = acc[ai][bj][m][0] * w, v1 = acc[ai][bj][m][1] * w; u32x4 q;
                        q.x = pg8::cvt_pk_bf16(v0[0], v0[1]); q.y = pg8::cvt_pk_bf16(v0[2], v0[3]); q.z = pg8::cvt_pk_bf16(v1[0], v1[1]); q.w = pg8::cvt_pk_bf16(v1[2], v1[3]);
                        *(u32x4*)(o + bj * 128) = q; } } }
    } };
__device__ __forceinline__ void ph_moe_down(const Params& p, LAS unsigned char* lds) {
    LAS int* tb = (LAS int*)(lds + LDS_TB);
    moe_tiles(p, tb);
    SchedMoe S{tb, (int)gridDim.x, (int)blockIdx.x, 0, (const int*)(p.ws + WS_CTL), (const int*)(p.ws + WS_LTOK), (const bf16_t*)(p.ws + WS_HID), (const bf16_t*)(p.ws + WS_WD)};
    pg8::gemm_phase<EpiDown, SchedMoe, false>(lds, DEXP, DEXP, DEXP, S, EpiDown{(bf16_t*)(p.ws + WS_YSLOT), (const float*)(p.ws + WS_LW), (const int*)(p.ws + WS_LTOK)});
}

__device__ __forceinline__ void ph_final(const Params& p) {
    const int tid = opaque_tid(), lane = tid & 63, wave = tid >> 6;
    const int gw = blockIdx.x * 8 + wave, NGW = gridDim.x * 8;
    const bf16_t* ys = (const bf16_t*)(p.ws + WS_YSLOT);
    for (int row = gw; row < NTOK; row += NGW) {
        f32x4 v[4];
#pragma unroll
        for (int j = 0; j < 4; ++j) v[j] = *(const f32x4*)(p.X + (size_t)row * DM + j * 256 + lane * 4);
#pragma unroll
        for (int s = 0; s < 2; ++s)
#pragma unroll
            for (int j = 0; j < 4; ++j) { const u32x2 y = *(const u32x2*)(ys + ((size_t)s * NTOK + row) * DM + j * 256 + lane * 4);
                v[j].x += __uint_as_float(y.x << 16); v[j].y += __uint_as_float(y.x & 0xffff0000u); v[j].z += __uint_as_float(y.y << 16); v[j].w += __uint_as_float(y.y & 0xffff0000u); }
        float ss = 0.f;
#pragma unroll
        for (int j = 0; j < 4; ++j) ss += (v[j].x * v[j].x + v[j].y * v[j].y) + (v[j].z * v[j].z + v[j].w * v[j].w);
        const float rstd = rsqrtf(wave_sum(ss) * (1.f / DM) + 1e-6f);
#pragma unroll
        for (int j = 0; j < 4; ++j) { const f32x4 w = *(const f32x4*)(p.final_norm + j * 256 + lane * 4); *(f32x4*)(p.X + (size_t)row * DM + j * 256 + lane * 4) = v[j] * rstd * w; }
    }
}


#ifndef DBG
#define DBG 0
#endif
#ifndef DBGA
#define DBGA 12
#define DBGB 12
#endif
#if DBG
constexpr size_t WS_MIX2 = 404 * MiB;
constexpr size_t WS_DBG = 470 * MiB;
__global__ void __launch_bounds__(64) dbg_lru_seq(Params p, int l_) {
    const int b = blockIdx.x >> 4, h = blockIdx.x & 15, j = threadIdx.x, col = h * 64 + j;
    const bf16_t* proj = (const bf16_t*)(p.ws + WS_PROJ); bf16_t* mix2 = (bf16_t*)(p.ws + WS_MIX2);
    __shared__ float us[64];
    const float* cw = p.lru_conv_w + (size_t)l_ * 4 * 1024 + col; const float cb = p.lru_conv_b[l_ * 1024 + col];
    const float* wa = p.lru_wa + ((size_t)l_ * 16 + h) * 4096; const float* wx = p.lru_wx + ((size_t)l_ * 16 + h) * 4096;
    const float ba = p.lru_ba[l_ * 1024 + col], bx = p.lru_bx[l_ * 1024 + col], lam = p.lru_lambda[l_ * 1024 + col];
    const float ls = -log1pf(expf(-lam));
    float hc = 0.f;
    for (int t = 0; t < SEQ; ++t) {
        float u = cb;
        for (int k = 0; k < 4; ++k) { const int tt = t - 3 + k; if (tt >= 0) u += cw[k * 1024] * bf2f(proj[(size_t)(b * SEQ + tt) * PROJW + O_LX + col]); }
        __syncthreads(); us[j] = u; __syncthreads();
        float ra = ba, ia = bx;
        for (int i = 0; i < 64; ++i) { ra += us[i] * wa[i * 64 + j]; ia += us[i] * wx[i * 64 + j]; }
        const float r = 1.f / (1.f + expf(-ra)), ig = 1.f / (1.f + expf(-ia));
        const float log_a = 8.f * r * ls, a = expf(log_a), mult = sqrtf(fmaxf(0.f, -expm1f(2.f * log_a)));
        hc = a * hc + mult * (ig * u);
        const float gt = bf2f(proj[(size_t)(b * SEQ + t) * PROJW + O_LG + col]);
        mix2[(size_t)(b * SEQ + t) * 2048 + col] = (bf16_t)f2bf(gelu_tanh_f(gt) * hc);
    }
}
__global__ void __launch_bounds__(512) dbg_ssd_seq(Params p, int l_) {
    const int b = blockIdx.x >> 4, h = blockIdx.x & 15, g = h >> 2, tid = threadIdx.x;
    const bf16_t* proj = (const bf16_t*)(p.ws + WS_PROJ); bf16_t* mix2 = (bf16_t*)(p.ws + WS_MIX2); const float* dtraw = (const float*)(p.ws + WS_DTRAW);
    __shared__ float xs[64], Bs[128], Cs[128];
    const float* cw = p.ssd_conv_w + (size_t)l_ * 4 * SSD_CD; const float* cb = p.ssd_conv_b + l_ * SSD_CD;
    const float bias = p.ssd_dt_bias[l_ * 16 + h], A = -expf(p.ssd_a_log[l_ * 16 + h]), Dh = p.ssd_d[l_ * 16 + h];
    const int pp = tid >> 3, nb = (tid & 7) * 16;
    float st[16];
    for (int q = 0; q < 16; ++q) st[q] = 0.f;
    for (int t = 0; t < SEQ; ++t) {
        __syncthreads();
        if (tid < 320) { int cc; if (tid < 64) cc = h * 64 + tid; else if (tid < 192) cc = 1024 + g * 128 + (tid - 64); else cc = 1536 + g * 128 + (tid - 192);
            float u = cb[cc];
            for (int k = 0; k < 4; ++k) { const int tt = t - 3 + k; if (tt >= 0) u += cw[k * SSD_CD + cc] * bf2f(proj[(size_t)(b * SEQ + tt) * PROJW + O_XS + cc]); }
            u = u / (1.f + expf(-u));
            if (tid < 64) xs[tid] = u; else if (tid < 192) Bs[tid - 64] = u; else Cs[tid - 192] = u; }
        __syncthreads();
        const float dtp = dtraw[(size_t)(b * SEQ + t) * 16 + h] + bias; const float dt = dtp > 20.f ? dtp : log1pf(expf(dtp));
        const float dec = expf(dt * A), xv = xs[pp] * dt;
        float y = 0.f;
        for (int q = 0; q < 16; ++q) { st[q] = dec * st[q] + xv * Bs[nb + q]; y += Cs[nb + q] * st[q]; }
        y += __shfl_xor(y, 1); y += __shfl_xor(y, 2); y += __shfl_xor(y, 4);
        if ((tid & 7) == 0) { y += Dh * xs[pp]; const float z = bf2f(proj[(size_t)(b * SEQ + t) * PROJW + O_Z + h * 64 + pp]); y *= z / (1.f + expf(-z));
            mix2[(size_t)(b * SEQ + t) * 2048 + 1024 + h * 64 + pp] = (bf16_t)f2bf(y); }
    }
}
__global__ void dbg_cmp_mix(Params p) {
    const bf16_t* a = (const bf16_t*)(p.ws + WS_MIX); const bf16_t* b2 = (const bf16_t*)(p.ws + WS_MIX2); float* acc = (float*)(p.ws + WS_DBG);
    float s[4] = {0.f, 0.f, 0.f, 0.f};
    for (size_t i = (size_t)blockIdx.x * blockDim.x + threadIdx.x; i < (size_t)NTOK * 2048; i += (size_t)gridDim.x * blockDim.x) {
        const int col = (int)(i & 2047); const float x = bf2f(a[i]), y = bf2f(b2[i]); const int o = col < 1024 ? 0 : 2; s[o] += (x - y) * (x - y); s[o + 1] += y * y; }
    for (int q = 0; q < 4; ++q) { const float v = wave_sum(s[q]); if ((threadIdx.x & 63) == 0) atomicAdd(acc + q, v); }
}

__global__ void dbg_chk_inproj(Params p, int l) {
    const int sidx = blockIdx.x * blockDim.x + threadIdx.x; float* acc = (float*)(p.ws + WS_DBG);
    const bf16_t* proj = (const bf16_t*)(p.ws + WS_PROJ); const float* dtraw = (const float*)(p.ws + WS_DTRAW);
    unsigned hsh = (unsigned)sidx * 2654435761u + 12345u; hsh ^= hsh >> 13; hsh *= 0x5bd1e995u; hsh ^= hsh >> 15;
    const int row = hsh % NTOK, col = (hsh >> 14) % INC;
    const float* xr = (l == 0 ? p.x : p.X) + (size_t)row * DM; float ss = 0.f;
    for (int k = 0; k < DM; ++k) ss += xr[k] * xr[k];
    const float rstd = 1.f / sqrtf(ss / DM + 1e-6f);
    float d = 0.f;
    for (int k = 0; k < DM; ++k) d += (xr[k] * rstd * p.norm_mix[l * DM + k]) * p.w_in[((size_t)l * DM + k) * INC + col];
    if (col < PROJW) { const float got = bf2f(proj[(size_t)row * PROJW + col]); atomicAdd(acc + 4, (got - d) * (got - d)); atomicAdd(acc + 5, d * d); }
    else { const float got = dtraw[(size_t)row * 16 + col - PROJW]; atomicAdd(acc + 6, (got - d) * (got - d)); atomicAdd(acc + 7, d * d); }
}
__global__ void dbg_chk_outproj(Params p, int l) {
    const int sidx = blockIdx.x * blockDim.x + threadIdx.x; float* acc = (float*)(p.ws + WS_DBG);
    const bf16_t* mix = (const bf16_t*)(p.ws + WS_MIX);
    unsigned hsh = (unsigned)sidx * 2654435761u + 777u; hsh ^= hsh >> 13; hsh *= 0x5bd1e995u; hsh ^= hsh >> 15;
    const int row = hsh % NTOK, col = (hsh >> 14) % DM;
    const bf16_t* mr = mix + (size_t)row * 2048; float s1 = 0.f, s2 = 0.f;
    for (int k = 0; k < 1024; ++k) { const float a = bf2f(mr[k]), b = bf2f(mr[1024 + k]); s1 += a * a; s2 += b * b; }
    const float r1 = 1.f / sqrtf(s1 / 1024.f + 1e-6f), r2 = 1.f / sqrtf(s2 / 1024.f + 1e-6f);
    float d = 0.f;
    for (int k = 0; k < 1024; ++k) { d += bf2f(mr[k]) * r1 * p.lru_norm[l * 1024 + k] * p.w_out[((size_t)l * 2048 + k) * DM + col]; d += bf2f(mr[1024 + k]) * r2 * p.ssd_norm[l * 1024 + k] * p.w_out[((size_t)l * 2048 + 1024 + k) * DM + col]; }
    const float* xb = (l == 0) ? p.x : (const float*)(p.ws + WS_MIX2); const float ref = d, got = p.X[(size_t)row * DM + col] - xb[(size_t)row * DM + col];
    atomicAdd(acc + 8, (got - ref) * (got - ref)); atomicAdd(acc + 9, ref * ref);
}

__global__ void __launch_bounds__(256) dbg_chk_moe(Params p, int l) {
    const int tid = threadIdx.x; float* acc = (float*)(p.ws + WS_DBG); const bf16_t* ys = (const bf16_t*)(p.ws + WS_YSLOT);
    unsigned hsh = (unsigned)blockIdx.x * 2654435761u + 4242u; hsh ^= hsh >> 13; hsh *= 0x5bd1e995u; hsh ^= hsh >> 15;
    const int row = hsh % NTOK;
    __shared__ float hs[1024], hid[512], red[256], outv[4]; __shared__ int ex[2]; __shared__ float ew[2];
    float ss = 0.f; for (int k = tid; k < DM; k += 256) { const float v = p.X[(size_t)row * DM + k]; ss += v * v; }
    red[tid] = ss; __syncthreads(); if (tid == 0) { float t = 0.f; for (int i = 0; i < 256; ++i) t += red[i]; red[0] = 1.f / sqrtf(t / DM + 1e-6f); } __syncthreads();
    const float rstd = red[0];
    for (int k = tid; k < DM; k += 256) hs[k] = p.X[(size_t)row * DM + k] * rstd * p.norm_ffn[l * DM + k];
    __syncthreads();
    if (tid == 0) { float cl[4]; for (int q = 0; q < 4; ++q) { float d = p.b_coarse[l * 4 + q]; for (int k = 0; k < DM; ++k) d += hs[k] * p.w_coarse[((size_t)l * DM + k) * 4 + q]; cl[q] = d; }
        int gi = 0; for (int q = 1; q < 4; ++q) if (cl[q] > cl[gi]) gi = q; float den = 0.f; for (int q = 0; q < 4; ++q) den += expf(cl[q] - cl[gi]);
        float fl[8]; for (int q = 0; q < 8; ++q) { float d = p.b_fine[(l * 4 + gi) * 8 + q]; for (int k = 0; k < DM; ++k) d += hs[k] * p.w_fine[(((size_t)l * 4 + gi) * DM + k) * 8 + q]; fl[q] = d; }
        int i0 = 0; for (int q = 1; q < 8; ++q) if (fl[q] > fl[i0]) i0 = q; int i1 = -1; for (int q = 0; q < 8; ++q) if (q != i0 && (i1 < 0 || fl[q] > fl[i1])) i1 = q;
        const float e1 = expf(fl[i1] - fl[i0]); ex[0] = gi * 8 + i0; ex[1] = gi * 8 + i1; ew[0] = (1.f / den) / (1.f + e1); ew[1] = (1.f / den) * e1 / (1.f + e1); }
    __syncthreads();
    if (tid < 4) outv[tid] = 0.f;
    for (int s2 = 0; s2 < 2; ++s2) { const int e = ex[s2]; const float* wg = p.w_gate + ((size_t)l * NEXP + e) * DM * DEXP; const float* wu = p.w_up + ((size_t)l * NEXP + e) * DM * DEXP; const float* wd = p.w_down + ((size_t)l * NEXP + e) * DEXP * DM;
        __syncthreads();
        for (int j = tid; j < DEXP; j += 256) { float g = 0.f, u = 0.f; for (int k = 0; k < DM; ++k) { g += hs[k] * wg[(size_t)k * DEXP + j]; u += hs[k] * wu[(size_t)k * DEXP + j]; } hid[j] = g / (1.f + expf(-g)) * u; }
        __syncthreads();
        if (tid < 4) { const int col = (hsh >> 16) % 256 + tid * 256; float d = 0.f; for (int j = 0; j < DEXP; ++j) d += hid[j] * wd[(size_t)j * DM + col]; outv[tid] += ew[s2] * d; } }
    __syncthreads();
    if (tid < 4) { const int col = (hsh >> 16) % 256 + tid * 256; const float got = bf2f(ys[(size_t)row * DM + col]) + bf2f(ys[((size_t)NTOK + row) * DM + col]); const float ref = outv[tid];
        atomicAdd(acc + 10, (got - ref) * (got - ref)); atomicAdd(acc + 11, ref * ref); }
}

__global__ void dbg_chk_final(Params p) {
    const int sidx = blockIdx.x * blockDim.x + threadIdx.x; float* acc = (float*)(p.ws + WS_DBG); const bf16_t* ys = (const bf16_t*)(p.ws + WS_YSLOT);
    unsigned hsh = (unsigned)sidx * 2654435761u + 99u; hsh ^= hsh >> 13; hsh *= 0x5bd1e995u; hsh ^= hsh >> 15;
    const int row = hsh % NTOK, col = (hsh >> 14) % DM; const float* xb = (const float*)(p.ws + WS_MIX2) + (size_t)row * DM;
    float ss = 0.f; for (int k = 0; k < DM; ++k) { const float v = xb[k] + bf2f(ys[(size_t)row * DM + k]) + bf2f(ys[((size_t)NTOK + row) * DM + k]); ss += v * v; }
    const float v = xb[col] + bf2f(ys[(size_t)row * DM + col]) + bf2f(ys[((size_t)NTOK + row) * DM + col]);
    const float ref = v / sqrtf(ss / DM + 1e-6f) * p.final_norm[col], got = p.X[(size_t)row * DM + col];
    atomicAdd(acc + 12, (got - ref) * (got - ref)); atomicAdd(acc + 13, ref * ref);
}
__global__ void dbg_zero(Params p) { float* acc = (float*)(p.ws + WS_DBG); if (threadIdx.x < 64) acc[threadIdx.x] = 0.f; }
__device__ __forceinline__ int dbg_digit(float num, float den) { const float d = sqrtf(num / fmaxf(den, 1e-30f)); if (!(d == d)) return 0; const float v = -2.f * log10f(fmaxf(d, 1e-10f)); return v < 0.f ? 0 : (v > 8.f ? 8 : (int)v); }
__global__ void dbg_report(Params p) {
    const float* acc = (const float*)(p.ws + WS_DBG);
    const size_t i = (size_t)blockIdx.x * blockDim.x + threadIdx.x;
    if (i < (size_t)NTOK * DM) p.X[i] = 0.f;
    if (i == 0) { const int a = dbg_digit(acc[DBGA], acc[DBGA + 1]), b = dbg_digit(acc[DBGB], acc[DBGB + 1]); p.X[0] = sqrtf((float)NTOK * DM * (9.f + 10.f * a + b)); }
}
#endif

#define XB_TMO      128
#define XB_XCNT(j)  (256  + 64 * (j))
#define XB_XSUB(j)  (1280 + 64 * (j))
#define XB_XGEN(j)  (2304 + 64 * (j))
#define XB_TOP      3328
#define XB_TOPGEN   3392
#define XCD_BAR_WORDS 3456
#define XB_SPIN_CAP (1u << 22)
constexpr int CW_BAR = 4096;
constexpr size_t CTL_ZERO_BYTES = 65536;
__device__ __forceinline__ unsigned xb_ld(unsigned* p)              { return __hip_atomic_load(p, __ATOMIC_RELAXED, __HIP_MEMORY_SCOPE_AGENT); }
__device__ __forceinline__ unsigned xb_add(unsigned* p, unsigned v) { return __hip_atomic_fetch_add(p, v, __ATOMIC_RELAXED, __HIP_MEMORY_SCOPE_AGENT); }
__device__ __forceinline__ unsigned xb_xcc_id() { return (unsigned)__builtin_amdgcn_s_getreg((3 << 11) | 20) & 0xFu; }
#define XB_SPIN(cond, bar) do { unsigned _sp = 0; while (cond) { __builtin_amdgcn_s_sleep(1); \
    if ((++_sp & 255u) == 0u) { if (xb_ld(&(bar)[XB_TMO])) break; if (_sp > XB_SPIN_CAP) { atomicAdd(&(bar)[XB_TMO], 1u); break; } } } } while (0)
struct XcdBarrier { unsigned* bar; unsigned x; volatile LAS unsigned* st; };
__device__ __forceinline__ XcdBarrier xcd_barrier_post(unsigned* bar, volatile LAS unsigned* st) {
    XcdBarrier b; b.bar = bar; b.x = xb_xcc_id(); b.st = st;
    if (threadIdx.x == 0) (void)xb_add(&bar[XB_XCNT(b.x)], 1u);
    return b;
}
__device__ __forceinline__ void xcd_barrier_complete(unsigned* bar, unsigned x, unsigned G, unsigned& nloc, unsigned& nx) {
    unsigned sum, cnt, mine, sp = 0u;
    for (;;) {
        sum = 0u; cnt = 0u; mine = 0u;
#pragma unroll
        for (unsigned j = 0; j < 16; ++j) { const unsigned c = xb_ld(&bar[XB_XCNT(j)]); sum += c; cnt += (c > 0u) ? 1u : 0u; mine = (j == x) ? c : mine; }
        if (sum == G) break;
        __builtin_amdgcn_s_sleep(1);
        if ((++sp & 255u) == 0u) { if (xb_ld(&bar[XB_TMO])) break; if (sp > XB_SPIN_CAP) { atomicAdd(&bar[XB_TMO], 1u); break; } }
    }
    nloc = mine > 0u ? mine : 1u; nx = cnt > 0u ? cnt : 1u;
}
__device__ __forceinline__ void xcd_barrier(const XcdBarrier& b) {
    asm volatile("s_waitcnt vmcnt(0)" ::: "memory");
    __syncthreads();
    if (threadIdx.x == 0) {
        size_t zb_; asm volatile("s_mov_b64 %0, 0" : "=s"(zb_)); unsigned* bar = b.bar + zb_;
        __builtin_amdgcn_s_waitcnt(0);
        const unsigned nloc = b.st[0], nx = b.st[1];
        unsigned bx = b.x; asm volatile("" : "+s"(bx));
        const unsigned old = xb_add(&bar[XB_XSUB(bx)], 1u);
        const unsigned gen = old / nloc;
        if (old + 1u == (gen + 1u) * nloc) {
            __builtin_amdgcn_fence(__ATOMIC_RELEASE, "agent");
            asm volatile("s_waitcnt vmcnt(0)" ::: "memory");
            const unsigned og = xb_add(&bar[XB_TOP], 1u);
            const unsigned tg = og / nx;
            if (og + 1u == (tg + 1u) * nx) xb_add(&bar[XB_TOPGEN], 1u);
            else XB_SPIN(xb_ld(&bar[XB_TOPGEN]) == tg, bar);
            __builtin_amdgcn_fence(__ATOMIC_ACQUIRE, "agent");
            xb_add(&bar[XB_XGEN(bx)], 1u);
            asm volatile("s_waitcnt vmcnt(0)" ::: "memory");
        } else {
            XB_SPIN(xb_ld(&bar[XB_XGEN(bx)]) == gen, bar);
            __builtin_amdgcn_fence(__ATOMIC_ACQUIRE, "agent");
            asm volatile("s_waitcnt vmcnt(0)" ::: "memory");
        }
    }
    __syncthreads();
}
enum { PH_CONVERT = 0, PH_NORM, PH_INPROJ, PH_MIXA, PH_SCAN, PH_MIXB, PH_OUTPROJ, PH_ROUTER, PH_MOEUP, PH_MOEDOWN, PH_FINAL };

template <int PH>
__device__ __forceinline__ void run_phase(const Params& p, int l, LAS unsigned char* lds) {
    if (PH == PH_CONVERT) ph_convert(p, l, lds);
    if (PH == PH_NORM) ph_norm(p, l, lds);
    if (PH == PH_INPROJ) ph_inproj(p, lds);
    if (PH == PH_MIXA) ph_mixA(p, l, lds);
    if (PH == PH_SCAN) ph_scan(p);
    if (PH == PH_MIXB) ph_mixB(p, l, lds);
    if (PH == PH_OUTPROJ) ph_outproj(p, l, lds);
    if (PH == PH_ROUTER) ph_router(p, l, lds);
    if (PH == PH_MOEUP) ph_moe_up(p, lds);
    if (PH == PH_MOEDOWN) ph_moe_down(p, lds);
    if (PH == PH_FINAL) ph_final(p);
}

template <int PH>
__global__ void __launch_bounds__(NTHR) k_phase(Params p, int l) {
    extern __shared__ __attribute__((aligned(16))) unsigned char lds_raw[];
    run_phase<PH>(p, l, (LAS unsigned char*)lds_raw);
}

#if ONE_LAUNCH
#ifndef USE_CG
#define USE_CG 0
#endif
__global__ void __launch_bounds__(NTHR, 2) k_mega(Params p) {
    extern __shared__ __attribute__((aligned(16))) unsigned char lds_raw[];
    LAS unsigned char* lds = (LAS unsigned char*)lds_raw;
#if USE_CG
    cg::grid_group grid = cg::this_grid();
#define GRID_BAR() grid.sync()
#else
    if (threadIdx.x < 64) ((volatile LAS unsigned*)(lds + LDS_MISC))[threadIdx.x] = 0u;
    __syncthreads();
    const XcdBarrier bar = xcd_barrier_post((unsigned*)(p.ws + WS_CTL) + CW_BAR, (volatile LAS unsigned*)(lds + LDS_MISC));
    { const unsigned Gn = gridDim.x; if (threadIdx.x == 0) { unsigned nloc, nx; xcd_barrier_complete(bar.bar, bar.x, Gn, nloc, nx); bar.st[0] = nloc; bar.st[1] = nx; } }
    __syncthreads();
#define GRID_BAR() xcd_barrier(bar)
#endif
#define AS1 __attribute__((address_space(1)))
#define AS4 __attribute__((address_space(4)))
#define KF(i) ((const float*)(const AS1 float*)kp_[i])
#define FRESH() Params q; int lv; { size_t z_; int lz_; asm volatile("s_mov_b64 %0, 0\n\ts_mov_b32 %1, 0" : "=s"(z_), "=s"(lz_)); lv = l + lz_; \
        const AS4 unsigned long long* kp_ = (const AS4 unsigned long long*)((const AS4 char*)__builtin_amdgcn_kernarg_segment_ptr() + z_); \
        q.x = KF(0); q.norm_mix = KF(1); q.w_in = KF(2); q.lru_conv_w = KF(3); q.lru_conv_b = KF(4); q.lru_wa = KF(5); q.lru_ba = KF(6); q.lru_wx = KF(7); q.lru_bx = KF(8); q.lru_lambda = KF(9); \
        q.lru_norm = KF(10); q.ssd_conv_w = KF(11); q.ssd_conv_b = KF(12); q.ssd_dt_bias = KF(13); q.ssd_a_log = KF(14); q.ssd_d = KF(15); q.ssd_norm = KF(16); q.w_out = KF(17); q.norm_ffn = KF(18); \
        q.w_coarse = KF(19); q.b_coarse = KF(20); q.w_fine = KF(21); q.b_fine = KF(22); q.w_gate = KF(23); q.w_up = KF(24); q.w_down = KF(25); q.final_norm = KF(26); \
        q.X = (float*)(AS1 float*)kp_[27]; q.ws = (unsigned char*)(AS1 unsigned char*)kp_[28]; }
#if TSEL
    unsigned long long tacc = 0ull, t0 = 0ull;
#define T0(k) do { if ((k) == TSEL) t0 = __builtin_amdgcn_s_memrealtime(); } while (0)
#define T1(k) do { if ((k) == TSEL) tacc += __builtin_amdgcn_s_memrealtime() - t0; } while (0)
#else
#define T0(k) do { } while (0)
#define T1(k) do { } while (0)
#endif
#pragma unroll 1
    for (int l = 0; l < DEPTH; ++l) {
        T0(1); { FRESH(); ph_convert(q, lv, lds); } T1(1);
        T0(2); { FRESH(); ph_norm(q, lv, lds); } GRID_BAR(); T1(2);
        T0(3); { FRESH(); ph_inproj(q, lds); } GRID_BAR(); T1(3);
        T0(4); { FRESH(); ph_mixA(q, lv, lds); } GRID_BAR(); T1(4);
        T0(5); { FRESH(); ph_scan(q); } GRID_BAR(); T1(5);
        T0(6); { FRESH(); ph_mixB(q, lv, lds); } GRID_BAR(); T1(6);
        T0(7); { FRESH(); ph_outproj(q, lv, lds); } GRID_BAR(); T1(7);
        T0(8); { FRESH(); ph_router(q, lv, lds); } GRID_BAR(); T1(8);
        T0(9); { FRESH(); ph_moe_up(q, lds); } GRID_BAR(); T1(9);
        T0(10); { FRESH(); ph_moe_down(q, lds); } GRID_BAR(); T1(10);
    }
    T0(11); { const int l = 0; FRESH(); (void)lv; ph_final(q); } T1(11);
#if TSEL
    if (blockIdx.x == 0 && threadIdx.x == 0) { const unsigned long long te = __builtin_amdgcn_s_memrealtime(); while (__builtin_amdgcn_s_memrealtime() - te < 4ull * tacc) __builtin_amdgcn_s_sleep(8); }
#endif
}
#endif

template <int PH> static void launch_phase(const Params& p, int l, int grid, hipStream_t stream) {
    static bool attr = false;
    if (!attr) { (void)hipFuncSetAttribute((const void*)k_phase<PH>, hipFuncAttributeMaxDynamicSharedMemorySize, LDS_BYTES); attr = true; }
    hipLaunchKernelGGL(k_phase<PH>, dim3(grid), dim3(NTHR), LDS_BYTES, stream, p, l);
}

extern "C" void kernel_launch(void* const* d_in, const int* in_sizes, int n_in, void* d_out, int out_size, void* d_ws, size_t ws_size, hipStream_t stream) {
    if (n_in != 27 || in_sizes[0] != NTOK * DM || out_size != NTOK * DM || ws_size < WS_END) {
        fprintf(stderr, "kernel_launch: unexpected shapes (n_in %d, in0 %d, out %d, ws %zu)\n", n_in, n_in > 0 ? in_sizes[0] : -1, out_size, ws_size); return; }
    Params p{};
    const float** f = (const float**)&p;
    for (int i = 0; i < 27; ++i) f[i] = (const float*)d_in[i];
    p.X = (float*)d_out; p.ws = (unsigned char*)d_ws;
#if DBG
    { const int G = 256;
      launch_phase<PH_CONVERT>(p, 0, G, stream); launch_phase<PH_NORM>(p, 0, G, stream); launch_phase<PH_INPROJ>(p, 0, G, stream);
      launch_phase<PH_MIXA>(p, 0, G, stream); launch_phase<PH_SCAN>(p, 0, G, stream); launch_phase<PH_MIXB>(p, 0, G, stream);
      launch_phase<PH_OUTPROJ>(p, 0, G, stream);
      launch_phase<PH_ROUTER>(p, 0, G, stream); launch_phase<PH_MOEUP>(p, 0, G, stream); launch_phase<PH_MOEDOWN>(p, 0, G, stream);
      launch_phase<PH_CONVERT>(p, 1, G, stream); launch_phase<PH_NORM>(p, 1, G, stream); launch_phase<PH_INPROJ>(p, 1, G, stream);
      launch_phase<PH_MIXA>(p, 1, G, stream); launch_phase<PH_SCAN>(p, 1, G, stream); launch_phase<PH_MIXB>(p, 1, G, stream);
      launch_phase<PH_OUTPROJ>(p, 1, G, stream);
      launch_phase<PH_ROUTER>(p, 1, G, stream); launch_phase<PH_MOEUP>(p, 1, G, stream); launch_phase<PH_MOEDOWN>(p, 1, G, stream);
      (void)hipMemcpyAsync(p.ws + WS_MIX2, p.X, (size_t)NTOK * DM * 4, hipMemcpyDeviceToDevice, stream);
      launch_phase<PH_FINAL>(p, 0, G, stream);
      hipLaunchKernelGGL(dbg_zero, dim3(1), dim3(64), 0, stream, p);
      hipLaunchKernelGGL(dbg_chk_final, dim3(64), dim3(64), 0, stream, p);
      hipLaunchKernelGGL(dbg_report, dim3(NTOK * DM / 256), dim3(256), 0, stream, p);
      return; }
#endif
#if ONE_LAUNCH
    static int grid = 0;
    if (!grid) { int dev = 0, cus = 0, per_cu = 0; (void)hipGetDevice(&dev); (void)hipDeviceGetAttribute(&cus, hipDeviceAttributeMultiprocessorCount, dev);
        (void)hipFuncSetAttribute((const void*)k_mega, hipFuncAttributeMaxDynamicSharedMemorySize, LDS_BYTES);
        (void)hipOccupancyMaxActiveBlocksPerMultiprocessor(&per_cu, (const void*)k_mega, NTHR, LDS_BYTES);
        if (per_cu < 1) fprintf(stderr, "kernel_launch: occupancy query says %d blocks/CU\n", per_cu);
        (void)hipGetLastError();
        grid = cus; }
#if USE_CG
    void* args[] = {&p};
    hipError_t e = hipLaunchCooperativeKernel((const void*)k_mega, dim3(grid), dim3(NTHR), args, LDS_BYTES, stream);
    if (e != hipSuccess) fprintf(stderr, "cooperative launch failed: %s (grid %d)\n", hipGetErrorString(e), grid);
#else
    (void)hipMemsetAsync((char*)d_ws + WS_CTL, 0, CTL_ZERO_BYTES, stream);
    hipLaunchKernelGGL(k_mega, dim3(grid), dim3(NTHR), LDS_BYTES, stream, p);
#endif
#else
    const int G = 256;
    for (int l = 0; l < DEPTH; ++l) {
        launch_phase<PH_CONVERT>(p, l, G, stream);
        launch_phase<PH_NORM>(p, l, G, stream);
        launch_phase<PH_INPROJ>(p, l, G, stream);
        launch_phase<PH_MIXA>(p, l, G, stream);
        launch_phase<PH_SCAN>(p, l, G, stream);
        launch_phase<PH_MIXB>(p, l, G, stream);
        launch_phase<PH_OUTPROJ>(p, l, G, stream);
        launch_phase<PH_ROUTER>(p, l, G, stream);
        launch_phase<PH_MOEUP>(p, l, G, stream);
        launch_phase<PH_MOEDOWN>(p, l, G, stream);
    }
    launch_phase<PH_FINAL>(p, 0, G, stream);
#endif
}
```

```cpp
#include <hip/hip_runtime.h>
#include <hip/hip_cooperative_groups.h>
#include <cstdint>
#include <cstdio>
namespace cg = cooperative_groups;

#ifndef TSEL
#define TSEL 0
#endif
#ifndef ONE_LAUNCH
#define ONE_LAUNCH 1
#endif

#define LAS __attribute__((address_space(3)))
typedef unsigned short bf16_t;
typedef short bf16x8 __attribute__((ext_vector_type(8)));
typedef float f32x4 __attribute__((ext_vector_type(4)));
typedef unsigned u32x2 __attribute__((ext_vector_type(2)));
typedef unsigned u32x4 __attribute__((ext_vector_type(4)));

constexpr int NB = 2, SEQ = 8192, DM = 1024, NTOK = NB * SEQ, DEPTH = 2;
constexpr int INC = 5136, PROJW = 5120;
constexpr int SSD_CD = 2048;
constexpr int O_LX = 0, O_LG = 1024, O_Z = 2048, O_XS = 3072, O_B = 4096, O_C = 4608;
constexpr int NEXP = 32, DEXP = 512, NCH = 64, CH = 128;
constexpr int NTHR = 512;
constexpr int MAXTILES = 160;
constexpr int LISTCAP = NTOK;

constexpr size_t MiB = 1u << 20;
constexpr size_t WS_CTL = 0;
constexpr size_t WS_WIN = 1 * MiB;
constexpr size_t WS_WOUT = 11 * MiB;
constexpr size_t WS_WGU = 15 * MiB;
constexpr size_t WS_WD = 79 * MiB;
constexpr size_t WS_PROJ = 111 * MiB;
constexpr int PPAD = 8;
constexpr size_t WS_H = WS_PROJ;
constexpr size_t WS_HID = WS_PROJ + 32 * MiB;
constexpr size_t WS_YSLOT = WS_PROJ + 72 * MiB;
constexpr size_t WS_LTOK = WS_PROJ + 136 * MiB;
constexpr size_t WS_LW = WS_PROJ + 138 * MiB;
constexpr size_t WS_MIX = 272 * MiB;
constexpr size_t WS_XN = WS_MIX;
constexpr size_t WS_STATES = 336 * MiB;
constexpr size_t WS_DTRAW = 400 * MiB;
constexpr size_t WS_ROWSS = 401 * MiB;
constexpr size_t WS_LSUM = 402 * MiB;
constexpr size_t WS_LCARRY = 403 * MiB;
constexpr size_t WS_DECAY = 404 * MiB;
constexpr size_t WS_PREV = 473 * MiB;
constexpr size_t WS_WAT = 505 * MiB;
constexpr size_t WS_END = 506 * MiB;

constexpr int LDS_BYTES = 152 * 1024;
constexpr int LDS_TB = 151552 + 256;
constexpr int LDS_MISC = 151552;

struct Params {
    const float *x, *norm_mix, *w_in, *lru_conv_w, *lru_conv_b, *lru_wa, *lru_ba, *lru_wx, *lru_bx, *lru_lambda, *lru_norm,
        *ssd_conv_w, *ssd_conv_b, *ssd_dt_bias, *ssd_a_log, *ssd_d, *ssd_norm, *w_out, *norm_ffn, *w_coarse, *b_coarse, *w_fine, *b_fine,
        *w_gate, *w_up, *w_down, *final_norm;
    float* X;
    unsigned char* ws;
};

__device__ __forceinline__ float bf2f(bf16_t v) { return __uint_as_float((unsigned)v << 16); }
__device__ __forceinline__ unsigned f2bf(float f) { unsigned u = __float_as_uint(f); return (u + 0x7fffu + ((u >> 16) & 1u)) >> 16; }
__device__ __forceinline__ unsigned pk2(float lo, float hi) { return f2bf(lo) | (f2bf(hi) << 16); }
#define SWZ_XOR(v, m) __builtin_bit_cast(float, __builtin_amdgcn_ds_swizzle(__builtin_bit_cast(int, (v)), ((m) << 10) | 0x1f))
__device__ __forceinline__ float wave_sum(float v) {
    v += SWZ_XOR(v, 1); v += SWZ_XOR(v, 2); v += SWZ_XOR(v, 4); v += SWZ_XOR(v, 8); v += SWZ_XOR(v, 16);
    return __builtin_bit_cast(float, __builtin_amdgcn_readlane(__builtin_bit_cast(int, v), 0)) + __builtin_bit_cast(float, __builtin_amdgcn_readlane(__builtin_bit_cast(int, v), 32));
}
template <int S, int N>
__device__ __forceinline__ void rs_step(const float (&cur)[N], float (&nxt)[N / 2], int lane) {
    const bool bit = (lane >> S) & 1;
#pragma unroll
    for (int i = 0; i < N / 2; ++i) { const float keep = bit ? cur[2 * i + 1] : cur[2 * i], send = bit ? cur[2 * i] : cur[2 * i + 1];
        float got; if constexpr (S < 5) got = SWZ_XOR(send, (1 << S)); else got = __builtin_bit_cast(float, __builtin_amdgcn_ds_bpermute((lane ^ 32) << 2, __builtin_bit_cast(int, send)));
        nxt[i] = keep + got; }
}
__device__ __forceinline__ float sigmoid_f(float x) { return __builtin_amdgcn_rcpf(1.f + __builtin_amdgcn_exp2f(x * -1.4426950408889634f)); }
__device__ __forceinline__ float silu_f(float x) { return x * sigmoid_f(x); }
__device__ __forceinline__ float softplus_f(float x) { return x > 20.f ? x : log1pf(__expf(x)); }
__device__ __forceinline__ float gelu_tanh_f(float x) { const float u = 0.7978845608028654f * (x + 0.044715f * x * x * x); return 0.5f * x * (1.f + tanhf(u)); }

__device__ __forceinline__ int opaque_tid() { int t = threadIdx.x; asm volatile("" : "+v"(t)); return t; }
#if TSEL >= 100
#define TS0(k) do { if ((k) == TSEL && threadIdx.x == 0) *(volatile LAS unsigned long long*)(lds + LDS_MISC + 72) = __builtin_amdgcn_s_memrealtime(); } while (0)
#define TS1(k) do { if ((k) == TSEL && threadIdx.x == 0) { volatile LAS unsigned long long* a_ = (volatile LAS unsigned long long*)(lds + LDS_MISC + 64); a_[0] = a_[0] + (__builtin_amdgcn_s_memrealtime() - a_[1]); } } while (0)
#else
#define TS0(k) do { } while (0)
#define TS1(k) do { } while (0)
#endif
#define LDS_WAIT() asm volatile("s_waitcnt lgkmcnt(0)" ::: "memory")
#define VM_WAIT() asm volatile("s_waitcnt vmcnt(0)" ::: "memory")

__device__ __forceinline__ void tr_item(const float* src, int ld, int k0, int c0, bf16_t* dst, int ldd, int r0, const float* kscale, LAS float* scr, int lane) {
#pragma unroll 8
    for (int i = 0; i < 32; ++i) {
        const int kk = 2 * i + (lane >> 5), nn = lane & 31;
        float v = src[(size_t)(k0 + kk) * ld + c0 + nn];
        if (kscale) v *= kscale[k0 + kk];
        scr[kk * 33 + nn] = v;
    }
    LDS_WAIT();
    const int c = lane & 7;
#pragma unroll
    for (int j = 0; j < 4; ++j) {
        const int n = (lane >> 3) + 8 * j; const LAS float* s = scr + (8 * c) * 33 + n;
        u32x4 o; o.x = pk2(s[0 * 33], s[1 * 33]); o.y = pk2(s[2 * 33], s[3 * 33]); o.z = pk2(s[4 * 33], s[5 * 33]); o.w = pk2(s[6 * 33], s[7 * 33]);
        *(u32x4*)(dst + (size_t)(r0 + n) * ldd + k0 + 8 * c) = o;
    }
    LDS_WAIT();
}

__device__ __forceinline__ void ph_convert(const Params& p, int l, LAS unsigned char* lds) {
    const int tid = opaque_tid(), lane = tid & 63, wave = tid >> 6;
    LAS float* scr = (LAS float*)(lds + wave * 16384);
    const int gw = blockIdx.x * 8 + wave, NGW = gridDim.x * 8;
    bf16_t* WinT = (bf16_t*)(p.ws + WS_WIN); bf16_t* WoutT = (bf16_t*)(p.ws + WS_WOUT); bf16_t* WguT = (bf16_t*)(p.ws + WS_WGU); bf16_t* WdT = (bf16_t*)(p.ws + WS_WD);
    constexpr int I_IN = 16 * 160, I_OUT = 32 * 32, I_GU = 32 * 512, I_D = 32 * 256, I_W = 64;
    for (int it = gw; it < I_W + I_IN + I_OUT + I_GU + I_D; it += NGW) {
        int r = it;
        if (r < I_W) { const int m = r >> 1, nb = r & 1, head = m >> 1, which = m & 1;
            tr_item((which ? p.lru_wx : p.lru_wa) + ((size_t)l * 16 + head) * 4096, 64, 0, nb * 32, (bf16_t*)(p.ws + WS_WAT) + (head * 2 + which) * 4096, 64, nb * 32, nullptr, scr, lane); continue; }
        r -= I_W;
        if (r < I_IN) { const int kb = r / 160, nb = r % 160; tr_item(p.w_in + (size_t)l * DM * INC, INC, kb * 64, nb * 32, WinT, DM, nb * 32, nullptr, scr, lane); continue; }
        r -= I_IN;
        if (r < I_OUT) { const int kb = r / 32, nb = r % 32; const int k0 = kb * 64;
            const float* ks = (k0 < 1024) ? (p.lru_norm + l * 1024) : (p.ssd_norm + l * 1024 - 1024);
            tr_item(p.w_out + (size_t)l * 2048 * DM, DM, k0, nb * 32, WoutT, 2048, nb * 32, ks, scr, lane); continue; }
        r -= I_OUT;
        if (r < I_GU) { const int e = r / 512, q = r % 512, kb = q / 32, rb = q % 32, pn = rb >> 3, jb = rb & 7;
            const float* src = (jb < 4 ? p.w_gate : p.w_up) + ((size_t)l * NEXP + e) * DM * DEXP;
            const int c0 = 128 * pn + 32 * (jb & 3);
            tr_item(src, DEXP, kb * 64, c0, WguT + (size_t)e * 1024 * 1024, DM, rb * 32, nullptr, scr, lane); continue; }
        r -= I_GU;
        { const int e = r / 256, q = r % 256, kb = q / 32, nb = q % 32;
            tr_item(p.w_down + ((size_t)l * NEXP + e) * DEXP * DM, DM, kb * 64, nb * 32, WdT + (size_t)e * 1024 * 512, DEXP, nb * 32, nullptr, scr, lane); }
    }
}

__device__ __forceinline__ void ph_norm(const Params& p, int l, LAS unsigned char* lds) {
    const int tid = opaque_tid(), lane = tid & 63, wave = tid >> 6;
    LAS float* wl = (LAS float*)lds;
    __syncthreads();
    TS0(110);
    for (int i = tid; i < 4096; i += NTHR) { const int k = i >> 2, q4 = i & 3; const f32x4 w = *(const f32x4*)(p.w_in + ((size_t)l * DM + k) * INC + PROJW + q4 * 4);
        wl[(q4 * 4 + 0) * 1024 + k] = w.x; wl[(q4 * 4 + 1) * 1024 + k] = w.y; wl[(q4 * 4 + 2) * 1024 + k] = w.z; wl[(q4 * 4 + 3) * 1024 + k] = w.w; }
    __syncthreads();
    TS1(110); TS0(111);
    const int gw = blockIdx.x * 8 + wave, NGW = gridDim.x * 8;
    bf16_t* xn = (bf16_t*)(p.ws + WS_XN); float* dtraw = (float*)(p.ws + WS_DTRAW);
    const bf16_t* ys = (const bf16_t*)(p.ws + WS_YSLOT);
    const float* nw = p.norm_mix + l * DM;
    if (blockIdx.x == 0 && tid < 64) ((int*)(p.ws + WS_CTL))[tid] = 0;
    constexpr int RB = 4;
    for (int base = gw * RB; base < NTOK; base += NGW * RB) {
        asm volatile("" ::: "memory");
        f32x4 v[RB][4];
#pragma unroll
        for (int r = 0; r < RB; ++r) { const float* src = (l == 0 ? p.x : p.X) + (size_t)(base + r) * DM;
#pragma unroll
            for (int j = 0; j < 4; ++j) v[r][j] = *(const f32x4*)(src + j * 256 + lane * 4); }
        if (l > 0) {
#pragma unroll
            for (int r = 0; r < RB; ++r) {
#pragma unroll
                for (int s = 0; s < 2; ++s)
#pragma unroll
                    for (int j = 0; j < 4; ++j) { const u32x2 y = *(const u32x2*)(ys + ((size_t)s * NTOK + base + r) * DM + j * 256 + lane * 4);
                        v[r][j].x += __uint_as_float(y.x << 16); v[r][j].y += __uint_as_float(y.x & 0xffff0000u); v[r][j].z += __uint_as_float(y.y << 16); v[r][j].w += __uint_as_float(y.y & 0xffff0000u); }
#pragma unroll
                for (int j = 0; j < 4; ++j) *(f32x4*)(p.X + (size_t)(base + r) * DM + j * 256 + lane * 4) = v[r][j]; }
        }
        f32x4 nwv[4];
#pragma unroll
        for (int j = 0; j < 4; ++j) nwv[j] = *(const f32x4*)(nw + j * 256 + lane * 4);
#pragma unroll
        for (int r = 0; r < RB; ++r) { float ss = 0.f;
#pragma unroll
            for (int j = 0; j < 4; ++j) ss += (v[r][j].x * v[r][j].x + v[r][j].y * v[r][j].y) + (v[r][j].z * v[r][j].z + v[r][j].w * v[r][j].w);
            const float rstd = rsqrtf(wave_sum(ss) * (1.f / DM) + 1e-6f);
#pragma unroll
            for (int j = 0; j < 4; ++j) { v[r][j] = v[r][j] * rstd * nwv[j];
                u32x2 o; o.x = pk2(v[r][j].x, v[r][j].y); o.y = pk2(v[r][j].z, v[r][j].w); *(u32x2*)(xn + (size_t)(base + r) * DM + j * 256 + lane * 4) = o; } }
        float val[64];
#pragma unroll
        for (int h = 0; h < 16; ++h) { float a[RB];
#pragma unroll
            for (int r = 0; r < RB; ++r) a[r] = 0.f;
#pragma unroll
            for (int j = 0; j < 4; ++j) { const f32x4 w = *(const LAS f32x4*)(wl + h * 1024 + j * 256 + lane * 4);
#pragma unroll
                for (int r = 0; r < RB; ++r) a[r] += (v[r][j].x * w.x + v[r][j].y * w.y) + (v[r][j].z * w.z + v[r][j].w * w.w); }
#pragma unroll
            for (int r = 0; r < RB; ++r) val[r * 16 + h] = a[r]; }
        float v32[32], v16[16], v8[8], v4[4], v2[2], v1[1];
        rs_step<0>(val, v32, lane); rs_step<1>(v32, v16, lane); rs_step<2>(v16, v8, lane); rs_step<3>(v8, v4, lane); rs_step<4>(v4, v2, lane); rs_step<5>(v2, v1, lane);
        dtraw[(size_t)(base + (lane >> 4)) * 16 + (lane & 15)] = v1[0];
    }
    TS1(111);
}

namespace pg8 {
constexpr int BM = 256, BK = 64, HALF = 128, HTB = HALF * BK * 2, STAGE_BYTES = 8 * HTB, NXCD = 8, WGM = 8;
__host__ __device__ __forceinline__ int lds_byte(int r, int c) { const int st = (r >> 4) * 2 + (c >> 5), rr = r & 15, cc = c & 31, ob = rr * 64 + cc * 2; return st * 1024 + (ob ^ (((ob >> 9) & 1) << 5)); }
__host__ __device__ __forceinline__ void stage_rc(int b, int& R, int& C) { const int st = b / 1024, sb = b % 1024, swz = sb ^ (((sb >> 9) & 1) << 5); R = (st >> 1) * 16 + swz / 64; C = (st & 1) * 32 + (swz % 64) / 2; }
__host__ __device__ __forceinline__ int perm32(int rho) { const int n = rho >> 4, i = rho & 15; return 8 * (i >> 2) + 4 * n + (i & 3); }
struct Unit { int pm, pn; const bf16_t* a; const bf16_t* b; const int* rows; int nrows; };
__device__ __forceinline__ unsigned cvt_pk_bf16(float lo, float hi) { unsigned r; asm volatile("v_cvt_pk_bf16_f32 %0, %1, %2" : "=v"(r) : "v"(lo), "v"(hi)); return r; }

struct GridOrder {
    int nM, nN, nwg, G, c;
    __device__ void init(int nM_, int nN_, int G_, int c_) { nM = nM_; nN = nN_; nwg = nM * nN; G = G_; c = c_; }
    __device__ bool tile(int i, int& pm, int& pn) const {
        const long L = (long)i * G + c; if (L >= nwg) return false;
        int wgid = (int)L; { const int q = nwg / NXCD, r = nwg % NXCD, xcd = wgid % NXCD, off = wgid / NXCD; wgid = (xcd < r ? xcd * (q + 1) : r * (q + 1) + (xcd - r) * q) + off; }
        const int nig = WGM * nN, gid = wgid / nig, fm = gid * WGM, gsz = (nM - fm) < WGM ? (nM - fm) : WGM;
        pm = fm + ((wgid % nig) % gsz); pn = (wgid % nig) / gsz; return true;
    }
};

template <class Epi, class Sched, bool GATHER, bool MID = false>
__device__ __forceinline__ void gemm_phase(LAS unsigned char* lds, const int K, const int lda, const int ldb, const Sched& S, const Epi& E) {
    const int tid = opaque_tid(), wid = __builtin_amdgcn_readfirstlane(tid >> 6), lane = tid & 63, wr = wid >> 2, wc = wid & 3, fr = lane & 15, fq = lane >> 4;
    const int nt = K / BK;
    unsigned voffA[2], voffB[2];
#pragma unroll
    for (int i = 0; i < 2; ++i) { int R, C; stage_rc(tid * 16 + i * 8192, R, C); const int Rb = Epi::PERM ? ((R & ~31) + perm32(R & 31)) : R;
        voffA[i] = (unsigned)(R * lda + C) * 2u; voffB[i] = (unsigned)(Rb * ldb + C) * 2u; }
    const size_t hstepA = (size_t)HALF * lda * 2, hstepB = (size_t)HALF * ldb * 2;
    const size_t kstep = (size_t)(BK * 2);
    const unsigned ldsw = (unsigned)wid * 1024u;
    const int aoff = lds_byte(wr * 64 + fr, fq * 8), boff = lds_byte(wc * 32 + fr, fq * 8);
#define PG8_SA(b, h) (((b) * 2 + (h)) * HTB)
#define PG8_SB(b, h) ((4 + (b) * 2 + (h)) * HTB)
#define PG8_GLDS(bufoff, gp, i_) __builtin_amdgcn_global_load_lds((const unsigned*)(gp), (LAS unsigned*)(lds + (bufoff) + ldsw + (i_) * 8192), 16, 0, 0)
#define PG8_STAGE_B(bufoff, gbase, h) do { PG8_GLDS(bufoff, (const char*)(gbase) + (h) * hstepB + voffB[0], 0); PG8_GLDS(bufoff, (const char*)(gbase) + (h) * hstepB + voffB[1], 1); } while (0)
#define PG8_STAGE_A(bufoff, gbase, h, nx) do { if (GATHER) { PG8_GLDS(bufoff, (const char*)(gbase) + ((nx) ? nvo[h][0] : vo[h][0]), 0); PG8_GLDS(bufoff, (const char*)(gbase) + ((nx) ? nvo[h][1] : vo[h][1]), 1); } \
        else { PG8_GLDS(bufoff, (const char*)(gbase) + (h) * hstepA + voffA[0], 0); PG8_GLDS(bufoff, (const char*)(gbase) + (h) * hstepA + voffA[1], 1); } } while (0)
#define PG8_LDA(dst, b, h) do { _Pragma("unroll") for (int m = 0; m < 4; ++m) _Pragma("unroll") for (int k = 0; k < 2; ++k) dst[m][k] = *(const LAS bf16x8*)(lds + PG8_SA(b, h) + aoff + m * 2048 + k * 1024); } while (0)
#define PG8_LDB(dst, b, h) do { _Pragma("unroll") for (int n = 0; n < 2; ++n) _Pragma("unroll") for (int k = 0; k < 2; ++k) dst[n][k] = *(const LAS bf16x8*)(lds + PG8_SB(b, h) + boff + n * 2048 + k * 1024); } while (0)
#define PG8_MMA(ai, bj, At, Bt) do { __builtin_amdgcn_s_setprio(1); _Pragma("unroll") for (int m = 0; m < 4; ++m) _Pragma("unroll") for (int n = 0; n < 2; ++n) _Pragma("unroll") for (int k = 0; k < 2; ++k) \
        acc[ai][bj][m][n] = __builtin_amdgcn_mfma_f32_16x16x32_bf16(Bt[n][k], At[m][k], acc[ai][bj][m][n], 0, 0, 0); __builtin_amdgcn_s_setprio(0); } while (0)
#define PG8_WAIT_V(n) asm volatile("s_waitcnt vmcnt(" #n ")" ::: "memory")
#define PG8_WAIT_L(n) asm volatile("s_waitcnt lgkmcnt(" #n ")" ::: "memory")
#define PG8_BAR __builtin_amdgcn_s_barrier()
#define PG8_SCHED __builtin_amdgcn_sched_barrier(0)
#define PG8_GVO(dst, u) do { if (GATHER) { _Pragma("unroll") for (int h = 0; h < 2; ++h) _Pragma("unroll") for (int i = 0; i < 2; ++i) { int R, C; stage_rc(tid * 16 + i * 8192, R, C); \
        const int rr = h * HALF + R; const int tok = (rr < (u).nrows) ? ((u).rows[rr] >> 1) : 0; dst[h][i] = (unsigned)(tok * lda + C) * 2u; } } } while (0)
    Unit cur, nxt; int ui = 0;
    if (!S.next(0, cur)) return;
    f32x4 acc[2][2][4][2];
#pragma unroll
    for (int a = 0; a < 2; ++a)
#pragma unroll
        for (int b = 0; b < 2; ++b)
#pragma unroll
            for (int m = 0; m < 4; ++m)
#pragma unroll
                for (int n = 0; n < 2; ++n) acc[a][b][m][n] = (f32x4){0.f, 0.f, 0.f, 0.f};
    bf16x8 At[4][2], B0[2][2], B1[2][2];
    unsigned vo[2][2] = {{0u, 0u}, {0u, 0u}}, nvo[2][2] = {{0u, 0u}, {0u, 0u}};
    PG8_GVO(vo, cur);
    if (GATHER) {
#pragma unroll
        for (int h = 0; h < 2; ++h) { nvo[h][0] = vo[h][0]; nvo[h][1] = vo[h][1]; } }
    const char* cA = (const char*)cur.a; const char* cB = (const char*)cur.b;
    PG8_STAGE_B(PG8_SB(0, 0), cB, 0); PG8_STAGE_B(PG8_SB(0, 1), cB, 1); PG8_STAGE_A(PG8_SA(0, 0), cA, 0, false); PG8_STAGE_A(PG8_SA(0, 1), cA, 1, false);
    if (wr == 1) PG8_BAR;
    PG8_WAIT_V(2); PG8_BAR;
    PG8_STAGE_B(PG8_SB(1, 0), cB + kstep, 0); PG8_STAGE_A(PG8_SA(1, 0), cA + kstep, 0, false); PG8_STAGE_B(PG8_SB(1, 1), cB + kstep, 1);
    PG8_WAIT_V(6); PG8_BAR;
    for (;;) {
        const bool has_next = S.next(ui + 1, nxt);
        const char* nA = has_next ? (const char*)nxt.a : cA; const char* nB = has_next ? (const char*)nxt.b : cB;
        if (GATHER && has_next) PG8_GVO(nvo, nxt);
        for (int t = 0; t < nt; t += 2) {
            const bool last = (t == nt - 2);
            const char* a1 = cA + (size_t)(t + 1) * kstep;
            const char* a2 = last ? nA : cA + (size_t)(t + 2) * kstep; const char* b2 = last ? nB : cB + (size_t)(t + 2) * kstep;
            const char* a3 = a2 + kstep; const char* b3 = b2 + kstep;
            const bool nx = GATHER && last;
            if constexpr (MID) { if (t == (nt >> 1)) E.mid(acc, cur, wr, wc, fr, fq); }
            PG8_LDB(B0, 0, 0); PG8_LDB(B1, 0, 1); PG8_SCHED; PG8_LDA(At, 0, 0); PG8_STAGE_A(PG8_SA(1, 1), a1, 1, false);
            PG8_WAIT_V(8); PG8_WAIT_L(0); PG8_BAR; PG8_MMA(0, 0, At, B0); PG8_MMA(0, 1, At, B1); PG8_BAR; PG8_SCHED;
            PG8_LDA(At, 0, 1); PG8_STAGE_B(PG8_SB(0, 0), b2, 0); PG8_STAGE_B(PG8_SB(0, 1), b2, 1); PG8_STAGE_A(PG8_SA(0, 0), a2, 0, nx);
            PG8_WAIT_V(8); PG8_WAIT_L(0); PG8_BAR; PG8_MMA(1, 0, At, B0); PG8_MMA(1, 1, At, B1); PG8_BAR; PG8_SCHED;
            PG8_LDB(B0, 1, 0); PG8_LDB(B1, 1, 1); PG8_SCHED; PG8_LDA(At, 1, 0); PG8_STAGE_A(PG8_SA(0, 1), a2, 1, nx);
            PG8_WAIT_V(8); PG8_WAIT_L(0); PG8_BAR; PG8_MMA(0, 0, At, B0); PG8_MMA(0, 1, At, B1); PG8_BAR; PG8_SCHED;
            PG8_LDA(At, 1, 1); PG8_STAGE_B(PG8_SB(1, 0), b3, 0); PG8_STAGE_B(PG8_SB(1, 1), b3, 1); PG8_STAGE_A(PG8_SA(1, 0), a3, 0, nx);
            PG8_WAIT_V(8); PG8_WAIT_L(0); PG8_BAR; PG8_MMA(1, 0, At, B0); PG8_MMA(1, 1, At, B1); PG8_BAR; PG8_SCHED;
        }
        if (wr == 0) PG8_BAR;
        E(acc, cur, wr, wc, fr, fq);
        if (!has_next) break;
#pragma unroll
        for (int a = 0; a < 2; ++a)
#pragma unroll
            for (int b = 0; b < 2; ++b)
#pragma unroll
                for (int m = 0; m < 4; ++m)
#pragma unroll
                    for (int n = 0; n < 2; ++n) acc[a][b][m][n] = (f32x4){0.f, 0.f, 0.f, 0.f};
        cur = nxt; cA = nA; cB = nB; ++ui;
        if (GATHER) {
#pragma unroll
            for (int h = 0; h < 2; ++h) { vo[h][0] = nvo[h][0]; vo[h][1] = nvo[h][1]; } }
        if (wr == 1) PG8_BAR;
    }
    PG8_WAIT_V(0);
    PG8_BAR;
#undef PG8_SA
#undef PG8_SB
#undef PG8_GLDS
#undef PG8_STAGE_A
#undef PG8_STAGE_B
#undef PG8_LDA
#undef PG8_LDB
#undef PG8_MMA
#undef PG8_WAIT_V
#undef PG8_WAIT_L
#undef PG8_BAR
#undef PG8_SCHED
#undef PG8_GVO
}
}

struct SchedIn { pg8::GridOrder o; const bf16_t* A; const bf16_t* B;
    __device__ __forceinline__ bool next(int i, pg8::Unit& u) const { int pm, pn; if (!o.tile(i, pm, pn)) return false; u.pm = pm; u.pn = pn; u.a = A + (size_t)pm * 256 * DM; u.b = B + (size_t)pn * 256 * DM; u.rows = nullptr; u.nrows = 0; return true; } };
struct EpiProj { static constexpr bool PERM = true; bf16_t* O;
    __device__ __forceinline__ void operator()(const f32x4 (&acc)[2][2][4][2], const pg8::Unit& u, int wr, int wc, int fr, int fq) const {
        const int row0 = u.pm * 256 + wr * 64 + fr + PPAD * ((u.pm >> 5) + 1), col0 = u.pn * 256 + wc * 32 + 8 * fq;
#pragma unroll
        for (int ai = 0; ai < 2; ++ai)
#pragma unroll
            for (int m = 0; m < 4; ++m) { bf16_t* rowp = O + (size_t)(row0 + ai * 128 + m * 16) * PROJW + col0;
#pragma unroll
                for (int bj = 0; bj < 2; ++bj) { const f32x4 v0 = acc[ai][bj][m][0], v1 = acc[ai][bj][m][1]; u32x4 w;
                    w.x = pg8::cvt_pk_bf16(v0[0], v0[1]); w.y = pg8::cvt_pk_bf16(v0[2], v0[3]); w.z = pg8::cvt_pk_bf16(v1[0], v1[1]); w.w = pg8::cvt_pk_bf16(v1[2], v1[3]);
                    *(u32x4*)(rowp + bj * 128) = w; } }
    } };
__device__ __forceinline__ void ph_inproj(const Params& p, LAS unsigned char* lds) {
    if (blockIdx.x < NB * PPAD) { const int b = blockIdx.x / PPAD, r = blockIdx.x % PPAD; unsigned* z = (unsigned*)((bf16_t*)(p.ws + WS_PROJ) + ((size_t)b * (SEQ + PPAD) + r) * PROJW);
        for (int i = opaque_tid(); i < PROJW / 2; i += NTHR) z[i] = 0u; }
    SchedIn S; S.o.init(64, 20, gridDim.x, blockIdx.x); S.A = (const bf16_t*)(p.ws + WS_XN); S.B = (const bf16_t*)(p.ws + WS_WIN);
    pg8::gemm_phase<EpiProj, SchedIn, false>(lds, DM, DM, DM, S, EpiProj{(bf16_t*)(p.ws + WS_PROJ)});
}

__device__ __forceinline__ void row_rstd(const float* rowss, int row, float& rl, float& rs) {
    const f32x4 a = *(const f32x4*)(rowss + (size_t)row * 8), b = *(const f32x4*)(rowss + (size_t)row * 8 + 4);
    rl = rsqrtf(((a.x + a.y) + (a.z + a.w)) * (1.f / 1024.f) + 1e-6f); rs = rsqrtf(((b.x + b.y) + (b.z + b.w)) * (1.f / 1024.f) + 1e-6f);
}
constexpr int LDS_RR = 131072;
struct SchedOne { int pm, pn; const bf16_t* A; const bf16_t* B;
    __device__ __forceinline__ bool next(int i, pg8::Unit& u) const { if (i != 0) return false; u.pm = pm; u.pn = pn; u.a = A + (size_t)pm * 256 * 2048; u.b = B + (size_t)pn * 256 * 2048; u.rows = nullptr; u.nrows = 0; return true; } };
struct EpiOut { static constexpr bool PERM = false; const float* resid; float* out; const LAS float* rr;
    __device__ __forceinline__ void mid(f32x4 (&acc)[2][2][4][2], const pg8::Unit& u, int wr, int wc, int fr, int fq) const {
#pragma unroll
        for (int ai = 0; ai < 2; ++ai)
#pragma unroll
            for (int m = 0; m < 4; ++m) { const float f = rr[(ai * 128 + wr * 64 + m * 16 + fr) * 2];
#pragma unroll
                for (int bj = 0; bj < 2; ++bj)
#pragma unroll
                    for (int n = 0; n < 2; ++n) acc[ai][bj][m][n] = acc[ai][bj][m][n] * f; }
    }
    __device__ __forceinline__ void operator()(const f32x4 (&acc)[2][2][4][2], const pg8::Unit& u, int wr, int wc, int fr, int fq) const {
        const int row0 = u.pm * 256 + wr * 64 + fr, col0 = u.pn * 256 + wc * 32 + 4 * fq;
#pragma unroll
        for (int ai = 0; ai < 2; ++ai)
#pragma unroll
            for (int m = 0; m < 4; ++m) { const int row = row0 + ai * 128 + m * 16; const float rs = rr[(ai * 128 + wr * 64 + m * 16 + fr) * 2 + 1]; const size_t off = (size_t)row * DM + col0;
#pragma unroll
                for (int bj = 0; bj < 2; ++bj)
#pragma unroll
                    for (int n = 0; n < 2; ++n) { const f32x4 bs = *(const f32x4*)(resid + off + bj * 128 + n * 16); *(f32x4*)(out + off + bj * 128 + n * 16) = bs + acc[ai][bj][m][n] * rs; } }
    } };
__device__ __forceinline__ void ph_outproj(const Params& p, int l, LAS unsigned char* lds) {
    const float* rowss = (const float*)(p.ws + WS_ROWSS); const int tid = opaque_tid();
    pg8::GridOrder o; o.init(64, 4, gridDim.x, blockIdx.x);
    LAS float* rr = (LAS float*)(lds + LDS_RR);
    for (int i = 0;; ++i) { int pm, pn; if (!o.tile(i, pm, pn)) break;
        __syncthreads();
        if (tid < 256) { float rl, rs; row_rstd(rowss, pm * 256 + tid, rl, rs); rr[tid * 2] = rl / rs; rr[tid * 2 + 1] = rs; }
        __syncthreads();
        SchedOne S{pm, pn, (const bf16_t*)(p.ws + WS_MIX), (const bf16_t*)(p.ws + WS_WOUT)};
        pg8::gemm_phase<EpiOut, SchedOne, false, true>(lds, 2048, 2048, 2048, S, EpiOut{(l == 0) ? p.x : p.X, p.X, rr}); }
}

constexpr int TS = 272;
constexpr int US = 528;
constexpr int L_TAB = 139264;
constexpr int L_RPART = L_TAB + 6144;
__device__ __forceinline__ float bperm_f(int srclane, float v) { return __builtin_bit_cast(float, __builtin_amdgcn_ds_bpermute(srclane << 2, __builtin_bit_cast(int, v))); }
__device__ __forceinline__ float fast_gelu(float x) { return x * sigmoid_f(1.5957691216057308f * (x + 0.044715f * x * x * x)); }
__device__ __forceinline__ float bflo(unsigned v) { return __uint_as_float(v << 16); }
__device__ __forceinline__ float bfhi(unsigned v) { return __uint_as_float(v & 0xffff0000u); }

template <int MODE, bool ACT, int NC>
__device__ __forceinline__ void stage_conv(const bf16_t* proj, int RP0, int pcol0, const float* cw, int cwld, const float* cb, LAS unsigned char* dst, int RS, const LAS float* wt, int tid) {
    constexpr int npair = NC >> 1, NIT = npair * 16 / NTHR, OSTEP = NTHR / npair;
    asm volatile("" : "+v"(tid));
    typedef float f32x2 __attribute__((ext_vector_type(2)));
    const int pr = tid & (npair - 1), oct0 = tid / npair, cc = pr * 2;
    unsigned raw[NIT][11];
    const char* pb = (const char*)(proj + ((size_t)RP0 - 3) * PROJW + pcol0);
    const unsigned vo0 = (unsigned)(oct0 * 8 * PROJW + cc) * 2u;
#pragma unroll
    for (int n = 0; n < NIT; ++n)
#pragma unroll
        for (int k = 0; k < 11; ++k) raw[n][k] = *(const unsigned*)(pb + (vo0 + (unsigned)((n * OSTEP * 8 + k) * PROJW * 2)));
    f32x2 w2[4];
#pragma unroll
    for (int k = 0; k < 4; ++k) w2[k] = *(const f32x2*)(cw + k * cwld + cc);
    const f32x2 b2 = *(const f32x2*)(cb + cc);
#pragma unroll
    for (int n = 0; n < NIT; ++n) { const int l0 = (oct0 + n * OSTEP) * 8;
        f32x2 x2[11];
#pragma unroll
        for (int k = 0; k < 11; ++k) x2[k] = (f32x2){bflo(raw[n][k]), bfhi(raw[n][k])};
        float y0[8], y1[8];
#pragma unroll
        for (int i = 0; i < 8; ++i) { f32x2 a2 = b2;
#pragma unroll
            for (int k = 0; k < 4; ++k) a2 = __builtin_elementwise_fma(w2[k], x2[i + k], a2);
            float a = a2.x, b = a2.y;
            if (ACT) { a = silu_f(a); b = silu_f(b); }
            if (MODE == 1 && wt) { const float sc = wt[(cc >> 6) * 128 + l0 + i]; a *= sc; b *= sc; }
            y0[i] = a; y1[i] = b; }
        if (MODE == 0) {
#pragma unroll
            for (int i = 0; i < 8; ++i) *(LAS unsigned*)(dst + (l0 + i) * RS + cc * 2) = pg8::cvt_pk_bf16(y0[i], y1[i]);
        } else {
            u32x4 q0, q1; q0.x = pg8::cvt_pk_bf16(y0[0], y0[1]); q0.y = pg8::cvt_pk_bf16(y0[2], y0[3]); q0.z = pg8::cvt_pk_bf16(y0[4], y0[5]); q0.w = pg8::cvt_pk_bf16(y0[6], y0[7]);
            q1.x = pg8::cvt_pk_bf16(y1[0], y1[1]); q1.y = pg8::cvt_pk_bf16(y1[2], y1[3]); q1.z = pg8::cvt_pk_bf16(y1[4], y1[5]); q1.w = pg8::cvt_pk_bf16(y1[6], y1[7]);
            *(LAS u32x4*)(dst + cc * TS + l0 * 2) = q0; *(LAS u32x4*)(dst + (cc + 1) * TS + l0 * 2) = q1;
        }
        __builtin_amdgcn_sched_barrier(0);
    }
    asm volatile("" ::: "memory");
}

template <bool WT>
__device__ __forceinline__ void ssd_tables(const Params& p, int l_, int R0, int g, LAS unsigned char* lds, int wid, int lane) {
    if (wid < 4) { const int h = 4 * g + wid; const float* dtraw = (const float*)(p.ws + WS_DTRAW);
        LAS float* dtv = (LAS float*)(lds + L_TAB) + wid * 128; LAS float* acs = (LAS float*)(lds + L_TAB + 2048) + wid * 128; LAS float* wt = (LAS float*)(lds + L_TAB + 4096) + wid * 128;
        const float bias = p.ssd_dt_bias[l_ * 16 + h], A = -__expf(p.ssd_a_log[l_ * 16 + h]);
        const float dt0 = softplus_f(dtraw[(size_t)(R0 + 2 * lane) * 16 + h] + bias), dt1 = softplus_f(dtraw[(size_t)(R0 + 2 * lane + 1) * 16 + h] + bias);
        const float v0 = dt0 * A, v1 = dt1 * A; float sc = v0 + v1;
#pragma unroll
        for (int d = 1; d < 64; d <<= 1) { const float t = bperm_f(lane - d, sc); if (lane >= d) sc += t; }
        const float a0 = sc - v1, a1 = sc;
        dtv[2 * lane] = dt0; dtv[2 * lane + 1] = dt1; acs[2 * lane] = a0; acs[2 * lane + 1] = a1;
        if (WT) { const float alast = __builtin_bit_cast(float, __builtin_amdgcn_readlane(__builtin_bit_cast(int, sc), 63)); wt[2 * lane] = dt0 * __expf(alast - a0); wt[2 * lane + 1] = dt1 * __expf(alast - a1);
            if (lane == 0) ((float*)(p.ws + WS_DECAY))[(R0 >> 7) * 16 + h] = __expf(alast); }
    }
}

template <bool FINAL>
__device__ __forceinline__ void lru_wave(const Params& p, int l_, int bc  , int g, const LAS unsigned char* U, LAS unsigned char* H, int wid, int lane) {
    const int hh = wid >> 1, sub = wid & 1, h = 4 * g + hh, jj = lane & 15, quad = lane >> 4;
    const bf16_t* wat = (const bf16_t*)(p.ws + WS_WAT) + (size_t)h * 2 * 4096;
    bf16x8 wa[2][2], wx[2][2];
    float ba[2], bx[2], c8[2], hin[2], P[2];
#pragma unroll
    for (int nt = 0; nt < 2; ++nt) { const int j = 32 * sub + 16 * nt + jj, col = h * 64 + j;
#pragma unroll
        for (int kc = 0; kc < 2; ++kc) { wa[nt][kc] = *(const bf16x8*)(wat + j * 64 + kc * 32 + quad * 8); wx[nt][kc] = *(const bf16x8*)(wat + 4096 + j * 64 + kc * 32 + quad * 8); }
        ba[nt] = p.lru_ba[l_ * 1024 + col]; bx[nt] = p.lru_bx[l_ * 1024 + col]; c8[nt] = -8.f * 1.4426950408889634f * softplus_f(-p.lru_lambda[l_ * 1024 + col]);
        hin[nt] = FINAL ? ((const float*)(p.ws + WS_LCARRY))[(size_t)bc * 1024 + col] : 0.f; P[nt] = 1.f; }
#pragma unroll 1
    for (int mt = 0; mt < 8; ++mt) {
        bf16x8 ua[2];
#pragma unroll
        for (int kc = 0; kc < 2; ++kc) ua[kc] = *(const LAS bf16x8*)(U + (16 * mt + jj) * US + (hh * 64 + kc * 32 + quad * 8) * 2);
#pragma unroll
        for (int nt = 0; nt < 2; ++nt) {
            f32x4 R = (f32x4){0.f, 0.f, 0.f, 0.f}, I = R;
            R = __builtin_amdgcn_mfma_f32_16x16x32_bf16(ua[0], wa[nt][0], R, 0, 0, 0); R = __builtin_amdgcn_mfma_f32_16x16x32_bf16(ua[1], wa[nt][1], R, 0, 0, 0);
            I = __builtin_amdgcn_mfma_f32_16x16x32_bf16(ua[0], wx[nt][0], I, 0, 0, 0); I = __builtin_amdgcn_mfma_f32_16x16x32_bf16(ua[1], wx[nt][1], I, 0, 0, 0);
            const int j = 32 * sub + 16 * nt + jj;
            float a[4], v[4];
#pragma unroll
            for (int r = 0; r < 4; ++r) { const int l = 16 * mt + 4 * quad + r;
                const float uval = bf2f(*(const LAS bf16_t*)(U + l * US + (hh * 64 + j) * 2));
                const float rr = sigmoid_f(R[r] + ba[nt]), ig = sigmoid_f(I[r] + bx[nt]);
                const float av = __builtin_amdgcn_exp2f(c8[nt] * rr);
                a[r] = av; v[r] = __builtin_amdgcn_sqrtf(fmaxf(0.f, __builtin_fmaf(-av, av, 1.f))) * (ig * uval); }
            const float A4 = (a[0] * a[1]) * (a[2] * a[3]);
            const float B4 = ((v[0] * a[1] + v[1]) * a[2] + v[2]) * a[3] + v[3];
            float hs = hin[nt], hstart = 0.f, Pm = 1.f;
#pragma unroll
            for (int q = 0; q < 4; ++q) { const float Aq = bperm_f(jj + 16 * q, A4), Bq = bperm_f(jj + 16 * q, B4); if (q == quad) hstart = hs; hs = Aq * hs + Bq; Pm *= Aq; }
            hin[nt] = hs; P[nt] *= Pm;
            if (FINAL) { float hc = hstart;
#pragma unroll
                for (int r = 0; r < 4; ++r) { hc = a[r] * hc + v[r]; *(LAS bf16_t*)(H + (16 * mt + 4 * quad + r) * US + (hh * 64 + j) * 2) = (bf16_t)f2bf(hc); } }
        }
    }
    if (!FINAL && quad == 0) {
#pragma unroll
        for (int nt = 0; nt < 2; ++nt) { float* o = (float*)(p.ws + WS_LSUM) + ((size_t)bc * 1024 + h * 64 + 32 * sub + 16 * nt + jj) * 2; o[0] = P[nt]; o[1] = hin[nt]; } }
}

__device__ __forceinline__ void ph_mixA(const Params& p, int l_, LAS unsigned char* lds) {
    const bf16_t* proj = (const bf16_t*)(p.ws + WS_PROJ); float* states = (float*)(p.ws + WS_STATES);
    const float* scw = p.ssd_conv_w + (size_t)l_ * 4 * SSD_CD; const float* scb = p.ssd_conv_b + l_ * SSD_CD;
    const float* lcw = p.lru_conv_w + (size_t)l_ * 4 * 1024; const float* lcb = p.lru_conv_b + l_ * 1024;
    for (int u = blockIdx.x; u < NB * NCH * 4; u += gridDim.x) {
        const int tid = opaque_tid(), wid = __builtin_amdgcn_readfirstlane(tid >> 6), lane = tid & 63, jj = lane & 15, quad = lane >> 4;
        const int g = u & 3, c = (u >> 2) & 63, b = u >> 8; const int t0 = c * CH, R0 = b * SEQ + t0, RP0 = R0 + PPAD * (b + 1);
        stage_conv<0, false, 256>(proj, RP0, O_LX + 256 * g, lcw + 256 * g, 1024, lcb + 256 * g, lds, US, nullptr, tid);
        ssd_tables<true>(p, l_, R0, g, lds, wid, lane);
        __syncthreads();
        lru_wave<false>(p, l_, b * NCH + c, g, lds, nullptr, wid, lane);
        __syncthreads();
        stage_conv<1, true, 256>(proj, RP0, O_XS + 256 * g, scw + 256 * g, SSD_CD, scb + 256 * g, lds, 0, (const LAS float*)(lds + L_TAB + 4096), tid);
        stage_conv<1, true, 128>(proj, RP0, O_B + 128 * g, scw + 1024 + 128 * g, SSD_CD, scb + 1024 + 128 * g, lds + 69632, 0, nullptr, tid);
        __syncthreads();
        { const int hh = wid >> 1, sub = wid & 1, h = 4 * g + hh;
            f32x4 acc[4][4];
#pragma unroll
            for (int mt = 0; mt < 4; ++mt)
#pragma unroll
                for (int n = 0; n < 4; ++n) acc[mt][n] = (f32x4){0.f, 0.f, 0.f, 0.f};
#pragma unroll
            for (int kc = 0; kc < 4; ++kc) { bf16x8 bfr[4];
#pragma unroll
                for (int n = 0; n < 4; ++n) bfr[n] = *(const LAS bf16x8*)(lds + 69632 + (16 * (4 * sub + n) + jj) * TS + (32 * kc + 8 * quad) * 2);
#pragma unroll
                for (int mt = 0; mt < 4; ++mt) { const bf16x8 xa = *(const LAS bf16x8*)(lds + (hh * 64 + 16 * mt + jj) * TS + (32 * kc + 8 * quad) * 2);
#pragma unroll
                    for (int n = 0; n < 4; ++n) acc[mt][n] = __builtin_amdgcn_mfma_f32_16x16x32_bf16(xa, bfr[n], acc[mt][n], 0, 0, 0); } }
            float* st = states + ((size_t)((b * NCH + c) * 16 + h)) * 8192;
#pragma unroll
            for (int mt = 0; mt < 4; ++mt)
#pragma unroll
                for (int n = 0; n < 4; ++n)
#pragma unroll
                    for (int r = 0; r < 4; ++r) st[(16 * mt + 4 * quad + r) * 128 + 16 * (4 * sub + n) + jj] = acc[mt][n][r];
        }
        __syncthreads();
    }
}

__device__ __forceinline__ void ph_scan(const Params& p) {
    const float* states = (const float*)(p.ws + WS_STATES); const float* decay = (const float*)(p.ws + WS_DECAY); bf16_t* prevb = (bf16_t*)(p.ws + WS_PREV);
    const float* lsum = (const float*)(p.ws + WS_LSUM); float* lcarry = (float*)(p.ws + WS_LCARRY);
    const int gt = blockIdx.x * NTHR + opaque_tid(), NGT = gridDim.x * NTHR;
    for (int e = gt; e < NB * 16 * 8192 / 4; e += NGT) {
        const int q = e & 2047, h = (e >> 11) & 15, b = e >> 15;
        f32x4 r = (f32x4){0.f, 0.f, 0.f, 0.f};
#pragma unroll 4
        for (int c = 0; c < NCH; ++c) { const size_t o = ((size_t)((b * NCH + c) * 16 + h)) * 8192 + q * 4; const f32x4 t = *(const f32x4*)(states + o);
            u32x2 w; w.x = pg8::cvt_pk_bf16(r.x, r.y); w.y = pg8::cvt_pk_bf16(r.z, r.w); *(u32x2*)(prevb + o) = w; r = r * decay[(b * NCH + c) * 16 + h] + t; }
    }
    for (int e = gt; e < NB * 1024; e += NGT) { const int ch = e & 1023, b = e >> 10; float r = 0.f;
        for (int c = 0; c < NCH; ++c) { const size_t i = (size_t)(b * NCH + c) * 1024 + ch; lcarry[i] = r; r = lsum[i * 2] * r + lsum[i * 2 + 1]; } }
}

__device__ __forceinline__ void ph_mixB(const Params& p, int l_, LAS unsigned char* lds) {
    const bf16_t* proj = (const bf16_t*)(p.ws + WS_PROJ); bf16_t* mix = (bf16_t*)(p.ws + WS_MIX); float* rowss = (float*)(p.ws + WS_ROWSS);
    const float* scw = p.ssd_conv_w + (size_t)l_ * 4 * SSD_CD; const float* scb = p.ssd_conv_b + l_ * SSD_CD;
    const float* lcw = p.lru_conv_w + (size_t)l_ * 4 * 1024; const float* lcb = p.lru_conv_b + l_ * 1024;
    LAS unsigned char* Bm = lds; LAS unsigned char* Cm = lds + 34816; LAS unsigned char* Xt = lds + 69632;
    const LAS float* dtv = (const LAS float*)(lds + L_TAB); const LAS float* acs = (const LAS float*)(lds + L_TAB + 2048); LAS float* rpart = (LAS float*)(lds + L_RPART);
    for (int u = blockIdx.x; u < NB * NCH * 4; u += gridDim.x) {
        const int tid = opaque_tid(), wid = __builtin_amdgcn_readfirstlane(tid >> 6), lane = tid & 63, jj = lane & 15, quad = lane >> 4;
        const int g = u & 3, c = (u >> 2) & 63, b = u >> 8; const int t0 = c * CH, R0 = b * SEQ + t0, RP0 = R0 + PPAD * (b + 1);
        TS0(101);
        stage_conv<0, true, 128>(proj, RP0, O_B + 128 * g, scw + 1024 + 128 * g, SSD_CD, scb + 1024 + 128 * g, Bm, TS, nullptr, tid);
        stage_conv<0, true, 128>(proj, RP0, O_C + 128 * g, scw + 1536 + 128 * g, SSD_CD, scb + 1536 + 128 * g, Cm, TS, nullptr, tid);
        stage_conv<1, true, 256>(proj, RP0, O_XS + 256 * g, scw + 256 * g, SSD_CD, scb + 256 * g, Xt, 0, nullptr, tid);
        ssd_tables<false>(p, l_, R0, g, lds, wid, lane);
        bf16x8 pa[4][4];
        { const bf16_t* prev = (const bf16_t*)(p.ws + WS_PREV) + ((size_t)((b * NCH + c) * 16 + 4 * g + (wid >> 1))) * 8192;
#pragma unroll
            for (int kc = 0; kc < 4; ++kc)
#pragma unroll
                for (int mt = 0; mt < 4; ++mt) pa[kc][mt] = *(const bf16x8*)(prev + (16 * mt + jj) * 128 + 32 * kc + 8 * quad); }
        __syncthreads();
        TS1(101); TS0(102);
        { const int hh = wid >> 1, sub = wid & 1, h = 4 * g + hh;
            const float Dh = p.ssd_d[l_ * 16 + h];
            const LAS float* dth = dtv + hh * 128; const LAS float* ach = acs + hh * 128;
            int lts[4]; lts[0] = sub ? 1 : 0; lts[1] = sub ? 2 : 3; lts[2] = sub ? 5 : 4; lts[3] = sub ? 6 : 7;
            f32x4 acc[4][4];
#pragma unroll
            for (int mt = 0; mt < 4; ++mt)
#pragma unroll
                for (int li = 0; li < 4; ++li) acc[mt][li] = (f32x4){0.f, 0.f, 0.f, 0.f};
            TS0(106);
#pragma unroll
            for (int kc = 0; kc < 4; ++kc) {
#pragma unroll
                for (int li = 0; li < 4; ++li) { const bf16x8 cf = *(const LAS bf16x8*)(Cm + (16 * lts[li] + jj) * TS + (32 * kc + 8 * quad) * 2);
#pragma unroll
                    for (int mt = 0; mt < 4; ++mt) acc[mt][li] = __builtin_amdgcn_mfma_f32_16x16x32_bf16(pa[kc][mt], cf, acc[mt][li], 0, 0, 0); } }
            u32x2 zr[4][4];
            { int jz = jj; asm volatile("" : "+v"(jz));
#pragma unroll
            for (int li = 0; li < 4; ++li)
#pragma unroll
                for (int mt = 0; mt < 4; ++mt) zr[li][mt] = *(const u32x2*)(proj + (size_t)(RP0 + 16 * lts[li] + jz) * PROJW + O_Z + h * 64 + 16 * mt + 4 * quad); }
#pragma unroll
            for (int li = 0; li < 4; ++li) { const float e = __expf(ach[16 * lts[li] + jj]);
#pragma unroll
                for (int mt = 0; mt < 4; ++mt) acc[mt][li] = acc[mt][li] * e; }
            TS1(106); TS0(107);
#pragma unroll
            for (int li = 0; li < 4; ++li) { const int lt = lts[li];
                bf16x8 cfr[4];
#pragma unroll
                for (int kc = 0; kc < 4; ++kc) cfr[kc] = *(const LAS bf16x8*)(Cm + (16 * lt + jj) * TS + (32 * kc + 8 * quad) * 2);
                const float al = ach[16 * lt + jj];
#pragma unroll 1
                for (int sc = 0; sc <= (lt >> 1); ++sc) {
                    float gv[8];
#pragma unroll
                    for (int t2 = 0; t2 < 2; ++t2) { const int st = 2 * sc + t2;
                        f32x4 S = (f32x4){0.f, 0.f, 0.f, 0.f};
                        if (st <= lt) {
#pragma unroll
                            for (int kc = 0; kc < 4; ++kc) { const bf16x8 bf_ = *(const LAS bf16x8*)(Bm + (16 * st + jj) * TS + (32 * kc + 8 * quad) * 2); S = __builtin_amdgcn_mfma_f32_16x16x32_bf16(bf_, cfr[kc], S, 0, 0, 0); }
                            const f32x4 dt4 = *(const LAS f32x4*)(dth + 16 * st + 4 * quad), as4 = *(const LAS f32x4*)(ach + 16 * st + 4 * quad);
                            const bool diag = (st == lt);
#pragma unroll
                            for (int r = 0; r < 4; ++r) { float val = S[r] * __expf(al - as4[r]) * dt4[r];
                                if (diag) { const int sr = 4 * quad + r; val = (sr > jj) ? 0.f : val; val = (sr == jj) ? val + Dh : val; }
                                gv[t2 * 4 + r] = val; }
                        } else {
#pragma unroll
                            for (int r = 0; r < 4; ++r) gv[t2 * 4 + r] = 0.f; }
                    }
                    u32x4 gq; gq.x = pg8::cvt_pk_bf16(gv[0], gv[1]); gq.y = pg8::cvt_pk_bf16(gv[2], gv[3]); gq.z = pg8::cvt_pk_bf16(gv[4], gv[5]); gq.w = pg8::cvt_pk_bf16(gv[6], gv[7]);
                    const bf16x8 gb = __builtin_bit_cast(bf16x8, gq);
#pragma unroll
                    for (int mt = 0; mt < 4; ++mt) { const LAS unsigned char* xp = Xt + (hh * 64 + 16 * mt + jj) * TS + (32 * sc + 4 * quad) * 2;
                        const u32x2 x0 = *(const LAS u32x2*)xp, x1 = *(const LAS u32x2*)(xp + 32);
                        u32x4 xq; xq.x = x0.x; xq.y = x0.y; xq.z = x1.x; xq.w = x1.y;
                        acc[mt][li] = __builtin_amdgcn_mfma_f32_16x16x32_bf16(__builtin_bit_cast(bf16x8, xq), gb, acc[mt][li], 0, 0, 0); }
                }
            }
            TS1(107); TS0(108);
#pragma unroll
            for (int li = 0; li < 4; ++li) { const int l = 16 * lts[li] + jj; float ssq = 0.f;
#pragma unroll
                for (int mt = 0; mt < 4; ++mt) { const u32x2 z = zr[li][mt]; const f32x4 a4 = acc[mt][li];
                    const float y0 = a4[0] * silu_f(bflo(z.x)), y1 = a4[1] * silu_f(bfhi(z.x)), y2 = a4[2] * silu_f(bflo(z.y)), y3 = a4[3] * silu_f(bfhi(z.y));
                    ssq += (y0 * y0 + y1 * y1) + (y2 * y2 + y3 * y3);
                    u32x2 o; o.x = pg8::cvt_pk_bf16(y0, y1); o.y = pg8::cvt_pk_bf16(y2, y3);
                    *(u32x2*)(mix + (size_t)(R0 + l) * 2048 + 1024 + h * 64 + 16 * mt + 4 * quad) = o; }
                ssq += bperm_f(lane ^ 16, ssq); ssq += bperm_f(lane ^ 32, ssq);
                if (quad == 0) rpart[hh * 128 + l] = ssq; }
            TS1(108);
        }
        __syncthreads();
        TS1(102); TS0(103);
        if (tid < 128) rowss[(size_t)(R0 + tid) * 8 + 4 + g] = (rpart[tid] + rpart[128 + tid]) + (rpart[256 + tid] + rpart[384 + tid]);
        stage_conv<0, false, 256>(proj, RP0, O_LX + 256 * g, lcw + 256 * g, 1024, lcb + 256 * g, lds, US, nullptr, tid);
        __syncthreads();
        TS1(103); TS0(104);
        lru_wave<true>(p, l_, b * NCH + c, g, lds, lds + 67584, wid, lane);
        __syncthreads();
        TS1(104); TS0(105);
#pragma unroll 4
        for (int k = 0; k < 8; ++k) { const int it = tid + k * NTHR, l = it >> 5, ch = it & 31;
            const u32x4 hv = *(const LAS u32x4*)(lds + 67584 + l * US + ch * 16);
            const u32x4 gt = *(const u32x4*)(proj + (size_t)(RP0 + l) * PROJW + O_LG + 256 * g + ch * 8);
            float y[8];
            y[0] = fast_gelu(bflo(gt.x)) * bflo(hv.x); y[1] = fast_gelu(bfhi(gt.x)) * bfhi(hv.x); y[2] = fast_gelu(bflo(gt.y)) * bflo(hv.y); y[3] = fast_gelu(bfhi(gt.y)) * bfhi(hv.y);
            y[4] = fast_gelu(bflo(gt.z)) * bflo(hv.z); y[5] = fast_gelu(bfhi(gt.z)) * bfhi(hv.z); y[6] = fast_gelu(bflo(gt.w)) * bflo(hv.w); y[7] = fast_gelu(bfhi(gt.w)) * bfhi(hv.w);
            float sq = 0.f;
#pragma unroll
            for (int i = 0; i < 8; ++i) sq += y[i] * y[i];
            u32x4 o; o.x = pg8::cvt_pk_bf16(y[0], y[1]); o.y = pg8::cvt_pk_bf16(y[2], y[3]); o.z = pg8::cvt_pk_bf16(y[4], y[5]); o.w = pg8::cvt_pk_bf16(y[6], y[7]);
            *(u32x4*)(mix + (size_t)(R0 + l) * 2048 + 256 * g + ch * 8) = o;
            sq += SWZ_XOR(sq, 1); sq += SWZ_XOR(sq, 2); sq += SWZ_XOR(sq, 4); sq += SWZ_XOR(sq, 8); sq += SWZ_XOR(sq, 16);
            if ((lane & 31) == 0) rowss[(size_t)(R0 + l) * 8 + g] = sq; }
        __syncthreads();
        TS1(105);
    }
}

__device__ __forceinline__ void ph_router(const Params& p, int l, LAS unsigned char* lds) {
    const int tid = opaque_tid(), lane = tid & 63, wave = tid >> 6;
    LAS float* wcl = (LAS float*)lds;
    LAS float* wfl = (LAS float*)(lds + 16384);
    __syncthreads();
    for (int i = tid; i < 1024; i += NTHR) { const f32x4 w = *(const f32x4*)(p.w_coarse + ((size_t)l * DM + i) * 4); wcl[i] = w.x; wcl[1024 + i] = w.y; wcl[2048 + i] = w.z; wcl[3072 + i] = w.w; }
    for (int i = tid; i < 8192; i += NTHR) { const int gk = i >> 1, hf = i & 1, gg = gk >> 10, k = gk & 1023; const f32x4 w = *(const f32x4*)(p.w_fine + (((size_t)l * 4 + gg) * DM + k) * 8 + hf * 4);
        LAS float* d = wfl + (gg * 8 + hf * 4) * 1024 + k; d[0] = w.x; d[1024] = w.y; d[2048] = w.z; d[3072] = w.w; }
    LAS int* lcount = (LAS int*)(lds + 147456); LAS int* lbase = lcount + 32; LAS int* rec_e = lcount + 64; LAS int* rec_tok = rec_e + 128; LAS int* rec_pos = rec_tok + 128; LAS float* rec_w = (LAS float*)(rec_pos + 128);
    if (tid < 32) lcount[tid] = 0;
    if (tid < 128) rec_e[tid] = -1;
    __syncthreads();
    const int gw = blockIdx.x * 8 + wave, NGW = gridDim.x * 8;
    bf16_t* hb = (bf16_t*)(p.ws + WS_H); int* cnt = (int*)(p.ws + WS_CTL); int* ltok = (int*)(p.ws + WS_LTOK); float* lw = (float*)(p.ws + WS_LW);
    const float* nw = p.norm_ffn + l * DM;
    constexpr int RB = 4;
    int it = 0;
    for (int base = gw * RB; base < NTOK; base += NGW * RB, ++it) {
        asm volatile("" ::: "memory");
        f32x4 v[RB][4];
#pragma unroll
        for (int r = 0; r < RB; ++r)
#pragma unroll
            for (int j = 0; j < 4; ++j) v[r][j] = *(const f32x4*)(p.X + (size_t)(base + r) * DM + j * 256 + lane * 4);
        f32x4 nwv[4];
#pragma unroll
        for (int j = 0; j < 4; ++j) nwv[j] = *(const f32x4*)(nw + j * 256 + lane * 4);
#pragma unroll
        for (int r = 0; r < RB; ++r) { float ss = 0.f;
#pragma unroll
            for (int j = 0; j < 4; ++j) ss += (v[r][j].x * v[r][j].x + v[r][j].y * v[r][j].y) + (v[r][j].z * v[r][j].z + v[r][j].w * v[r][j].w);
            const float rstd = rsqrtf(wave_sum(ss) * (1.f / DM) + 1e-6f);
#pragma unroll
            for (int j = 0; j < 4; ++j) { v[r][j] = v[r][j] * rstd * nwv[j];
                u32x2 o; o.x = pk2(v[r][j].x, v[r][j].y); o.y = pk2(v[r][j].z, v[r][j].w); *(u32x2*)(hb + (size_t)(base + r) * DM + j * 256 + lane * 4) = o; } }
        float cv[16];
#pragma unroll
        for (int q = 0; q < 4; ++q) { float a[RB];
#pragma unroll
            for (int r = 0; r < RB; ++r) a[r] = 0.f;
#pragma unroll
            for (int j = 0; j < 4; ++j) { const f32x4 c4 = *(const LAS f32x4*)(wcl + q * 1024 + j * 256 + lane * 4);
#pragma unroll
                for (int r = 0; r < RB; ++r) a[r] += (v[r][j].x * c4.x + v[r][j].y * c4.y) + (v[r][j].z * c4.z + v[r][j].w * c4.w); }
#pragma unroll
            for (int r = 0; r < RB; ++r) cv[r * 4 + q] = a[r]; }
        float c8[8], c4v[4], c2[2], c1[1];
        rs_step<0>(cv, c8, lane); rs_step<1>(c8, c4v, lane); rs_step<2>(c4v, c2, lane); rs_step<3>(c2, c1, lane);
        float cs = c1[0]; cs += SWZ_XOR(cs, 16); cs += __builtin_bit_cast(float, __builtin_amdgcn_ds_bpermute((lane ^ 32) << 2, __builtin_bit_cast(int, cs)));
        int gi[RB]; float gwt[RB];
#pragma unroll
        for (int r = 0; r < RB; ++r) { float cl[4];
#pragma unroll
            for (int q = 0; q < 4; ++q) cl[q] = __builtin_bit_cast(float, __builtin_amdgcn_readlane(__builtin_bit_cast(int, cs), r * 4 + q)) + p.b_coarse[l * 4 + q];
            int g_ = 0; float cm = cl[0];
#pragma unroll
            for (int q = 1; q < 4; ++q) if (cl[q] > cm) { cm = cl[q]; g_ = q; }
            float den = 0.f;
#pragma unroll
            for (int q = 0; q < 4; ++q) den += __expf(cl[q] - cm);
            gi[r] = __builtin_amdgcn_readfirstlane(g_); gwt[r] = 1.f / den; }
        float fv[32];
#pragma unroll
        for (int r = 0; r < RB; ++r) { const LAS float* wfg = wfl + gi[r] * 8192;
#pragma unroll
            for (int q = 0; q < 8; ++q) { float a = 0.f;
#pragma unroll
                for (int j = 0; j < 4; ++j) { const f32x4 w = *(const LAS f32x4*)(wfg + q * 1024 + j * 256 + lane * 4); a += (v[r][j].x * w.x + v[r][j].y * w.y) + (v[r][j].z * w.z + v[r][j].w * w.w); }
                fv[r * 8 + q] = a; } }
        float f16[16], f8[8], f4[4], f2[2], f1[1];
        rs_step<0>(fv, f16, lane); rs_step<1>(f16, f8, lane); rs_step<2>(f8, f4, lane); rs_step<3>(f4, f2, lane); rs_step<4>(f2, f1, lane);
        float fs = f1[0]; fs += __builtin_bit_cast(float, __builtin_amdgcn_ds_bpermute((lane ^ 32) << 2, __builtin_bit_cast(int, fs)));
#pragma unroll
        for (int r = 0; r < RB; ++r) { float fl[8];
#pragma unroll
            for (int q = 0; q < 8; ++q) fl[q] = __builtin_bit_cast(float, __builtin_amdgcn_readlane(__builtin_bit_cast(int, fs), r * 8 + q)) + p.b_fine[(l * 4 + gi[r]) * 8 + q];
            int i0 = 0; float v0 = fl[0];
#pragma unroll
            for (int q = 1; q < 8; ++q) if (fl[q] > v0) { v0 = fl[q]; i0 = q; }
            int i1 = -1; float v1 = -3.0e38f;
#pragma unroll
            for (int q = 0; q < 8; ++q) if (q != i0 && fl[q] > v1) { v1 = fl[q]; i1 = q; }
            const float e1 = __expf(v1 - v0), w0 = gwt[r] / (1.f + e1), w1 = gwt[r] * e1 / (1.f + e1);
            if (lane == 0) { const int row = base + r, ex0 = gi[r] * 8 + i0, ex1 = gi[r] * 8 + i1, lr = wave * 8 + it * RB + r;
                if (lr < 64 && it * RB + r < 8) {
                    const int p0 = __hip_atomic_fetch_add(lcount + ex0, 1, __ATOMIC_RELAXED, __HIP_MEMORY_SCOPE_WORKGROUP); rec_e[lr * 2] = ex0; rec_tok[lr * 2] = row * 2 + 0; rec_pos[lr * 2] = p0; rec_w[lr * 2] = w0;
                    const int p1 = __hip_atomic_fetch_add(lcount + ex1, 1, __ATOMIC_RELAXED, __HIP_MEMORY_SCOPE_WORKGROUP); rec_e[lr * 2 + 1] = ex1; rec_tok[lr * 2 + 1] = row * 2 + 1; rec_pos[lr * 2 + 1] = p1; rec_w[lr * 2 + 1] = w1;
                } else {
                    const int p0 = atomicAdd(cnt + ex0, 1); ltok[(size_t)ex0 * LISTCAP + p0] = row * 2 + 0; lw[(size_t)ex0 * LISTCAP + p0] = w0;
                    const int p1 = atomicAdd(cnt + ex1, 1); ltok[(size_t)ex1 * LISTCAP + p1] = row * 2 + 1; lw[(size_t)ex1 * LISTCAP + p1] = w1; } } }
    }
    __syncthreads();
    if (tid < 32) { const int n = lcount[tid]; lbase[tid] = n ? atomicAdd(cnt + tid, n) : 0; }
    __syncthreads();
    if (tid < 128) { const int e = rec_e[tid]; if (e >= 0) { const size_t dst = (size_t)e * LISTCAP + lbase[e] + rec_pos[tid]; ltok[dst] = rec_tok[tid]; lw[dst] = rec_w[tid]; } }
}

__device__ __forceinline__ int moe_tiles(const Params& p, LAS int* tb) {
    const int* cnt = (const int*)(p.ws + WS_CTL);
    __syncthreads();
    if (opaque_tid() == 0) { int s = 0; for (int e = 0; e < NEXP; ++e) { tb[e] = s; s += (cnt[e] + 255) >> 8; } tb[NEXP] = s; }
    __syncthreads();
    return tb[NEXP];
}
struct SchedMoe { LAS const int* tb; int G, c, up; const int* cnt; const int* ltok; const bf16_t* A; const bf16_t* B;
    __device__ __forceinline__ bool next(int i, pg8::Unit& u) const {
        const int L = i * G + c; if (L >= tb[NEXP] * 4) return false;
        const int t = L >> 2, pn = L & 3; int e = 0; while (tb[e + 1] <= t) ++e;
        const int pos0 = (t - tb[e]) * 256;
        u.pm = t; u.pn = pn; u.rows = ltok + (size_t)e * LISTCAP + pos0; u.nrows = cnt[e] - pos0;
        if (up) { u.a = A; u.b = B + ((size_t)e * 1024 + pn * 256) * DM; } else { u.a = A + (size_t)t * 256 * DEXP; u.b = B + ((size_t)e * 1024 + pn * 256) * DEXP; }
        return true; } };
struct EpiUp { static constexpr bool PERM = true; bf16_t* hid;
    __device__ __forceinline__ void operator()(const f32x4 (&acc)[2][2][4][2], const pg8::Unit& u, int wr, int wc, int fr, int fq) const {
        const int row0 = u.pm * 256 + wr * 64 + fr, col0 = u.pn * 128 + wc * 32 + 8 * fq;
#pragma unroll
        for (int ai = 0; ai < 2; ++ai)
#pragma unroll
            for (int m = 0; m < 4; ++m) { float o[8];
#pragma unroll
                for (int n = 0; n < 2; ++n)
#pragma unroll
                    for (int j = 0; j < 4; ++j) o[n * 4 + j] = silu_f(acc[ai][0][m][n][j]) * acc[ai][1][m][n][j];
                u32x4 w; w.x = pg8::cvt_pk_bf16(o[0], o[1]); w.y = pg8::cvt_pk_bf16(o[2], o[3]); w.z = pg8::cvt_pk_bf16(o[4], o[5]); w.w = pg8::cvt_pk_bf16(o[6], o[7]);
                *(u32x4*)(hid + (size_t)(row0 + ai * 128 + m * 16) * DEXP + col0) = w; }
    } };
__device__ __forceinline__ void ph_moe_up(const Params& p, LAS unsigned char* lds) {
    LAS int* tb = (LAS int*)(lds + LDS_TB);
    moe_tiles(p, tb);
    SchedMoe S{tb, (int)gridDim.x, (int)blockIdx.x, 1, (const int*)(p.ws + WS_CTL), (const int*)(p.ws + WS_LTOK), (const bf16_t*)(p.ws + WS_H), (const bf16_t*)(p.ws + WS_WGU)};
    pg8::gemm_phase<EpiUp, SchedMoe, true>(lds, DM, DM, DM, S, EpiUp{(bf16_t*)(p.ws + WS_HID)});
}
struct EpiDown { static constexpr bool PERM = true; bf16_t* ys; const float* lw; const int* ltok;
    __device__ __forceinline__ void operator()(const f32x4 (&acc)[2][2][4][2], const pg8::Unit& u, int wr, int wc, int fr, int fq) const {
        const int col0 = u.pn * 256 + wc * 32 + 8 * fq; const float* lwr = lw + (u.rows - ltok);
#pragma unroll
        for (int ai = 0; ai < 2; ++ai)
#pragma unroll
            for (int m = 0; m < 4; ++m) { const int r = ai * 128 + wr * 64 + m * 16 + fr;
                if (r < u.nrows) { const int tk = u.rows[r]; const float w = lwr[r]; bf16_t* o = ys + ((size_t)(tk & 1) * NTOK + (tk >> 1)) * DM + col0;
#pragma unroll
                    for (int bj = 0; bj < 2; ++bj) { const f32x4 v0 = acc[ai][bj][m][0] * w, v1 = acc[ai][bj][m][1] * w; u32x4 q;
                        q.x = pg8::cvt_pk_bf16(v0[0], v0[1]); q.y = pg8::cvt_pk_bf16(v0[2], v0[3]); q.z = pg8::cvt_pk_bf16(v1[0], v1[1]); q.w = pg8::cvt_pk_bf16(v1[2], v1[3]);
                        *(u32x4*)(o + bj * 128) = q; } } }
    } };
__device__ __forceinline__ void ph_moe_down(const Params& p, LAS unsigned char* lds) {
    LAS int* tb = (LAS int*)(lds + LDS_TB);
    moe_tiles(p, tb);
    SchedMoe S{tb, (int)gridDim.x, (int)blockIdx.x, 0, (const int*)(p.ws + WS_CTL), (const int*)(p.ws + WS_LTOK), (const bf16_t*)(p.ws + WS_HID), (const bf16_t*)(p.ws + WS_WD)};
    pg8::gemm_phase<EpiDown, SchedMoe, false>(lds, DEXP, DEXP, DEXP, S, EpiDown{(bf16_t*)(p.ws + WS_YSLOT), (const float*)(p.ws + WS_LW), (const int*)(p.ws + WS_LTOK)});
}

__device__ __forceinline__ void ph_final(const Params& p) {
    const int tid = opaque_tid(), lane = tid & 63, wave = tid >> 6;
    const int gw = blockIdx.x * 8 + wave, NGW = gridDim.x * 8;
    const bf16_t* ys = (const bf16_t*)(p.ws + WS_YSLOT);
    for (int row = gw; row < NTOK; row += NGW) {
        f32x4 v[4];
#pragma unroll
        for (int j = 0; j < 4; ++j) v[j] = *(const f32x4*)(p.X + (size_t)row * DM + j * 256 + lane * 4);
#pragma unroll
        for (int s = 0; s < 2; ++s)
#pragma unroll
            for (int j = 0; j < 4; ++j) { const u32x2 y = *(const u32x2*)(ys + ((size_t)s * NTOK + row) * DM + j * 256 + lane * 4);
                v[j].x += __uint_as_float(y.x << 16); v[j].y += __uint_as_float(y.x & 0xffff0000u); v[j].z += __uint_as_float(y.y << 16); v[j].w += __uint_as_float(y.y & 0xffff0000u); }
        float ss = 0.f;
#pragma unroll
        for (int j = 0; j < 4; ++j) ss += (v[j].x * v[j].x + v[j].y * v[j].y) + (v[j].z * v[j].z + v[j].w * v[j].w);
        const float rstd = rsqrtf(wave_sum(ss) * (1.f / DM) + 1e-6f);
#pragma unroll
        for (int j = 0; j < 4; ++j) { const f32x4 w = *(const f32x4*)(p.final_norm + j * 256 + lane * 4); *(f32x4*)(p.X + (size_t)row * DM + j * 256 + lane * 4) = v[j] * rstd * w; }
    }
}


#ifndef DBG
#define DBG 0
#endif
#ifndef DBGA
#define DBGA 12
#define DBGB 12
#endif
#if DBG
constexpr size_t WS_MIX2 = 405 * MiB;
constexpr size_t WS_DBG = 470 * MiB;
__global__ void __launch_bounds__(64) dbg_lru_seq(Params p, int l_) {
    const int b = blockIdx.x >> 4, h = blockIdx.x & 15, j = threadIdx.x, col = h * 64 + j;
    const bf16_t* proj = (const bf16_t*)(p.ws + WS_PROJ); bf16_t* mix2 = (bf16_t*)(p.ws + WS_MIX2);
    __shared__ float us[64];
    const float* cw = p.lru_conv_w + (size_t)l_ * 4 * 1024 + col; const float cb = p.lru_conv_b[l_ * 1024 + col];
    const float* wa = p.lru_wa + ((size_t)l_ * 16 + h) * 4096; const float* wx = p.lru_wx + ((size_t)l_ * 16 + h) * 4096;
    const float ba = p.lru_ba[l_ * 1024 + col], bx = p.lru_bx[l_ * 1024 + col], lam = p.lru_lambda[l_ * 1024 + col];
    const float ls = -log1pf(expf(-lam));
    float hc = 0.f;
    for (int t = 0; t < SEQ; ++t) {
        float u = cb;
        for (int k = 0; k < 4; ++k) { const int tt = t - 3 + k; if (tt >= 0) u += cw[k * 1024] * bf2f(proj[(size_t)(b * SEQ + tt) * PROJW + O_LX + col]); }
        __syncthreads(); us[j] = u; __syncthreads();
        float ra = ba, ia = bx;
        for (int i = 0; i < 64; ++i) { ra += us[i] * wa[i * 64 + j]; ia += us[i] * wx[i * 64 + j]; }
        const float r = 1.f / (1.f + expf(-ra)), ig = 1.f / (1.f + expf(-ia));
        const float log_a = 8.f * r * ls, a = expf(log_a), mult = sqrtf(fmaxf(0.f, -expm1f(2.f * log_a)));
        hc = a * hc + mult * (ig * u);
        const float gt = bf2f(proj[(size_t)(b * SEQ + t) * PROJW + O_LG + col]);
        mix2[(size_t)(b * SEQ + t) * 2048 + col] = (bf16_t)f2bf(gelu_tanh_f(gt) * hc);
    }
}
__global__ void __launch_bounds__(512) dbg_ssd_seq(Params p, int l_) {
    const int b = blockIdx.x >> 4, h = blockIdx.x & 15, g = h >> 2, tid = threadIdx.x;
    const bf16_t* proj = (const bf16_t*)(p.ws + WS_PROJ); bf16_t* mix2 = (bf16_t*)(p.ws + WS_MIX2); const float* dtraw = (const float*)(p.ws + WS_DTRAW);
    __shared__ float xs[64], Bs[128], Cs[128];
    const float* cw = p.ssd_conv_w + (size_t)l_ * 4 * SSD_CD; const float* cb = p.ssd_conv_b + l_ * SSD_CD;
    const float bias = p.ssd_dt_bias[l_ * 16 + h], A = -expf(p.ssd_a_log[l_ * 16 + h]), Dh = p.ssd_d[l_ * 16 + h];
    const int pp = tid >> 3, nb = (tid & 7) * 16;
    float st[16];
    for (int q = 0; q < 16; ++q) st[q] = 0.f;
    for (int t = 0; t < SEQ; ++t) {
        __syncthreads();
        if (tid < 320) { int cc; if (tid < 64) cc = h * 64 + tid; else if (tid < 192) cc = 1024 + g * 128 + (tid - 64); else cc = 1536 + g * 128 + (tid - 192);
            float u = cb[cc];
            for (int k = 0; k < 4; ++k) { const int tt = t - 3 + k; if (tt >= 0) u += cw[k * SSD_CD + cc] * bf2f(proj[(size_t)(b * SEQ + tt) * PROJW + O_XS + cc]); }
            u = u / (1.f + expf(-u));
            if (tid < 64) xs[tid] = u; else if (tid < 192) Bs[tid - 64] = u; else Cs[tid - 192] = u; }
        __syncthreads();
        const float dtp = dtraw[(size_t)(b * SEQ + t) * 16 + h] + bias; const float dt = dtp > 20.f ? dtp : log1pf(expf(dtp));
        const float dec = expf(dt * A), xv = xs[pp] * dt;
        float y = 0.f;
        for (int q = 0; q < 16; ++q) { st[q] = dec * st[q] + xv * Bs[nb + q]; y += Cs[nb + q] * st[q]; }
        y += __shfl_xor(y, 1); y += __shfl_xor(y, 2); y += __shfl_xor(y, 4);
        if ((tid & 7) == 0) { y += Dh * xs[pp]; const float z = bf2f(proj[(size_t)(b * SEQ + t) * PROJW + O_Z + h * 64 + pp]); y *= z / (1.f + expf(-z));
            mix2[(size_t)(b * SEQ + t) * 2048 + 1024 + h * 64 + pp] = (bf16_t)f2bf(y); }
    }
}
__global__ void dbg_cmp_mix(Params p) {
    const bf16_t* a = (const bf16_t*)(p.ws + WS_MIX); const bf16_t* b2 = (const bf16_t*)(p.ws + WS_MIX2); float* acc = (float*)(p.ws + WS_DBG);
    float s[4] = {0.f, 0.f, 0.f, 0.f};
    for (size_t i = (size_t)blockIdx.x * blockDim.x + threadIdx.x; i < (size_t)NTOK * 2048; i += (size_t)gridDim.x * blockDim.x) {
        const int col = (int)(i & 2047); const float x = bf2f(a[i]), y = bf2f(b2[i]); const int o = col < 1024 ? 0 : 2; s[o] += (x - y) * (x - y); s[o + 1] += y * y; }
    for (int q = 0; q < 4; ++q) { const float v = wave_sum(s[q]); if ((threadIdx.x & 63) == 0) atomicAdd(acc + q, v); }
}

__global__ void dbg_chk_inproj(Params p, int l) {
    const int sidx = blockIdx.x * blockDim.x + threadIdx.x; float* acc = (float*)(p.ws + WS_DBG);
    const bf16_t* proj = (const bf16_t*)(p.ws + WS_PROJ); const float* dtraw = (const float*)(p.ws + WS_DTRAW);
    unsigned hsh = (unsigned)sidx * 2654435761u + 12345u; hsh ^= hsh >> 13; hsh *= 0x5bd1e995u; hsh ^= hsh >> 15;
    const int row = hsh % NTOK, col = (hsh >> 14) % INC;
    const float* xr = (l == 0 ? p.x : p.X) + (size_t)row * DM; float ss = 0.f;
    for (int k = 0; k < DM; ++k) ss += xr[k] * xr[k];
    const float rstd = 1.f / sqrtf(ss / DM + 1e-6f);
    float d = 0.f;
    for (int k = 0; k < DM; ++k) d += (xr[k] * rstd * p.norm_mix[l * DM + k]) * p.w_in[((size_t)l * DM + k) * INC + col];
    if (col < PROJW) { const float got = bf2f(proj[(size_t)row * PROJW + col]); atomicAdd(acc + 4, (got - d) * (got - d)); atomicAdd(acc + 5, d * d); }
    else { const float got = dtraw[(size_t)row * 16 + col - PROJW]; atomicAdd(acc + 6, (got - d) * (got - d)); atomicAdd(acc + 7, d * d); }
}
__global__ void dbg_chk_outproj(Params p, int l) {
    const int sidx = blockIdx.x * blockDim.x + threadIdx.x; float* acc = (float*)(p.ws + WS_DBG);
    const bf16_t* mix = (const bf16_t*)(p.ws + WS_MIX);
    unsigned hsh = (unsigned)sidx * 2654435761u + 777u; hsh ^= hsh >> 13; hsh *= 0x5bd1e995u; hsh ^= hsh >> 15;
    const int row = hsh % NTOK, col = (hsh >> 14) % DM;
    const bf16_t* mr = mix + (size_t)row * 2048; float s1 = 0.f, s2 = 0.f;
    for (int k = 0; k < 1024; ++k) { const float a = bf2f(mr[k]), b = bf2f(mr[1024 + k]); s1 += a * a; s2 += b * b; }
    const float r1 = 1.f / sqrtf(s1 / 1024.f + 1e-6f), r2 = 1.f / sqrtf(s2 / 1024.f + 1e-6f);
    float d = 0.f;
    for (int k = 0; k < 1024; ++k) { d += bf2f(mr[k]) * r1 * p.lru_norm[l * 1024 + k] * p.w_out[((size_t)l * 2048 + k) * DM + col]; d += bf2f(mr[1024 + k]) * r2 * p.ssd_norm[l * 1024 + k] * p.w_out[((size_t)l * 2048 + 1024 + k) * DM + col]; }
    const float* xb = (l == 0) ? p.x : (const float*)(p.ws + WS_MIX2); const float ref = d, got = p.X[(size_t)row * DM + col] - xb[(size_t)row * DM + col];
    atomicAdd(acc + 8, (got - ref) * (got - ref)); atomicAdd(acc + 9, ref * ref);
}

__global__ void __launch_bounds__(256) dbg_chk_moe(Params p, int l) {
    const int tid = threadIdx.x; float* acc = (float*)(p.ws + WS_DBG); const bf16_t* ys = (const bf16_t*)(p.ws + WS_YSLOT);
    unsigned hsh = (unsigned)blockIdx.x * 2654435761u + 4242u; hsh ^= hsh >> 13; hsh *= 0x5bd1e995u; hsh ^= hsh >> 15;
    const int row = hsh % NTOK;
    __shared__ float hs[1024], hid[512], red[256], outv[4]; __shared__ int ex[2]; __shared__ float ew[2];
    float ss = 0.f; for (int k = tid; k < DM; k += 256) { const float v = p.X[(size_t)row * DM + k]; ss += v * v; }
    red[tid] = ss; __syncthreads(); if (tid == 0) { float t = 0.f; for (int i = 0; i < 256; ++i) t += red[i]; red[0] = 1.f / sqrtf(t / DM + 1e-6f); } __syncthreads();
    const float rstd = red[0];
    for (int k = tid; k < DM; k += 256) hs[k] = p.X[(size_t)row * DM + k] * rstd * p.norm_ffn[l * DM + k];
    __syncthreads();
    if (tid == 0) { float cl[4]; for (int q = 0; q < 4; ++q) { float d = p.b_coarse[l * 4 + q]; for (int k = 0; k < DM; ++k) d += hs[k] * p.w_coarse[((size_t)l * DM + k) * 4 + q]; cl[q] = d; }
        int gi = 0; for (int q = 1; q < 4; ++q) if (cl[q] > cl[gi]) gi = q; float den = 0.f; for (int q = 0; q < 4; ++q) den += expf(cl[q] - cl[gi]);
        float fl[8]; for (int q = 0; q < 8; ++q) { float d = p.b_fine[(l * 4 + gi) * 8 + q]; for (int k = 0; k < DM; ++k) d += hs[k] * p.w_fine[(((size_t)l * 4 + gi) * DM + k) * 8 + q]; fl[q] = d; }
        int i0 = 0; for (int q = 1; q < 8; ++q) if (fl[q] > fl[i0]) i0 = q; int i1 = -1; for (int q = 0; q < 8; ++q) if (q != i0 && (i1 < 0 || fl[q] > fl[i1])) i1 = q;
        const float e1 = expf(fl[i1] - fl[i0]); ex[0] = gi * 8 + i0; ex[1] = gi * 8 + i1; ew[0] = (1.f / den) / (1.f + e1); ew[1] = (1.f / den) * e1 / (1.f + e1); }
    __syncthreads();
    if (tid < 4) outv[tid] = 0.f;
    for (int s2 = 0; s2 < 2; ++s2) { const int e = ex[s2]; const float* wg = p.w_gate + ((size_t)l * NEXP + e) * DM * DEXP; const float* wu = p.w_up + ((size_t)l * NEXP + e) * DM * DEXP; const float* wd = p.w_down + ((size_t)l * NEXP + e) * DEXP * DM;
        __syncthreads();
        for (int j = tid; j < DEXP; j += 256) { float g = 0.f, u = 0.f; for (int k = 0; k < DM; ++k) { g += hs[k] * wg[(size_t)k * DEXP + j]; u += hs[k] * wu[(size_t)k * DEXP + j]; } hid[j] = g / (1.f + expf(-g)) * u; }
        __syncthreads();
        if (tid < 4) { const int col = (hsh >> 16) % 256 + tid * 256; float d = 0.f; for (int j = 0; j < DEXP; ++j) d += hid[j] * wd[(size_t)j * DM + col]; outv[tid] += ew[s2] * d; } }
    __syncthreads();
    if (tid < 4) { const int col = (hsh >> 16) % 256 + tid * 256; const float got = bf2f(ys[(size_t)row * DM + col]) + bf2f(ys[((size_t)NTOK + row) * DM + col]); const float ref = outv[tid];
        atomicAdd(acc + 10, (got - ref) * (got - ref)); atomicAdd(acc + 11, ref * ref); }
}

__global__ void dbg_chk_final(Params p) {
    const int sidx = blockIdx.x * blockDim.x + threadIdx.x; float* acc = (float*)(p.ws + WS_DBG); const bf16_t* ys = (const bf16_t*)(p.ws + WS_YSLOT);
    unsigned hsh = (unsigned)sidx * 2654435761u + 99u; hsh ^= hsh >> 13; hsh *= 0x5bd1e995u; hsh ^= hsh >> 15;
    const int row = hsh % NTOK, col = (hsh >> 14) % DM; const float* xb = (const float*)(p.ws + WS_MIX2) + (size_t)row * DM;
    float ss = 0.f; for (int k = 0; k < DM; ++k) { const float v = xb[k] + bf2f(ys[(size_t)row * DM + k]) + bf2f(ys[((size_t)NTOK + row) * DM + k]); ss += v * v; }
    const float v = xb[col] + bf2f(ys[(size_t)row * DM + col]) + bf2f(ys[((size_t)NTOK + row) * DM + col]);
    const float ref = v / sqrtf(ss / DM + 1e-6f) * p.final_norm[col], got = p.X[(size_t)row * DM + col];
    atomicAdd(acc + 12, (got - ref) * (got - ref)); atomicAdd(acc + 13, ref * ref);
}
__global__ void dbg_zero(Params p) { float* acc = (float*)(p.ws + WS_DBG); if (threadIdx.x < 64) acc[threadIdx.x] = 0.f; }
__device__ __forceinline__ int dbg_digit(float num, float den) { const float d = sqrtf(num / fmaxf(den, 1e-30f)); if (!(d == d)) return 0; const float v = -2.f * log10f(fmaxf(d, 1e-10f)); return v < 0.f ? 0 : (v > 8.f ? 8 : (int)v); }
__global__ void dbg_report(Params p) {
    const float* acc = (const float*)(p.ws + WS_DBG);
    const size_t i = (size_t)blockIdx.x * blockDim.x + threadIdx.x;
    if (i < (size_t)NTOK * DM) p.X[i] = 0.f;
    if (i == 0) { const int a = dbg_digit(acc[DBGA], acc[DBGA + 1]), b = dbg_digit(acc[DBGB], acc[DBGB + 1]); p.X[0] = sqrtf((float)NTOK * DM * (9.f + 10.f * a + b)); }
}
#endif

#define XB_TMO      128
#define XB_XCNT(j)  (256  + 64 * (j))
#define XB_XSUB(j)  (1280 + 64 * (j))
#define XB_XGEN(j)  (2304 + 64 * (j))
#define XB_TOP      3328
#define XB_TOPGEN   3392
#define XCD_BAR_WORDS 3456
#define XB_SPIN_CAP (1u << 22)
constexpr int CW_BAR = 4096;
constexpr size_t CTL_ZERO_BYTES = 65536;
__device__ __forceinline__ unsigned xb_ld(unsigned* p)              { return __hip_atomic_load(p, __ATOMIC_RELAXED, __HIP_MEMORY_SCOPE_AGENT); }
__device__ __forceinline__ unsigned xb_add(unsigned* p, unsigned v) { return __hip_atomic_fetch_add(p, v, __ATOMIC_RELAXED, __HIP_MEMORY_SCOPE_AGENT); }
__device__ __forceinline__ unsigned xb_xcc_id() { return (unsigned)__builtin_amdgcn_s_getreg((3 << 11) | 20) & 0xFu; }
#define XB_SPIN(cond, bar) do { unsigned _sp = 0; while (cond) { __builtin_amdgcn_s_sleep(1); \
    if ((++_sp & 255u) == 0u) { if (xb_ld(&(bar)[XB_TMO])) break; if (_sp > XB_SPIN_CAP) { atomicAdd(&(bar)[XB_TMO], 1u); break; } } } } while (0)
struct XcdBarrier { unsigned* bar; unsigned x; volatile LAS unsigned* st; };
__device__ __forceinline__ XcdBarrier xcd_barrier_post(unsigned* bar, volatile LAS unsigned* st) {
    XcdBarrier b; b.bar = bar; b.x = xb_xcc_id(); b.st = st;
    if (threadIdx.x == 0) (void)xb_add(&bar[XB_XCNT(b.x)], 1u);
    return b;
}
__device__ __forceinline__ void xcd_barrier_complete(unsigned* bar, unsigned x, unsigned G, unsigned& nloc, unsigned& nx) {
    unsigned sum, cnt, mine, sp = 0u;
    for (;;) {
        sum = 0u; cnt = 0u; mine = 0u;
#pragma unroll
        for (unsigned j = 0; j < 16; ++j) { const unsigned c = xb_ld(&bar[XB_XCNT(j)]); sum += c; cnt += (c > 0u) ? 1u : 0u; mine = (j == x) ? c : mine; }
        if (sum == G) break;
        __builtin_amdgcn_s_sleep(1);
        if ((++sp & 255u) == 0u) { if (xb_ld(&bar[XB_TMO])) break; if (sp > XB_SPIN_CAP) { atomicAdd(&bar[XB_TMO], 1u); break; } }
    }
    nloc = mine > 0u ? mine : 1u; nx = cnt > 0u ? cnt : 1u;
}
__device__ __forceinline__ void xcd_barrier(const XcdBarrier& b) {
    asm volatile("s_waitcnt vmcnt(0)" ::: "memory");
    __syncthreads();
    if (threadIdx.x == 0) {
        size_t zb_; asm volatile("s_mov_b64 %0, 0" : "=s"(zb_)); unsigned* bar = b.bar + zb_;
        __builtin_amdgcn_s_waitcnt(0);
        const unsigned nloc = b.st[0], nx = b.st[1];
        unsigned bx = b.x; asm volatile("" : "+s"(bx));
        const unsigned old = xb_add(&bar[XB_XSUB(bx)], 1u);
        const unsigned gen = old / nloc;
        if (old + 1u == (gen + 1u) * nloc) {
            __builtin_amdgcn_fence(__ATOMIC_RELEASE, "agent");
            asm volatile("s_waitcnt vmcnt(0)" ::: "memory");
            const unsigned og = xb_add(&bar[XB_TOP], 1u);
            const unsigned tg = og / nx;
            if (og + 1u == (tg + 1u) * nx) xb_add(&bar[XB_TOPGEN], 1u);
            else XB_SPIN(xb_ld(&bar[XB_TOPGEN]) == tg, bar);
            __builtin_amdgcn_fence(__ATOMIC_ACQUIRE, "agent");
            xb_add(&bar[XB_XGEN(bx)], 1u);
            asm volatile("s_waitcnt vmcnt(0)" ::: "memory");
        } else {
            XB_SPIN(xb_ld(&bar[XB_XGEN(bx)]) == gen, bar);
            __builtin_amdgcn_fence(__ATOMIC_ACQUIRE, "agent");
            asm volatile("s_waitcnt vmcnt(0)" ::: "memory");
        }
    }
    __syncthreads();
}
enum { PH_CONVERT = 0, PH_NORM, PH_INPROJ, PH_MIXA, PH_SCAN, PH_MIXB, PH_OUTPROJ, PH_ROUTER, PH_MOEUP, PH_MOEDOWN, PH_FINAL };

template <int PH>
__device__ __forceinline__ void run_phase(const Params& p, int l, LAS unsigned char* lds) {
    if (PH == PH_CONVERT) ph_convert(p, l, lds);
    if (PH == PH_NORM) ph_norm(p, l, lds);
    if (PH == PH_INPROJ) ph_inproj(p, lds);
    if (PH == PH_MIXA) ph_mixA(p, l, lds);
    if (PH == PH_SCAN) ph_scan(p);
    if (PH == PH_MIXB) ph_mixB(p, l, lds);
    if (PH == PH_OUTPROJ) ph_outproj(p, l, lds);
    if (PH == PH_ROUTER) ph_router(p, l, lds);
    if (PH == PH_MOEUP) ph_moe_up(p, lds);
    if (PH == PH_MOEDOWN) ph_moe_down(p, lds);
    if (PH == PH_FINAL) ph_final(p);
}

template <int PH>
__global__ void __launch_bounds__(NTHR) k_phase(Params p, int l) {
    extern __shared__ __attribute__((aligned(16))) unsigned char lds_raw[];
    run_phase<PH>(p, l, (LAS unsigned char*)lds_raw);
}

#if ONE_LAUNCH
#ifndef USE_CG
#define USE_CG 0
#endif
__global__ void __launch_bounds__(NTHR, 2) k_mega(Params p) {
    extern __shared__ __attribute__((aligned(16))) unsigned char lds_raw[];
    LAS unsigned char* lds = (LAS unsigned char*)lds_raw;
#if USE_CG
    cg::grid_group grid = cg::this_grid();
#define GRID_BAR() grid.sync()
#else
    if (threadIdx.x < 64) ((volatile LAS unsigned*)(lds + LDS_MISC))[threadIdx.x] = 0u;
    __syncthreads();
    const XcdBarrier bar = xcd_barrier_post((unsigned*)(p.ws + WS_CTL) + CW_BAR, (volatile LAS unsigned*)(lds + LDS_MISC));
    { const unsigned Gn = gridDim.x; if (threadIdx.x == 0) { unsigned nloc, nx; xcd_barrier_complete(bar.bar, bar.x, Gn, nloc, nx); bar.st[0] = nloc; bar.st[1] = nx; } }
    __syncthreads();
#define GRID_BAR() xcd_barrier(bar)
#endif
#define AS1 __attribute__((address_space(1)))
#define AS4 __attribute__((address_space(4)))
#define KF(i) ((const float*)(const AS1 float*)kp_[i])
#define FRESH() Params q; int lv; { size_t z_; int lz_; asm volatile("s_mov_b64 %0, 0\n\ts_mov_b32 %1, 0" : "=s"(z_), "=s"(lz_)); lv = l + lz_; \
        const AS4 unsigned long long* kp_ = (const AS4 unsigned long long*)((const AS4 char*)__builtin_amdgcn_kernarg_segment_ptr() + z_); \
        q.x = KF(0); q.norm_mix = KF(1); q.w_in = KF(2); q.lru_conv_w = KF(3); q.lru_conv_b = KF(4); q.lru_wa = KF(5); q.lru_ba = KF(6); q.lru_wx = KF(7); q.lru_bx = KF(8); q.lru_lambda = KF(9); \
        q.lru_norm = KF(10); q.ssd_conv_w = KF(11); q.ssd_conv_b = KF(12); q.ssd_dt_bias = KF(13); q.ssd_a_log = KF(14); q.ssd_d = KF(15); q.ssd_norm = KF(16); q.w_out = KF(17); q.norm_ffn = KF(18); \
        q.w_coarse = KF(19); q.b_coarse = KF(20); q.w_fine = KF(21); q.b_fine = KF(22); q.w_gate = KF(23); q.w_up = KF(24); q.w_down = KF(25); q.final_norm = KF(26); \
        q.X = (float*)(AS1 float*)kp_[27]; q.ws = (unsigned char*)(AS1 unsigned char*)kp_[28]; }
#if TSEL
    unsigned long long tacc = 0ull, t0 = 0ull;
#define T0(k) do { if ((k) == TSEL) t0 = __builtin_amdgcn_s_memrealtime(); } while (0)
#define T1(k) do { if ((k) == TSEL) tacc += __builtin_amdgcn_s_memrealtime() - t0; } while (0)
#else
#define T0(k) do { } while (0)
#define T1(k) do { } while (0)
#endif
#pragma unroll 1
    for (int l = 0; l < DEPTH; ++l) {
        T0(1); { FRESH(); ph_convert(q, lv, lds); } T1(1);
        T0(2); { FRESH(); ph_norm(q, lv, lds); } GRID_BAR(); T1(2);
        T0(3); { FRESH(); ph_inproj(q, lds); } GRID_BAR(); T1(3);
        T0(4); { FRESH(); ph_mixA(q, lv, lds); } GRID_BAR(); T1(4);
        T0(5); { FRESH(); ph_scan(q); } GRID_BAR(); T1(5);
        T0(6); { FRESH(); ph_mixB(q, lv, lds); } GRID_BAR(); T1(6);
        T0(7); { FRESH(); ph_outproj(q, lv, lds); } GRID_BAR(); T1(7);
        T0(8); { FRESH(); ph_router(q, lv, lds); } GRID_BAR(); T1(8);
        T0(9); { FRESH(); ph_moe_up(q, lds); } GRID_BAR(); T1(9);
        T0(10); { FRESH(); ph_moe_down(q, lds); } GRID_BAR(); T1(10);
    }
    T0(11); { const int l = 0; FRESH(); (void)lv; ph_final(q); } T1(11);
#if TSEL >= 100
    if (threadIdx.x == 0) tacc = *(volatile LAS unsigned long long*)(lds + LDS_MISC + 64);
#endif
#if TSEL
    if (blockIdx.x == 0 && threadIdx.x == 0) { const unsigned long long te = __builtin_amdgcn_s_memrealtime(); while (__builtin_amdgcn_s_memrealtime() - te < 4ull * tacc) __builtin_amdgcn_s_sleep(8); }
#endif
}
#endif

template <int PH> static void launch_phase(const Params& p, int l, int grid, hipStream_t stream) {
    static bool attr = false;
    if (!attr) { (void)hipFuncSetAttribute((const void*)k_phase<PH>, hipFuncAttributeMaxDynamicSharedMemorySize, LDS_BYTES); attr = true; }
    hipLaunchKernelGGL(k_phase<PH>, dim3(grid), dim3(NTHR), LDS_BYTES, stream, p, l);
}

extern "C" void kernel_launch(void* const* d_in, const int* in_sizes, int n_in, void* d_out, int out_size, void* d_ws, size_t ws_size, hipStream_t stream) {
    if (n_in != 27 || in_sizes[0] != NTOK * DM || out_size != NTOK * DM || ws_size < WS_END) {
        fprintf(stderr, "kernel_launch: unexpected shapes (n_in %d, in0 %d, out %d, ws %zu)\n", n_in, n_in > 0 ? in_sizes[0] : -1, out_size, ws_size); return; }
    Params p{};
    const float** f = (const float**)&p;
    for (int i = 0; i < 27; ++i) f[i] = (const float*)d_in[i];
    p.X = (float*)d_out; p.ws = (unsigned char*)d_ws;
#if DBG
    { const int G = 256;
      launch_phase<PH_CONVERT>(p, 0, G, stream); launch_phase<PH_NORM>(p, 0, G, stream); launch_phase<PH_INPROJ>(p, 0, G, stream);
      launch_phase<PH_MIXA>(p, 0, G, stream); launch_phase<PH_SCAN>(p, 0, G, stream); launch_phase<PH_MIXB>(p, 0, G, stream);
      launch_phase<PH_OUTPROJ>(p, 0, G, stream);
      launch_phase<PH_ROUTER>(p, 0, G, stream); launch_phase<PH_MOEUP>(p, 0, G, stream); launch_phase<PH_MOEDOWN>(p, 0, G, stream);
      launch_phase<PH_CONVERT>(p, 1, G, stream); launch_phase<PH_NORM>(p, 1, G, stream); launch_phase<PH_INPROJ>(p, 1, G, stream);
      launch_phase<PH_MIXA>(p, 1, G, stream); launch_phase<PH_SCAN>(p, 1, G, stream); launch_phase<PH_MIXB>(p, 1, G, stream);
      launch_phase<PH_OUTPROJ>(p, 1, G, stream);
      launch_phase<PH_ROUTER>(p, 1, G, stream); launch_phase<PH_MOEUP>(p, 1, G, stream); launch_phase<PH_MOEDOWN>(p, 1, G, stream);
      (void)hipMemcpyAsync(p.ws + WS_MIX2, p.X, (size_t)NTOK * DM * 4, hipMemcpyDeviceToDevice, stream);
      launch_phase<PH_FINAL>(p, 0, G, stream);
      hipLaunchKernelGGL(dbg_zero, dim3(1), dim3(64), 0, stream, p);
      hipLaunchKernelGGL(dbg_chk_final, dim3(64), dim3(64), 0, stream, p);
      hipLaunchKernelGGL(dbg_report, dim3(NTOK * DM / 256), dim3(256), 0, stream, p);
      return; }
#endif
#if ONE_LAUNCH
    static int grid = 0;
    if (!grid) { int dev = 0, cus = 0, per_cu = 0; (void)hipGetDevice(&dev); (void)hipDeviceGetAttribute(&cus, hipDeviceAttributeMultiprocessorCount, dev);
        (void)hipFuncSetAttribute((const void*)k_mega, hipFuncAttributeMaxDynamicSharedMemorySize, LDS_BYTES);
        (void)hipOccupancyMaxActiveBlocksPerMultiprocessor(&per_cu, (const void*)k_mega, NTHR, LDS_BYTES);
        if (per_cu < 1) fprintf(stderr, "kernel_launch: occupancy query says %d blocks/CU\n", per_cu);
        (void)hipGetLastError();
        grid = cus; }
#if USE_CG
    void* args[] = {&p};
    hipError_t e = hipLaunchCooperativeKernel((const void*)k_mega, dim3(grid), dim3(NTHR), args, LDS_BYTES, stream);
    if (e != hipSuccess) fprintf(stderr, "cooperative launch failed: %s (grid %d)\n", hipGetErrorString(e), grid);
#else
    (void)hipMemsetAsync((char*)d_ws + WS_CTL, 0, CTL_ZERO_BYTES, stream);
    hipLaunchKernelGGL(k_mega, dim3(grid), dim3(NTHR), LDS_BYTES, stream, p);
#endif
#else
    const int G = 256;
    for (int l = 0; l < DEPTH; ++l) {
        launch_phase<PH_CONVERT>(p, l, G, stream);
        launch_phase<PH_NORM>(p, l, G, stream);
        launch_phase<PH_INPROJ>(p, l, G, stream);
        launch_phase<PH_MIXA>(p, l, G, stream);
        launch_phase<PH_SCAN>(p, l, G, stream);
        launch_phase<PH_MIXB>(p, l, G, stream);
        launch_phase<PH_OUTPROJ>(p, l, G, stream);
        launch_phase<PH_ROUTER>(p, l, G, stream);
        launch_phase<PH_MOEUP>(p, l, G, stream);
        launch_phase<PH_MOEDOWN>(p, l, G, stream);
    }
    launch_phase<PH_FINAL>(p, 0, G, stream);
#endif
}
```
